# Optimizing an MI355X kernel written in HIP

```python
import math
import jax, jax.numpy as jnp
from jax import lax
import numpy as np

D_MODEL = 1024
BATCH = 2
SEQ = 16384
DEPTH = 4
DEC_BATCH = 32
DEC_SEQ = 32
PAST_LEN = 1024

CHUNK = 64
N_META = 16
N_A_LAYERS = DEPTH // 2
N_B_LAYERS = DEPTH - N_A_LAYERS
SSM_GROUP = 16
N_GROUPS = D_MODEL // SSM_GROUP
SSM_STATE = 64
HEAD_DIM = 64
N_HEADS = D_MODEL // HEAD_DIM
N_KV_HEADS = 4
Q_PER_KV = N_HEADS // N_KV_HEADS
WINDOW = 128
LEFT_CHUNKS = WINDOW // CHUNK
BAND = WINDOW + CHUNK
N_BUCKETS = 32
MAX_DISTANCE = 128
D_FF = ((8 * D_MODEL // 3 + 255) // 256) * 256
EPS = 1e-6
NEG = -1e30

kernel_name = "yoco_s5_swa_sink_stream_step"

F32 = jnp.float32


def rmsnorm(x, g):
    xf = x.astype(F32)
    y = xf * lax.rsqrt(jnp.mean(xf * xf, axis=-1, keepdims=True) + EPS)
    return (y * g.astype(F32)).astype(x.dtype)


def swiglu(x, w_in, w_out):
    gate, up = jnp.split(x @ w_in, 2, axis=-1)
    return (jax.nn.silu(gate) * up) @ w_out


def s5_discretize(a_re, a_im, log_dt, b_re, b_im):
    a_re = a_re.astype(F32)
    a_im = a_im.astype(F32)
    dt = jnp.exp(log_dt.astype(F32))[:, None]
    mag = jnp.exp(a_re * dt)
    ang = a_im * dt
    abar_re = mag * jnp.cos(ang)
    abar_im = mag * jnp.sin(ang)
    num_re = abar_re - 1.0
    num_im = abar_im
    inv = 1.0 / (a_re * a_re + a_im * a_im)
    f_re = (num_re * a_re + num_im * a_im) * inv
    f_im = (num_im * a_re - num_re * a_im) * inv
    b_re = b_re.astype(F32)
    b_im = b_im.astype(F32)
    bbar_re = f_re[..., None] * b_re - f_im[..., None] * b_im
    bbar_im = f_re[..., None] * b_im + f_im[..., None] * b_re
    return abar_re, abar_im, bbar_re, bbar_im


def _linrec_combine(e1, e2):
    a1r, a1i, b1r, b1i = e1
    a2r, a2i, b2r, b2i = e2
    return (a2r * a1r - a2i * a1i, a2r * a1i + a2i * a1r,
            a2r * b1r - a2i * b1i + b2r, a2r * b1i + a2i * b1r + b2i)


def s5_block(u, h_re, h_im, disc, c_re, c_im, d_skip):
    abar_re, abar_im, bbar_re, bbar_im = disc
    bu_re = jnp.einsum('blgc,gpc->blgp', u, bbar_re)
    bu_im = jnp.einsum('blgc,gpc->blgp', u, bbar_im)
    first_re = abar_re * h_re - abar_im * h_im + bu_re[:, 0]
    first_im = abar_re * h_im + abar_im * h_re + bu_im[:, 0]
    bu_re = bu_re.at[:, 0].set(first_re)
    bu_im = bu_im.at[:, 0].set(first_im)
    a_re = jnp.broadcast_to(abar_re, bu_re.shape)
    a_im = jnp.broadcast_to(abar_im, bu_im.shape)
    _, _, hs_re, hs_im = lax.associative_scan(_linrec_combine, (a_re, a_im, bu_re, bu_im), axis=1)
    y = (jnp.einsum('blgp,gcp->blgc', hs_re, c_re)
         - jnp.einsum('blgp,gcp->blgc', hs_im, c_im) + d_skip * u)
    return y, hs_re[:, -1], hs_im[:, -1]


def s5_scan(u, h_re, h_im, disc, c_re, c_im, d_skip, block):
    bsz, length = u.shape[:2]
    nb = length // block
    ub = jnp.swapaxes(u.reshape(bsz, nb, block, N_GROUPS, SSM_GROUP), 0, 1)

    def step(carry, u_blk):
        y, hr, hi = s5_block(u_blk, carry[0], carry[1], disc, c_re, c_im, d_skip)
        return (hr, hi), y

    (h_re, h_im), ys = lax.scan(step, (h_re, h_im), ub)
    return jnp.swapaxes(ys, 0, 1).reshape(bsz, length, D_MODEL), h_re, h_im


def a_layer(x, h_re, h_im, l, block, ssm, norm_mix, norm_ffn, w_ffn_in, w_ffn_out):
    a_re, a_im, log_dt, b_re, b_im, c_re, c_im, d_skip, w_glu = ssm
    disc = s5_discretize(a_re[l], a_im[l], log_dt[l], b_re[l], b_im[l])
    bsz, length, _ = x.shape
    u = rmsnorm(x, norm_mix[l]).astype(F32).reshape(bsz, length, N_GROUPS, SSM_GROUP)
    y, h_re, h_im = s5_scan(u, h_re.astype(F32), h_im.astype(F32), disc,
                            c_re[l].astype(F32), c_im[l].astype(F32), d_skip[l].astype(F32), block)
    val, gate = jnp.split(jax.nn.gelu(y).astype(x.dtype) @ w_glu[l], 2, axis=-1)
    x = x + val * jax.nn.sigmoid(gate)
    x = x + swiglu(rmsnorm(x, norm_ffn[l]), w_ffn_in[l], w_ffn_out[l])
    return x, h_re, h_im


def shared_kv(x, norm_kv, w_kv, k_norm):
    k, v = jnp.split(rmsnorm(x, norm_kv) @ w_kv, 2, axis=-1)
    k = k.reshape(*x.shape[:-1], N_KV_HEADS, HEAD_DIM)
    v = v.reshape(*x.shape[:-1], N_KV_HEADS, HEAD_DIM)
    return rmsnorm(k, k_norm), v


def rel_bucket(rel):
    half = N_BUCKETS // 2
    max_exact = half // 2
    n = jnp.abs(rel)
    nf = jnp.maximum(n, 1).astype(F32)
    large = max_exact + (jnp.log(nf / max_exact) / math.log(MAX_DISTANCE / max_exact)
                         * (half - max_exact)).astype(jnp.int32)
    large = jnp.minimum(large, half - 1)
    return jnp.where(rel > 0, half, 0) + jnp.where(n < max_exact, n, large)


def rel_bias_lookup(rel, rel_bias):
    b = rel_bias.astype(F32)[rel_bucket(rel)]
    b = b.reshape(*rel.shape, N_KV_HEADS, Q_PER_KV)
    return jnp.moveaxis(b, 1, -1)


def queries(xn, w_q_l, q_norm_l):
    q = (xn @ w_q_l).reshape(*xn.shape[:-1], N_KV_HEADS, Q_PER_KV, HEAD_DIM)
    return rmsnorm(q, q_norm_l).astype(F32) * (HEAD_DIM ** -0.5)


def sink_attention(q, k_meta, v_meta, k, v, bias_meta, bias_band, band_mask, sinks):
    lm = jnp.einsum('...qkgd,mkd->...qkgm', q, k_meta.astype(F32)) + bias_meta
    lb = jnp.einsum('...qkgd,...skd->...qkgs', q, k.astype(F32)) + bias_band
    lb = jnp.where(band_mask, lb, NEG)
    s = sinks.astype(F32).reshape(N_KV_HEADS, Q_PER_KV, 1)
    m = jnp.maximum(jnp.maximum(lm.max(-1, keepdims=True), lb.max(-1, keepdims=True)), s)
    pm = jnp.exp(lm - m)
    pb = jnp.exp(lb - m)
    den = pm.sum(-1, keepdims=True) + pb.sum(-1, keepdims=True) + jnp.exp(s - m)
    out = (jnp.einsum('...qkgm,mkd->...qkgd', pm, v_meta.astype(F32))
           + jnp.einsum('...qkgs,...skd->...qkgd', pb, v.astype(F32)))
    return out / den


def window_attention_prompt(xn, w_q_l, q_norm_l, sinks_l, w_o_l, k_fr, v_fr, k_meta, v_meta, rel_bias):
    bsz, seq, _ = xn.shape
    nc = seq // CHUNK
    q = queries(xn, w_q_l, q_norm_l).reshape(bsz, nc, CHUNK, N_KV_HEADS, Q_PER_KV, HEAD_DIM)
    pad = ((0, 0), (WINDOW, 0), (0, 0), (0, 0))
    kp = jnp.pad(k_fr, pad).reshape(bsz, nc + LEFT_CHUNKS, CHUNK, N_KV_HEADS, HEAD_DIM)
    vp = jnp.pad(v_fr, pad).reshape(bsz, nc + LEFT_CHUNKS, CHUNK, N_KV_HEADS, HEAD_DIM)
    k_band = jnp.concatenate([kp[:, i:i + nc] for i in range(LEFT_CHUNKS + 1)], axis=2)
    v_band = jnp.concatenate([vp[:, i:i + nc] for i in range(LEFT_CHUNKS + 1)], axis=2)
    qi = jnp.arange(CHUNK)
    sj = jnp.arange(BAND)
    bias_band = rel_bias_lookup(sj[None, :] - WINDOW - qi[:, None], rel_bias)
    t = jnp.arange(seq)
    mj = jnp.arange(N_META)
    bias_meta = rel_bias_lookup(mj[None, :] - N_META - t[:, None], rel_bias).reshape(
        nc, CHUNK, N_KV_HEADS, Q_PER_KV, N_META)
    key_chunk = jnp.arange(nc)[:, None] - LEFT_CHUNKS + sj[None, :] // CHUNK
    mask = (key_chunk >= 0)[:, None, None, None, :]
    out = sink_attention(q, k_meta, v_meta, k_band, v_band, bias_meta, bias_band, mask, sinks_l)
    return out.reshape(bsz, seq, N_HEADS * HEAD_DIM).astype(xn.dtype) @ w_o_l


def window_attention_sample(xn, w_q_l, q_norm_l, sinks_l, w_o_l, cache_k, cache_v, k_new, v_new,
                            k_meta, v_meta, rel_bias):
    bsz, ds, _ = xn.shape
    q = queries(xn, w_q_l, q_norm_l)
    k = jnp.concatenate([cache_k.astype(k_new.dtype), k_new], axis=1)
    v = jnp.concatenate([cache_v.astype(v_new.dtype), v_new], axis=1)
    qi = jnp.arange(ds)
    sj = jnp.arange(WINDOW + ds)
    bias_band = rel_bias_lookup(sj[None, :] - WINDOW - qi[:, None], rel_bias)
    t = PAST_LEN + qi
    mj = jnp.arange(N_META)
    bias_meta = rel_bias_lookup(mj[None, :] - N_META - t[:, None], rel_bias)
    out = sink_attention(q, k_meta, v_meta, k, v, bias_meta, bias_band, jnp.asarray(True), sinks_l)
    return out.reshape(bsz, ds, N_HEADS * HEAD_DIM).astype(xn.dtype) @ w_o_l


def setup_inputs(seed: int = 0) -> dict:
    key = jax.random.key(seed)
    k = jax.random.split(key, 28)

    def nrm(kk, shape, scale):
        return jax.random.normal(kk, shape, F32) * scale

    def gain(kk, shape):
        return 1.0 + 0.02 * jax.random.normal(kk, shape, F32)

    na, nb, g, p, c = N_A_LAYERS, N_B_LAYERS, N_GROUPS, SSM_STATE, SSM_GROUP
    hd_all = N_HEADS * HEAD_DIM
    kv_all = N_KV_HEADS * HEAD_DIM
    n_idx = jnp.arange(p, dtype=F32)
    return {
        "x_prompt": nrm(k[0], (BATCH, SEQ, D_MODEL), 1.0),
        "x_sample": nrm(k[1], (DEC_BATCH, DEC_SEQ, D_MODEL), 1.0),
        "state_ssm_re": nrm(k[2], (na, DEC_BATCH, g, p), 0.1),
        "state_ssm_im": nrm(k[3], (na, DEC_BATCH, g, p), 0.1),
        "cache_k": nrm(k[4], (DEC_BATCH, WINDOW, N_KV_HEADS, HEAD_DIM), 1.0),
        "cache_v": nrm(k[5], (DEC_BATCH, WINDOW, N_KV_HEADS, HEAD_DIM), 1.0),
        "meta_tokens": nrm(k[6], (N_META, D_MODEL), 1.0),
        "norm_mix": gain(k[7], (DEPTH, D_MODEL)),
        "norm_ffn": gain(k[8], (DEPTH, D_MODEL)),
        "ssm_a_re": -0.5 + nrm(k[9], (na, g, p), 0.01),
        "ssm_a_im": math.pi * n_idx + nrm(k[10], (na, g, p), 0.01),
        "ssm_log_dt": jax.random.uniform(k[11], (na, g), F32, math.log(1e-3), math.log(1e-1)),
        "ssm_b_re": nrm(k[12], (na, g, p, c), (2 * c) ** -0.5),
        "ssm_b_im": nrm(k[13], (na, g, p, c), (2 * c) ** -0.5),
        "ssm_c_re": nrm(k[14], (na, g, c, p), 2.0 * p ** -0.5),
        "ssm_c_im": nrm(k[15], (na, g, c, p), 2.0 * p ** -0.5),
        "ssm_d": nrm(k[16], (na, g, c), 0.5),
        "w_glu": nrm(k[17], (na, D_MODEL, 2 * D_MODEL), D_MODEL ** -0.5),
        "w_ffn_in": nrm(k[18], (DEPTH, D_MODEL, 2 * D_FF), D_MODEL ** -0.5),
        "w_ffn_out": nrm(k[19], (DEPTH, D_FF, D_MODEL), D_FF ** -0.5),
        "norm_kv": gain(k[20], (D_MODEL,)),
        "w_kv": nrm(k[21], (D_MODEL, 2 * kv_all), D_MODEL ** -0.5),
        "k_norm": gain(k[22], (HEAD_DIM,)),
        "w_q": nrm(k[23], (nb, D_MODEL, hd_all), D_MODEL ** -0.5),
        "q_norm": gain(k[24], (nb, HEAD_DIM)),
        "attn_sinks": nrm(k[25], (nb, N_HEADS), 1.0),
        "w_o": nrm(k[26], (nb, hd_all, D_MODEL), hd_all ** -0.5),
        "rel_bias": nrm(k[27], (N_BUCKETS, N_HEADS), 0.5),
    }


def reference(x_prompt, x_sample, state_ssm_re, state_ssm_im, cache_k, cache_v, meta_tokens,
              norm_mix, norm_ffn, ssm_a_re, ssm_a_im, ssm_log_dt, ssm_b_re, ssm_b_im, ssm_c_re, ssm_c_im,
              ssm_d, w_glu, w_ffn_in, w_ffn_out, norm_kv, w_kv, k_norm, w_q, q_norm, attn_sinks, w_o,
              rel_bias):
    ssm = (ssm_a_re, ssm_a_im, ssm_log_dt, ssm_b_re, ssm_b_im, ssm_c_re, ssm_c_im, ssm_d, w_glu)

    meta = meta_tokens[None].astype(x_prompt.dtype)
    zero = jnp.zeros((1, N_GROUPS, SSM_STATE), F32)
    meta_h = []
    for l in range(N_A_LAYERS):
        meta, hr, hi = a_layer(meta, zero, zero, l, N_META, ssm, norm_mix, norm_ffn, w_ffn_in, w_ffn_out)
        meta_h.append((hr, hi))
    k_meta, v_meta = shared_kv(meta[0], norm_kv, w_kv, k_norm)

    x = x_prompt
    bsz = x.shape[0]
    p_re, p_im = [], []
    k_p = v_p = None
    for l in range(DEPTH):
        if l < N_A_LAYERS:
            h0r = jnp.broadcast_to(meta_h[l][0], (bsz, N_GROUPS, SSM_STATE))
            h0i = jnp.broadcast_to(meta_h[l][1], (bsz, N_GROUPS, SSM_STATE))
            x, hr, hi = a_layer(x, h0r, h0i, l, CHUNK, ssm, norm_mix, norm_ffn, w_ffn_in, w_ffn_out)
            p_re.append(hr)
            p_im.append(hi)
            if l == N_A_LAYERS - 1:
                k_p, v_p = shared_kv(x, norm_kv, w_kv, k_norm)
        else:
            j = l - N_A_LAYERS
            x = x + window_attention_prompt(rmsnorm(x, norm_mix[l]), w_q[j], q_norm[j], attn_sinks[j], w_o[j],
                                            k_p, v_p, k_meta, v_meta, rel_bias)
            x = x + swiglu(rmsnorm(x, norm_ffn[l]), w_ffn_in[l], w_ffn_out[l])
    y_prompt = x

    x = x_sample
    ds = x.shape[1]
    s_re, s_im = [], []
    k_s = v_s = None
    for l in range(DEPTH):
        if l < N_A_LAYERS:
            x, hr, hi = a_layer(x, state_ssm_re[l], state_ssm_im[l], l, ds, ssm, norm_mix, norm_ffn,
                                w_ffn_in, w_ffn_out)
            s_re.append(hr)
            s_im.append(hi)
            if l == N_A_LAYERS - 1:
                k_s, v_s = shared_kv(x, norm_kv, w_kv, k_norm)
        else:
            j = l - N_A_LAYERS
            x = x + window_attention_sample(rmsnorm(x, norm_mix[l]), w_q[j], q_norm[j], attn_sinks[j], w_o[j],
                                            cache_k, cache_v, k_s, v_s, k_meta, v_meta, rel_bias)
            x = x + swiglu(rmsnorm(x, norm_ffn[l]), w_ffn_in[l], w_ffn_out[l])
    y_sample = x

    p_ssm_re = jnp.stack(p_re)
    p_ssm_im = jnp.stack(p_im)
    p_k = k_p[:, -WINDOW:]
    p_v = v_p[:, -WINDOW:]
    s_ssm_re = jnp.stack(s_re)
    s_ssm_im = jnp.stack(s_im)
    return (y_prompt, y_sample, p_ssm_re, p_ssm_im, p_k, p_v, s_ssm_re, s_ssm_im, k_s, v_s)
```

```cpp
#include <hip/hip_runtime.h>
#include <hip/hip_cooperative_groups.h>
#include <cstdio>
#include <cstdint>
namespace cg = cooperative_groups;

typedef unsigned short bf16_t;
typedef short bf16x8 __attribute__((ext_vector_type(8)));
typedef float f32x4 __attribute__((ext_vector_type(4)));
typedef float f32x16 __attribute__((ext_vector_type(16)));
typedef unsigned u32x4 __attribute__((ext_vector_type(4)));
typedef unsigned u32x2 __attribute__((ext_vector_type(2)));

constexpr int D = 1024, SEQ = 16384, NB = 2, DB = 32, DS = 32, FF = 2816;
constexpr int R_PROMPT = 0, R_SAMPLE = 32768, R_META = 33792, R_REAL = 33808, R_PAD = 34048;
constexpr int NTM = R_PAD / 256;
constexpr int NCH = 2 * 1025 + 64, NCH_PAD = 2304;
constexpr int KROWS = 32768 + 32 * 160 + 16;
constexpr int KS_BASE = 32768, KM_BASE = 32768 + 5120;
constexpr size_t VT_S = (size_t)2 * 4 * 64 * 16384, VT_M = VT_S + (size_t)32 * 4 * 64 * 160;

constexpr size_t O_YP = 0, O_YS = 33554432, O_PRE = O_YS + 1048576, O_PIM = O_PRE + 16384, O_PK = O_PIM + 16384, O_PV = O_PK + 65536,
                 O_SRE = O_PV + 65536, O_SIM = O_SRE + 262144, O_SK = O_SIM + 262144, O_SV = O_SK + 262144, O_END = O_SV + 262144;

constexpr size_t al(size_t x) { return (x + 255) & ~(size_t)255; }
constexpr size_t W_XMETA = 0;
constexpr size_t W_XB = al(W_XMETA + (size_t)256 * D * 4);
constexpr size_t W_RS = al(W_XB + (size_t)R_PAD * D * 2);
constexpr size_t W_UB = al(W_RS + (size_t)R_PAD * 4);
constexpr size_t W_YG = al(W_UB + (size_t)R_PAD * D * 2);
constexpr size_t W_SB = al(W_YG + (size_t)R_PAD * D * 2);
constexpr size_t W_HIN = al(W_SB + (size_t)NCH_PAD * 8192 * 4);
constexpr size_t W_KB = al(W_HIN + (size_t)NCH_PAD * 8192 * 2);
constexpr size_t W_VT = al(W_KB + (size_t)(KROWS + 16) * 256 * 2);
constexpr size_t W_WGLU = al(W_VT + (size_t)(KROWS + 16) * 256 * 2);
constexpr size_t W_WIN = al(W_WGLU + (size_t)2 * 2048 * 1024 * 2);
constexpr size_t W_WOUT = al(W_WIN + (size_t)4 * 5632 * 1024 * 2);
constexpr size_t W_WQKV = al(W_WOUT + (size_t)4 * 1024 * FF * 2);
constexpr size_t W_WO = al(W_WQKV + (size_t)2560 * 1024 * 2);
constexpr size_t W_BS1 = al(W_WO + (size_t)2 * 1024 * 1024 * 2);
constexpr size_t W_BS3 = al(W_BS1 + (size_t)2 * 8192 * 512 * 2);
constexpr size_t W_A16 = al(W_BS3 + (size_t)2 * 16384 * 384 * 2);
constexpr size_t W_BAR = al(W_A16 + (size_t)2 * 64 * 64 * 8);
constexpr size_t W_END = al(W_BAR + (size_t)4096 * 4);
constexpr size_t W_HB = W_UB;
constexpr size_t W_KVRAW = W_SB;
constexpr size_t W_PART = W_UB + (size_t)R_PAD * FF * 2;
constexpr int SPLIT_ROW0 = 32768, SPLIT_ROWS = R_PAD - 32768, SPLIT_PM0 = 128;
static_assert(W_PART + (size_t)11 * SPLIT_ROWS * D * 4 <= W_KB, "partials overlay");
static_assert((size_t)R_PAD * FF * 2 <= W_HIN - W_UB, "hb overlay");
static_assert((size_t)R_PAD * 512 * 4 <= W_HIN - W_SB, "kvraw overlay");
static_assert(W_END <= (size_t)512 * 1024 * 1024, "workspace");

constexpr int LDS_BYTES = 147456;
constexpr int XB_LDS_OFF = LDS_BYTES - 16;
constexpr int PROBE = 0;

struct Params {
  const float* in[28];
  float* out;
  unsigned char* ws;
};

extern __shared__ __attribute__((aligned(16))) unsigned char shm[];

__device__ __forceinline__ unsigned cvt_pk_bf16(float lo, float hi) { unsigned r; asm volatile("v_cvt_pk_bf16_f32 %0, %1, %2" : "=v"(r) : "v"(lo), "v"(hi)); return r; }
__device__ __forceinline__ bf16_t f2bf(float f) { return (bf16_t)(cvt_pk_bf16(f, 0.f) & 0xffffu); }
__device__ __forceinline__ float bf2f(unsigned b) { return __uint_as_float(b << 16); }
__device__ __forceinline__ f32x4 unpack4(u32x2 r) { return (f32x4){__uint_as_float(r.x << 16), __uint_as_float(r.x & 0xffff0000u), __uint_as_float(r.y << 16), __uint_as_float(r.y & 0xffff0000u)}; }
__device__ __forceinline__ float shx(float v, int o, int lane) { return __int_as_float(__builtin_amdgcn_ds_bpermute((lane ^ o) << 2, __float_as_int(v))); }
__device__ __forceinline__ float wave_sum(float v, int lane) {
#pragma unroll
  for (int o = 1; o < 64; o <<= 1) v += shx(v, o, lane);
  return v;
}
__device__ __forceinline__ int tid_o() { int t = threadIdx.x; asm volatile("" : "+v"(t)); return t; }
__device__ __forceinline__ int bid_o() { int b = blockIdx.x; asm volatile("" : "+s"(b)); return b; }
__device__ __forceinline__ int gdim_o() { int b = gridDim.x; asm volatile("" : "+s"(b)); return b; }
__device__ __forceinline__ float sigmoidf_(float x) { return __builtin_amdgcn_rcpf(1.f + __expf(-x)); }
__device__ __forceinline__ float gelu_tanh(float x) {
  const float x2 = x * x;
  const float w = x * (-2.302208198f - 0.102943242f * x2);
  return x * __builtin_amdgcn_rcpf(1.f + __builtin_amdgcn_exp2f(w));
}
__device__ __forceinline__ float* xrow_ptr(const Params& p, int row) {
  return row < R_META ? p.out + (size_t)row * D : (float*)(p.ws + W_XMETA) + (size_t)(row - R_META) * D;
}
__device__ __forceinline__ const float* xsrc_ptr(const Params& p, int row) {
  return row < R_SAMPLE ? p.in[0] + (size_t)row * D : row < R_META ? p.in[1] + (size_t)(row - R_SAMPLE) * D : row < R_REAL ? p.in[6] + (size_t)(row - R_META) * D : nullptr;
}
__device__ __forceinline__ int chunk_row(int cgi) {
  if (cgi >= NCH) cgi = 0;
  if (cgi < 2050) { const int b = cgi >= 1025 ? 1 : 0; const int c = cgi - b * 1025; return c == 0 ? R_META : b * SEQ + (c - 1) * 16; }
  return R_SAMPLE + (cgi - 2050) * 16;
}

#define LAS __attribute__((address_space(3)))
constexpr int BM = 256, BK = 64, HALF = 128, HTB = HALF * BK * 2;
__device__ __forceinline__ int lds_byte(int r, int c) {
  int st = (r >> 4) * 2 + (c >> 5), rr = r & 15, cc = c & 31, ob = rr * 64 + cc * 2;
  return st * 1024 + (ob ^ (((ob >> 9) & 1) << 5));
}
__device__ __forceinline__ void stage_rc(int b, int& R, int& C) {
  int st = b / 1024, sb = b % 1024, swz = sb ^ (((sb >> 9) & 1) << 5);
  R = (st >> 1) * 16 + swz / 64; C = (st & 1) * 32 + (swz % 64) / 2;
}

typedef f32x4 acc_t[2][2][4][2];

struct ARow {
  const char* base; unsigned hstep; unsigned voff[2];
  __device__ __forceinline__ void init(const bf16_t* A, int lda, int brow) {
    base = (const char*)(A + (size_t)brow * lda); hstep = (unsigned)HALF * lda * 2u;
#pragma unroll
    for (int i = 0; i < 2; ++i) { int R, C; stage_rc(tid_o() * 16 + i * 8192, R, C); voff[i] = (unsigned)(R * lda + C) * 2u; }
  }
  __device__ __forceinline__ const char* ptr(int h, int i, int kt) const { return base + (size_t)h * hstep + (size_t)kt * 128 + voff[i]; }
};
struct AS1 {
  const char* ub; unsigned voff[2][2]; int pn;
  __device__ __forceinline__ void init(const bf16_t* u, int brow, int pn_) {
    ub = (const char*)u; pn = pn_;
#pragma unroll
    for (int h = 0; h < 2; ++h)
#pragma unroll
      for (int i = 0; i < 2; ++i) { int R, C; stage_rc(tid_o() * 16 + i * 8192, R, C);
        voff[h][i] = (unsigned)(chunk_row(brow + h * 128 + R) + (C >> 4)) * 2048u + (unsigned)(C & 15) * 2u; }
  }
  __device__ __forceinline__ const char* ptr(int h, int i, int kt) const { return ub + (size_t)((pn * 2 + (kt >> 2)) * 32 + (kt & 3) * 8192) + voff[h][i]; }
};
struct AS3 {
  const char* ub; const char* hin; unsigned voffu[2][2], voffh[2][2]; int g;
  __device__ __forceinline__ void init(const bf16_t* u, const bf16_t* hn, int brow, int g_) {
    ub = (const char*)u; hin = (const char*)hn; g = g_;
#pragma unroll
    for (int h = 0; h < 2; ++h)
#pragma unroll
      for (int i = 0; i < 2; ++i) { int R, C; stage_rc(tid_o() * 16 + i * 8192, R, C);
        int cgi = brow + h * 128 + R; if (cgi >= NCH) cgi = 0;
        voffu[h][i] = (unsigned)(chunk_row(cgi) + (C >> 4)) * 2048u + (unsigned)(C & 15) * 2u;
        voffh[h][i] = (unsigned)cgi * 16384u + (unsigned)C * 2u; }
  }
  __device__ __forceinline__ const char* ptr(int h, int i, int kt) const {
    return kt < 4 ? ub + (size_t)(g * 32 + kt * 8192) + voffu[h][i] : hin + (size_t)(g * 256 + (kt - 4) * 128) + voffh[h][i];
  }
};

template <class AF>
__device__ __forceinline__ void gemm_mainloop(acc_t& acc, const AF& A, const bf16_t* Bt, int K, int bcol, int nt) {
  LAS unsigned char* lds = (LAS unsigned char*)shm;
  const int tid = tid_o(), wid = __builtin_amdgcn_readfirstlane(tid >> 6), lane = tid & 63, wr = wid >> 2, wc = wid & 3, fr = lane & 15, fq = lane >> 4;
  unsigned voffB[2];
#pragma unroll
  for (int i = 0; i < 2; ++i) { int R, C; stage_rc(tid * 16 + i * 8192, R, C); voffB[i] = (unsigned)(R * K + C) * 2u; }
  const char* cB = (const char*)(Bt + (size_t)bcol * K);
  const size_t hstepB = (size_t)HALF * K * 2;
  const unsigned ldsw = (unsigned)wid * 1024u;
  const int aoff = lds_byte(wr * 64 + fr, fq * 8), boff = lds_byte(wc * 32 + fr, fq * 8);
#define SA(b, h) (((b) * 2 + (h)) * HTB)
#define SB(b, h) ((4 + (b) * 2 + (h)) * HTB)
#define STAGE_A(bufoff, h, kt) do { _Pragma("unroll") for (int _i = 0; _i < 2; ++_i) \
    __builtin_amdgcn_global_load_lds((const unsigned*)A.ptr(h, _i, kt), (LAS unsigned*)(lds + (bufoff) + ldsw + _i * 8192), 16, 0, 0); } while (0)
#define STAGE_B(bufoff, h, kt) do { _Pragma("unroll") for (int _i = 0; _i < 2; ++_i) \
    __builtin_amdgcn_global_load_lds((const unsigned*)(cB + (size_t)(h) * hstepB + (size_t)(kt) * 128 + voffB[_i]), (LAS unsigned*)(lds + (bufoff) + ldsw + _i * 8192), 16, 0, 0); } while (0)
#define LDA(dst, b, h) do { _Pragma("unroll") for (int m = 0; m < 4; ++m) _Pragma("unroll") for (int k = 0; k < 2; ++k) dst[m][k] = *(const LAS bf16x8*)(lds + SA(b, h) + aoff + m * 2048 + k * 1024); } while (0)
#define LDB(dst, b, h) do { _Pragma("unroll") for (int n = 0; n < 2; ++n) _Pragma("unroll") for (int k = 0; k < 2; ++k) dst[n][k] = *(const LAS bf16x8*)(lds + SB(b, h) + boff + n * 2048 + k * 1024); } while (0)
#define MMA(ai, bj, At_, Bt_) do { __builtin_amdgcn_s_setprio(1); _Pragma("unroll") for (int m = 0; m < 4; ++m) _Pragma("unroll") for (int n = 0; n < 2; ++n) _Pragma("unroll") for (int k = 0; k < 2; ++k) \
      acc[ai][bj][m][n] = __builtin_amdgcn_mfma_f32_16x16x32_bf16(Bt_[n][k], At_[m][k], acc[ai][bj][m][n], 0, 0, 0); \
    __builtin_amdgcn_s_setprio(0); } while (0)
#define WAIT_V(n) asm volatile("s_waitcnt vmcnt(" #n ")" ::: "memory")
#define WAIT_L(n) asm volatile("s_waitcnt lgkmcnt(" #n ")" ::: "memory")
#define BAR __builtin_amdgcn_s_barrier()
#define SCHED __builtin_amdgcn_sched_barrier(0)
#pragma unroll
  for (int a = 0; a < 2; ++a)
#pragma unroll
    for (int b = 0; b < 2; ++b)
#pragma unroll
      for (int m = 0; m < 4; ++m)
#pragma unroll
        for (int n = 0; n < 2; ++n) acc[a][b][m][n] = (f32x4){0.f, 0.f, 0.f, 0.f};
  bf16x8 At[4][2], B0[2][2], B1[2][2];
  STAGE_B(SB(0, 0), 0, 0); STAGE_A(SA(0, 0), 0, 0); STAGE_B(SB(0, 1), 1, 0); STAGE_A(SA(0, 1), 1, 0);
  if (wr == 1) BAR;
  WAIT_V(4); BAR;
  STAGE_B(SB(1, 0), 0, 1); STAGE_A(SA(1, 0), 0, 1); STAGE_B(SB(1, 1), 1, 1);
  WAIT_V(6); BAR;
#pragma unroll 1
  for (int t = 0; t < nt - 2; t += 2) {
    LDB(B0, 0, 0); SCHED; LDA(At, 0, 0); STAGE_A(SA(1, 1), 1, t + 1);
    WAIT_L(8); BAR; WAIT_L(0); MMA(0, 0, At, B0); BAR; SCHED;
    LDB(B1, 0, 1); STAGE_B(SB(0, 0), 0, t + 2);
    BAR; WAIT_L(0); MMA(0, 1, At, B1); BAR;
    LDA(At, 0, 1); STAGE_A(SA(0, 0), 0, t + 2);
    BAR; WAIT_L(0); MMA(1, 0, At, B0); BAR; SCHED;
    STAGE_B(SB(0, 1), 1, t + 2);
    WAIT_V(6); BAR; MMA(1, 1, At, B1); BAR;
    LDB(B0, 1, 0); SCHED; LDA(At, 1, 0); STAGE_A(SA(0, 1), 1, t + 2);
    WAIT_L(8); BAR; WAIT_L(0); MMA(0, 0, At, B0); BAR; SCHED;
    LDB(B1, 1, 1); STAGE_B(SB(1, 0), 0, t + 3);
    BAR; WAIT_L(0); MMA(0, 1, At, B1); BAR;
    LDA(At, 1, 1); STAGE_A(SA(1, 0), 0, t + 3);
    BAR; WAIT_L(0); MMA(1, 0, At, B0); BAR; SCHED;
    STAGE_B(SB(1, 1), 1, t + 3);
    WAIT_V(6); BAR; MMA(1, 1, At, B1); BAR;
  }
  { LDB(B0, 0, 0); LDA(At, 0, 0); STAGE_A(SA(1, 1), 1, nt - 1);
    BAR; WAIT_L(0); MMA(0, 0, At, B0); BAR;
    LDB(B1, 0, 1); BAR; WAIT_L(0); MMA(0, 1, At, B1); BAR;
    LDA(At, 0, 1); WAIT_V(4); BAR; WAIT_L(0); MMA(1, 0, At, B0); MMA(1, 1, At, B1); BAR; }
  { LDB(B0, 1, 0); LDA(At, 1, 0); WAIT_V(2); BAR; WAIT_L(0); MMA(0, 0, At, B0); BAR;
    LDB(B1, 1, 1); WAIT_V(0); BAR; WAIT_L(0); MMA(0, 1, At, B1); BAR;
    LDA(At, 1, 1); BAR; WAIT_L(0); MMA(1, 0, At, B0); MMA(1, 1, At, B1); BAR; }
  if (wr == 0) BAR;
#undef SA
#undef SB
}


#define XB_TMO      128
#define XB_XCNT(j)  (256  + 64 * (j))
#define XB_XSUB(j)  (1280 + 64 * (j))
#define XB_XGEN(j)  (2304 + 64 * (j))
#define XB_TOP      3328
#define XB_TOPGEN   3392
#define XCD_BAR_WORDS 3456
#define XB_SPIN_CAP (1u << 18)
__device__ __forceinline__ unsigned xb_ld(unsigned* p)              { return __hip_atomic_load(p, __ATOMIC_RELAXED, __HIP_MEMORY_SCOPE_AGENT); }
__device__ __forceinline__ unsigned xb_add(unsigned* p, unsigned v) { return __hip_atomic_fetch_add(p, v, __ATOMIC_RELAXED, __HIP_MEMORY_SCOPE_AGENT); }
__device__ __forceinline__ unsigned xb_xcc_id() { return (unsigned)__builtin_amdgcn_s_getreg((3 << 11) | 20) & 0xFu; }
#define XB_SPIN(cond, bar) do { unsigned _sp = 0; while (cond) { __builtin_amdgcn_s_sleep(1); \
    if ((++_sp & 255u) == 0u) { if (xb_ld(&(bar)[XB_TMO])) break; if (_sp > XB_SPIN_CAP) { atomicAdd(&(bar)[XB_TMO], 1u); break; } } } } while (0)
struct XcdBarrier { unsigned* bar; unsigned x; volatile LAS unsigned* st; };
__device__ __forceinline__ XcdBarrier xcd_barrier_post(unsigned* bar, volatile LAS unsigned* st) {
  XcdBarrier b; b.bar = bar; b.x = xb_xcc_id(); b.st = st;
  if (threadIdx.x == 0) (void)xb_add(&bar[XB_XCNT(b.x)], 1u);
  return b;
}
__device__ __forceinline__ void xcd_barrier_complete(unsigned* bar, unsigned x, unsigned& nloc, unsigned& nx) {
  const unsigned G = gridDim.x * gridDim.y * gridDim.z;
  unsigned sum, cnt, mine, sp = 0u;
  for (;;) {
    sum = 0u; cnt = 0u; mine = 0u;
#pragma unroll
    for (unsigned j = 0; j < 16; ++j) { const unsigned c = xb_ld(&bar[XB_XCNT(j)]); sum += c; cnt += (c > 0u) ? 1u : 0u; mine = (j == x) ? c : mine; }
    if (sum == G) break;
    __builtin_amdgcn_s_sleep(1);
    if ((++sp & 255u) == 0u) { if (xb_ld(&bar[XB_TMO])) break; if (sp > XB_SPIN_CAP) { atomicAdd(&bar[XB_TMO], 1u); break; } }
  }
  nloc = mine > 0u ? mine : 1u; nx = cnt > 0u ? cnt : 1u;
}
__device__ __forceinline__ void xcd_barrier(unsigned char* ws_) {
  XcdBarrier b; b.bar = (unsigned*)(ws_ + W_BAR); b.x = xb_xcc_id(); b.st = (volatile LAS unsigned*)((LAS unsigned char*)shm + XB_LDS_OFF);
  asm volatile("s_waitcnt vmcnt(0)" ::: "memory");
  __syncthreads();
  if (threadIdx.x == 0) {
    unsigned* bar = b.bar;
    __builtin_amdgcn_s_waitcnt(0);
    unsigned nloc = b.st[0], nx = b.st[1];
    if (nloc == 0u) { xcd_barrier_complete(bar, b.x, nloc, nx); b.st[0] = nloc; b.st[1] = nx; }
    const unsigned old = xb_add(&bar[XB_XSUB(b.x)], 1u);
    const unsigned gen = old / nloc;
    if (old + 1u == (gen + 1u) * nloc) {
      __builtin_amdgcn_fence(__ATOMIC_RELEASE, "agent");
      asm volatile("s_waitcnt vmcnt(0)" ::: "memory");
      const unsigned og = xb_add(&bar[XB_TOP], 1u);
      const unsigned tg = og / nx;
      if (og + 1u == (tg + 1u) * nx) xb_add(&bar[XB_TOPGEN], 1u);
      else XB_SPIN(xb_ld(&bar[XB_TOPGEN]) == tg, bar);
      __builtin_amdgcn_fence(__ATOMIC_ACQUIRE, "agent");
      xb_add(&bar[XB_XGEN(b.x)], 1u);
      asm volatile("s_waitcnt vmcnt(0)" ::: "memory");
    } else {
      XB_SPIN(xb_ld(&bar[XB_XGEN(b.x)]) == gen, bar);
      __builtin_amdgcn_fence(__ATOMIC_ACQUIRE, "agent");
      asm volatile("s_waitcnt vmcnt(0)" ::: "memory");
    }
  }
  __syncthreads();
}

__device__ __forceinline__ bool tile_at(long L, int nM, int nN, int& pm, int& pn) {
  const int nwg = nM * nN;
  if (L >= nwg) return false;
  int wgid = (int)L;
  { const int q = nwg / 8, r = nwg % 8, xcd = wgid % 8, off = wgid / 8; wgid = (xcd < r ? xcd * (q + 1) : r * (q + 1) + (xcd - r) * q) + off; }
  const int nig = 8 * nN, gid = wgid / nig, fm = gid * 8, gsz = (nM - fm) < 8 ? (nM - fm) : 8;
  pm = fm + ((wgid % nig) % gsz); pn = (wgid % nig) / gsz;
  return true;
}
__device__ __forceinline__ bool tile_next(int it, int nM, int nN, int& pm, int& pn) { return tile_at((long)it * gdim_o() + bid_o(), nM, nN, pm, pn); }

#define EPI_ROWS_BEGIN \
  const int wid = tid_o() >> 6, lane = tid_o() & 63, wr = wid >> 2, wc = wid & 3, fr = lane & 15, fq = lane >> 4; \
  _Pragma("unroll") for (int ai = 0; ai < 2; ++ai) _Pragma("unroll") for (int m = 0; m < 4; ++m) { \
    const int row = brow + ai * 128 + wr * 64 + m * 16 + fr;
#define EPI_ROWS_END }

enum { G_GLU = 0, G_FFIN = 1, G_RESID = 2, G_QKV = 3, G_S1 = 4, G_S3 = 5 };

template <int MODE>
__device__ __forceinline__ void gemm_phase(const Params& p, const bf16_t* A, int lda, const bf16_t* Bt, int N, int K, int first = 0) {
  const int nM = (MODE == G_S1 || MODE == G_S3) ? NCH_PAD / 256 : NTM, nN = N / 256, nt = K / BK;
  unsigned char* ws = p.ws;
  const int G = gdim_o(), ks = nt / 4, nsplit = (NTM - SPLIT_PM0) * nN * ks, nMw = (MODE == G_RESID) ? SPLIT_PM0 : nM;
  const int nfull_it = (nMw * nN + G - 1) / G;
#pragma unroll 1
  for (int it = 0;; ++it) {
    int pm, pn; bool split = false; int kt0 = 0, ntu = nt, ksi = 0;
    if (MODE == G_RESID && it >= nfull_it) {
      const int u = (it - nfull_it) * G + bid_o();
      if (u >= nsplit) break;
      ksi = u % ks; const int tq = u / ks; pn = tq % nN; pm = SPLIT_PM0 + tq / nN;
      split = true; kt0 = ksi * 4; ntu = 4;
    } else if (!tile_next(it, nMw, nN, pm, pn)) { if (MODE == G_RESID) continue; else break; }
    const int brow = pm * 256, bcol = pn * 256;
    float rsv[8];
    if (MODE == G_FFIN || MODE == G_QKV) {
      const int tid_ = tid_o(), wr_ = (tid_ >> 6) >> 2, fr_ = tid_ & 15;
      const float* rsp = (const float*)(ws + W_RS) + brow + wr_ * 64 + fr_;
#pragma unroll
      for (int q = 0; q < 8; ++q) rsv[q] = rsp[(q >> 2) * 128 + (q & 3) * 16];
    }
    acc_t acc;
    if (MODE == G_S1) { AS1 af; af.init((const bf16_t*)(ws + W_UB), brow, pn); gemm_mainloop(acc, af, Bt, K, bcol, nt); }
    else if (MODE == G_S3) { AS3 af; af.init((const bf16_t*)(ws + W_UB), (const bf16_t*)(ws + W_HIN), brow, pn); gemm_mainloop(acc, af, Bt, K, bcol, nt); }
    else { ARow af; af.init(A + kt0 * BK, lda, brow); gemm_mainloop(acc, af, Bt + kt0 * BK, K, bcol, ntu); }
    if (MODE == G_GLU) {
      bf16_t* xb = (bf16_t*)(ws + W_XB);
      EPI_ROWS_BEGIN
        bf16_t* xr = xb + (size_t)row * D;
        const int oc = (bcol >> 1) + wc * 32 + fq * 8;
        f32x4 x0, x1;
        if (first & 1) { const float* xs = xsrc_ptr(p, row); x0 = xs ? *(const f32x4*)(xs + oc) : (f32x4){0.f, 0.f, 0.f, 0.f}; x1 = xs ? *(const f32x4*)(xs + oc + 4) : (f32x4){0.f, 0.f, 0.f, 0.f}; }
        else { const u32x4 raw = *(const u32x4*)(xr + oc); x0 = unpack4((u32x2){raw.x, raw.y}); x1 = unpack4((u32x2){raw.z, raw.w}); }
#pragma unroll
        for (int j = 0; j < 4; ++j) { x0[j] += acc[ai][0][m][0][j] * sigmoidf_(acc[ai][1][m][0][j]); x1[j] += acc[ai][0][m][1][j] * sigmoidf_(acc[ai][1][m][1][j]); }
        u32x4 o; o.x = cvt_pk_bf16(x0[0], x0[1]); o.y = cvt_pk_bf16(x0[2], x0[3]); o.z = cvt_pk_bf16(x1[0], x1[1]); o.w = cvt_pk_bf16(x1[2], x1[3]);
        *(u32x4*)(xr + oc) = o;
      EPI_ROWS_END
    } else if (MODE == G_FFIN) {
      bf16_t* hb = (bf16_t*)(ws + W_HB); const float* rs = (const float*)(ws + W_RS);
      EPI_ROWS_BEGIN
        const float s = rsv[ai * 4 + m];
        const int oc = (bcol >> 1) + wc * 32 + fq * 8;
        float hv[8];
#pragma unroll
        for (int n = 0; n < 2; ++n)
#pragma unroll
          for (int j = 0; j < 4; ++j) { const float gt = acc[ai][0][m][n][j] * s, up = acc[ai][1][m][n][j] * s; hv[n * 4 + j] = gt * sigmoidf_(gt) * up; }
        u32x4 o; o.x = cvt_pk_bf16(hv[0], hv[1]); o.y = cvt_pk_bf16(hv[2], hv[3]); o.z = cvt_pk_bf16(hv[4], hv[5]); o.w = cvt_pk_bf16(hv[6], hv[7]);
        *(u32x4*)(hb + (size_t)row * FF + oc) = o;
      EPI_ROWS_END
    } else if (MODE == G_RESID) {
      bf16_t* xb = (bf16_t*)(ws + W_XB);
      EPI_ROWS_BEGIN
        bf16_t* xr = xb + (size_t)row * D;
#pragma unroll
        for (int bj = 0; bj < 2; ++bj)
#pragma unroll
          for (int n = 0; n < 2; ++n) {
            const int oc = bcol + bj * 128 + wc * 32 + n * 16 + fq * 4;
            if (split) {
              *(f32x4*)((float*)(ws + W_PART) + ((size_t)ksi * SPLIT_ROWS + (row - SPLIT_ROW0)) * D + oc) = acc[ai][bj][m][n];
            } else {
              f32x4 x = unpack4(*(const u32x2*)(xr + oc));
              x += acc[ai][bj][m][n];
              if (first & 2) *(f32x4*)(xrow_ptr(p, row) + oc) = x;
              else { u32x2 o; o.x = cvt_pk_bf16(x[0], x[1]); o.y = cvt_pk_bf16(x[2], x[3]); *(u32x2*)(xr + oc) = o; }
            }
          }
      EPI_ROWS_END
    } else if (MODE == G_QKV) {
      bf16_t* qb = (bf16_t*)(ws + W_UB); float* kv = (float*)(ws + W_KVRAW); const float* rs = (const float*)(ws + W_RS);
      EPI_ROWS_BEGIN
        const float s = rsv[ai * 4 + m];
#pragma unroll
        for (int bj = 0; bj < 2; ++bj)
#pragma unroll
          for (int n = 0; n < 2; ++n) {
            const int oc = bcol + bj * 128 + wc * 32 + n * 16 + fq * 4;
            const f32x4 v = acc[ai][bj][m][n] * s;
            if (bcol < 1024) { u32x2 o; o.x = cvt_pk_bf16(v[0], v[1]); o.y = cvt_pk_bf16(v[2], v[3]); *(u32x2*)(qb + (size_t)row * D + oc) = o; }
            else *(f32x4*)(kv + (size_t)row * 512 + (oc - 1024)) = v;
          }
      EPI_ROWS_END
    } else if (MODE == G_S1) {
      float* sb = (float*)(ws + W_SB);
      EPI_ROWS_BEGIN
#pragma unroll
        for (int bj = 0; bj < 2; ++bj)
#pragma unroll
          for (int n = 0; n < 2; ++n) {
            const int oc = bcol + bj * 128 + wc * 32 + n * 16 + fq * 4;
            *(f32x4*)(sb + (size_t)row * 8192 + oc) = acc[ai][bj][m][n];
          }
      EPI_ROWS_END
    } else if (MODE == G_S3) {
      bf16_t* yg = (bf16_t*)(ws + W_YG);
      EPI_ROWS_BEGIN
        const bool valid = row < NCH && row != 1025;
        const int tr = chunk_row(row);
        if (valid) {
#pragma unroll
          for (int bj = 0; bj < 2; ++bj)
#pragma unroll
            for (int n = 0; n < 2; ++n) {
              const int t = bj * 8 + wc * 2 + n;
              const f32x4 v = acc[ai][bj][m][n];
              u32x2 o; o.x = cvt_pk_bf16(gelu_tanh(v[0]), gelu_tanh(v[1])); o.y = cvt_pk_bf16(gelu_tanh(v[2]), gelu_tanh(v[3]));
              *(u32x2*)(yg + (size_t)(tr + t) * D + pn * 16 + fq * 4) = o;
            }
        }
      EPI_ROWS_END
    }
    __builtin_amdgcn_s_barrier();
  }
}

__device__ __forceinline__ int perm32(int rho) { return 8 * ((rho & 15) >> 2) + 4 * (rho >> 4) + (rho & 3); }
__device__ __forceinline__ int srccol(int np, int mode, int Nh) {
  if (mode == 0) return np;
  const int t256 = np >> 8, r = np & 255, bj = r >> 7, r128 = r & 127, out = t256 * 128 + (r128 & ~31) + perm32(r128 & 31);
  return bj ? Nh + out : out;
}
__device__ __forceinline__ void transpose_tile(const float* W, int K, int N, bf16_t* Wt, int np0, int k0, int mode, int Nh, const float* gain) {
  float* tile = (float*)shm;
  const int tid = tid_o(), c4 = tid & 63, r0 = tid >> 6;
  const int sc = srccol(np0 + c4 * 4, mode, Nh);
  f32x4 v[8];
#pragma unroll
  for (int q = 0; q < 8; ++q) v[q] = *(const f32x4*)(W + (size_t)(k0 + r0 + q * 8) * N + sc);
#pragma unroll
  for (int q = 0; q < 8; ++q) { const int r = r0 + q * 8; const float g = gain ? gain[k0 + r] : 1.f; float* t = tile + r * 257 + c4 * 4; t[0] = v[q].x * g; t[1] = v[q].y * g; t[2] = v[q].z * g; t[3] = v[q].w * g; }
  __syncthreads();
#pragma unroll
  for (int q = 0; q < 4; ++q) {
    const int e = tid + q * 512, n = e & 255, ks = e >> 8;
    const float* s = tile + (ks * 8) * 257 + n;
    u32x4 o; o.x = cvt_pk_bf16(s[0], s[257]); o.y = cvt_pk_bf16(s[2 * 257], s[3 * 257]); o.z = cvt_pk_bf16(s[4 * 257], s[5 * 257]); o.w = cvt_pk_bf16(s[6 * 257], s[7 * 257]);
    *(u32x4*)(Wt + (size_t)(np0 + n) * K + k0 + ks * 8) = o;
  }
  __syncthreads();
}

__device__ __forceinline__ void weights_phase(const Params& p) {
  unsigned char* ws = p.ws;
  const int total = 2 * 128 + 4 * 352 + 4 * 176 + 64 + 32 + 64 + 2 * 64;
  unsigned* qctr = (unsigned*)(ws + W_BAR) + 3600;
  volatile LAS int* qslot = (volatile LAS int*)((LAS unsigned char*)shm + XB_LDS_OFF + 8);
  for (;;) {
    __syncthreads();
    if (tid_o() == 0) *qslot = (int)__hip_atomic_fetch_add(qctr, 1u, __ATOMIC_RELAXED, __HIP_MEMORY_SCOPE_AGENT);
    __syncthreads();
    const int t = *qslot;
    if (t >= total) break;
    int r = t; const float* W; int K, N, mode = 0, Nh = 0; const float* gain = nullptr; bf16_t* dst;
    if (r < 256) { const int l = r / 128; r -= l * 128; W = p.in[17] + (size_t)l * 1024 * 2048; K = 1024; N = 2048; mode = 1; Nh = 1024; dst = (bf16_t*)(ws + W_WGLU) + (size_t)l * 2048 * 1024; }
    else if ((r -= 256) < 1408) { const int l = r / 352; r -= l * 352; W = p.in[18] + (size_t)l * 1024 * 5632; K = 1024; N = 5632; mode = 1; Nh = FF; gain = p.in[8] + l * D; dst = (bf16_t*)(ws + W_WIN) + (size_t)l * 5632 * 1024; }
    else if ((r -= 1408) < 704) { const int l = r / 176; r -= l * 176; W = p.in[19] + (size_t)l * FF * 1024; K = FF; N = 1024; dst = (bf16_t*)(ws + W_WOUT) + (size_t)l * 1024 * FF; }
    else if ((r -= 704) < 64) { W = p.in[23]; K = 1024; N = 1024; gain = p.in[7] + 2 * D; dst = (bf16_t*)(ws + W_WQKV); }
    else if ((r -= 64) < 32) { W = p.in[21]; K = 1024; N = 512; gain = p.in[20]; dst = (bf16_t*)(ws + W_WQKV) + (size_t)1024 * 1024; }
    else if ((r -= 32) < 64) { W = p.in[23] + (size_t)1024 * 1024; K = 1024; N = 1024; gain = p.in[7] + 3 * D; dst = (bf16_t*)(ws + W_WQKV) + (size_t)1536 * 1024; }
    else { r -= 64; const int l = r / 64; r -= l * 64; W = p.in[26] + (size_t)l * 1024 * 1024; K = 1024; N = 1024; dst = (bf16_t*)(ws + W_WO) + (size_t)l * 1024 * 1024; }
    const int nkt = K / 64, kt = r % nkt, nb = r / nkt;
    transpose_tile(W, K, N, dst, nb * 256, kt * 64, mode, Nh, gain);
  }
}

__device__ __forceinline__ void s5_matrices(const Params& p, int l, int g) {
  float* L = (float*)shm;
  float* apr = L;
  float* api = apr + 64 * 17;
  float* bbr = api + 64 * 17;
  float* bbi = bbr + 1024;
  float* ccr = bbi + 1024;
  float* cci = ccr + 1024;
  float* fre = cci + 1024;
  float* fim = fre + 64;
  float* Kv = fim + 64;
  const int tid = tid_o();
  unsigned char* ws = p.ws;
  const size_t lg = (size_t)l * 64 + g;
  if (tid < 64) {
    const int pp = tid;
    const double dt = exp((double)p.in[11][lg]);
    const double are = p.in[9][lg * 64 + pp], aim = p.in[10][lg * 64 + pp];
    const double mg = exp(are * dt), an = aim * dt, br = mg * cos(an), bi = mg * sin(an);
    { double pr = 1.0, pi = 0.0;
      for (int j = 0; j <= 16; ++j) { apr[pp * 17 + j] = (float)pr; api[pp * 17 + j] = (float)pi; const double t = pr * br - pi * bi; pi = pr * bi + pi * br; pr = t; } }
    const double nr = br - 1.0, ni = bi, inv = 1.0 / (are * are + aim * aim);
    fre[pp] = (float)((nr * are + ni * aim) * inv); fim[pp] = (float)((ni * are - nr * aim) * inv);
    float* a16 = (float*)(ws + W_A16) + (lg * 64 + pp) * 2;
    a16[0] = apr[pp * 17 + 16]; a16[1] = api[pp * 17 + 16];
  }
  __syncthreads();
  for (int e = tid; e < 1024; e += 512) {
    const int pp = e >> 4;
    const float br = p.in[12][lg * 1024 + e], bi = p.in[13][lg * 1024 + e];
    bbr[e] = fre[pp] * br - fim[pp] * bi; bbi[e] = fre[pp] * bi + fim[pp] * br;
    ccr[e] = p.in[14][lg * 1024 + e]; cci[e] = p.in[15][lg * 1024 + e];
  }
  __syncthreads();
  for (int e = tid; e < 4096; e += 512) {
    const int j = e >> 8, cp = (e >> 4) & 15, c = e & 15;
    float s = 0.f;
    for (int pp = 0; pp < 64; ++pp) {
      const float xr = ccr[cp * 64 + pp] * apr[pp * 17 + j] - cci[cp * 64 + pp] * api[pp * 17 + j];
      const float xi = ccr[cp * 64 + pp] * api[pp * 17 + j] + cci[cp * 64 + pp] * apr[pp * 17 + j];
      s += xr * bbr[pp * 16 + c] - xi * bbi[pp * 16 + c];
    }
    if (j == 0 && cp == c) s += p.in[16][lg * 16 + c];
    Kv[e] = s;
  }
  __syncthreads();
  bf16_t* bs3 = (bf16_t*)(ws + W_BS3) + ((size_t)l * 16384 + (size_t)g * 256) * 384;
  for (int e = tid; e < 256 * 48; e += 512) {
    const int n = e / 48, k8 = e % 48, t = n >> 4, cp = n & 15;
    float v[8];
    if (k8 < 32) {
      const int s = k8 >> 1, c0 = (k8 & 1) * 8;
#pragma unroll
      for (int i = 0; i < 8; ++i) v[i] = (s <= t) ? Kv[((t - s) * 16 + cp) * 16 + c0 + i] : 0.f;
    } else {
      const int kk = (k8 - 32) * 8;
#pragma unroll
      for (int i = 0; i < 8; ++i) {
        const int q = kk + i, pp = q & 63;
        const float cr = ccr[cp * 64 + pp], ci = cci[cp * 64 + pp], ar = apr[pp * 17 + t + 1], ai = api[pp * 17 + t + 1];
        v[i] = q < 64 ? (cr * ar - ci * ai) : -(cr * ai + ci * ar);
      }
    }
    u32x4 o; o.x = cvt_pk_bf16(v[0], v[1]); o.y = cvt_pk_bf16(v[2], v[3]); o.z = cvt_pk_bf16(v[4], v[5]); o.w = cvt_pk_bf16(v[6], v[7]);
    *(u32x4*)(bs3 + (size_t)n * 384 + k8 * 8) = o;
  }
  bf16_t* bs1 = (bf16_t*)(ws + W_BS1) + ((size_t)l * 8192 + (size_t)(g >> 1) * 256 + (g & 1) * 128) * 512;
  for (int e = tid; e < 128 * 64; e += 512) {
    const int jn = e >> 6, k8 = e & 63, k = k8 * 8, pp = jn & 63;
    float v[8];
    if ((k >> 8) == (g & 1)) {
      const int s = (k & 255) >> 4, c0 = k & 15;
      const float ar = apr[pp * 17 + 15 - s], ai = api[pp * 17 + 15 - s];
#pragma unroll
      for (int i = 0; i < 8; ++i) {
        const float br = bbr[pp * 16 + c0 + i], bi = bbi[pp * 16 + c0 + i];
        v[i] = jn < 64 ? (ar * br - ai * bi) : (ar * bi + ai * br);
      }
    } else {
#pragma unroll
      for (int i = 0; i < 8; ++i) v[i] = 0.f;
    }
    u32x4 o; o.x = cvt_pk_bf16(v[0], v[1]); o.y = cvt_pk_bf16(v[2], v[3]); o.z = cvt_pk_bf16(v[4], v[5]); o.w = cvt_pk_bf16(v[6], v[7]);
    *(u32x4*)(bs1 + (size_t)jn * 512 + k) = o;
  }
  __syncthreads();
}

__device__ __forceinline__ size_t kf_off(int krow, int kvh, int kk, int hh) { return ((((size_t)(krow >> 5) * 4 + kvh) * 4 + kk) * 64 + hh * 32 + (krow & 31)) * 8; }
__device__ __forceinline__ size_t vf_off(int krow, int kvh, int d) {
  const int kin = krow & 15, hh = (kin >> 2) & 1, j = (kin >> 3) * 4 + (kin & 3);
  return ((((size_t)(krow >> 4) * 4 + kvh) * 2 + (d >> 5)) * 64 + hh * 32 + (d & 31)) * 8 + j;
}
__device__ __forceinline__ void cache_phase(const Params& p) {
  unsigned char* ws = p.ws;
  bf16_t* kb = (bf16_t*)(ws + W_KB); bf16_t* vt = (bf16_t*)(ws + W_VT);
  const int gt = bid_o() * 512 + tid_o(), nth = gdim_o() * 512;
  for (int e = gt; e < 32 * 128 * 32; e += nth) {
    const int i = e / (128 * 32), w = (e / 32) % 128, c8 = e % 32, kvh = c8 >> 3, d0 = (c8 & 7) * 8;
    const int krow = KS_BASE + i * 160 + w;
    const float* s = p.in[4] + ((size_t)i * 128 + w) * 256 + c8 * 8;
    const f32x4 a = *(const f32x4*)s, b = *(const f32x4*)(s + 4);
    u32x4 o; o.x = cvt_pk_bf16(a.x, a.y); o.y = cvt_pk_bf16(a.z, a.w); o.z = cvt_pk_bf16(b.x, b.y); o.w = cvt_pk_bf16(b.z, b.w);
    *(u32x4*)(kb + kf_off(krow, kvh, d0 >> 4, (d0 >> 3) & 1)) = o;
  }
  for (int e = gt; e < 32 * 128 * 256; e += nth) {
    const int i = e / (128 * 256), w = (e / 256) % 128, c = e % 256;
    vt[vf_off(KS_BASE + i * 160 + w, c >> 6, c & 63)] = f2bf(p.in[5][e]);
  }
}

template <int MODE>
__device__ __forceinline__ void norm_phase(const Params& p, const float* gain, int nks) {
  unsigned char* ws = p.ws;
  const int lane = tid_o() & 63, wv = tid_o() >> 6;
  bf16_t* ub = (bf16_t*)(ws + W_UB); float* rs = (float*)(ws + W_RS);
  if (MODE == 2) {
    const bf16_t* xb = (const bf16_t*)(ws + W_XB);
    for (int row = (bid_o() * 8 + wv) * 4; row < SPLIT_ROW0; row += gdim_o() * 32) {
      u32x2 raw[4][4];
#pragma unroll
      for (int q = 0; q < 4; ++q)
#pragma unroll
        for (int j = 0; j < 4; ++j) raw[q][j] = *(const u32x2*)(xb + (size_t)(row + q) * D + (lane + 64 * j) * 4);
#pragma unroll
      for (int q = 0; q < 4; ++q) {
        float s = 0.f;
#pragma unroll
        for (int j = 0; j < 4; ++j) { const f32x4 v = unpack4(raw[q][j]); s += (v.x * v.x + v.y * v.y) + (v.z * v.z + v.w * v.w); }
        const float r = rsqrtf(wave_sum(s, lane) * (1.f / D) + 1e-6f);
        if (lane == 0) rs[row + q] = r;
      }
    }
  }
  for (int row = ((MODE == 3 || MODE == 2) ? SPLIT_ROW0 : 0) + bid_o() * 8 + wv; row < R_PAD; row += gdim_o() * 8) {
    float* xr = xrow_ptr(p, row);
    f32x4 v[4];
    if (MODE == 0) {
      const float* src = xsrc_ptr(p, row);
#pragma unroll
      for (int j = 0; j < 4; ++j) v[j] = src ? *(const f32x4*)(src + (lane + 64 * j) * 4) : (f32x4){0.f, 0.f, 0.f, 0.f};
    } else {
      bf16_t* xbr = (bf16_t*)(ws + W_XB) + (size_t)row * D;
#pragma unroll
      for (int j = 0; j < 4; ++j) v[j] = unpack4(*(const u32x2*)(xbr + (lane + 64 * j) * 4));
      if (nks > 0 && row >= SPLIT_ROW0) {
        const float* pp = (const float*)(ws + W_PART) + (size_t)(row - SPLIT_ROW0) * D + lane * 4;
        for (int k = 0; k < nks; k += 4) {
          f32x4 t[4][4];
#pragma unroll
          for (int kk = 0; kk < 4; ++kk)
#pragma unroll
            for (int j = 0; j < 4; ++j) t[kk][j] = (k + kk < nks) ? *(const f32x4*)(pp + (size_t)(k + kk) * SPLIT_ROWS * D + 256 * j) : (f32x4){0.f, 0.f, 0.f, 0.f};
#pragma unroll
          for (int kk = 0; kk < 4; ++kk)
#pragma unroll
            for (int j = 0; j < 4; ++j) v[j] += t[kk][j];
        }
        if (MODE == 3) {
#pragma unroll
          for (int j = 0; j < 4; ++j) *(f32x4*)(xr + (lane + 64 * j) * 4) = v[j];
        } else {
#pragma unroll
          for (int j = 0; j < 4; ++j) { u32x2 o; o.x = cvt_pk_bf16(v[j].x, v[j].y); o.y = cvt_pk_bf16(v[j].z, v[j].w); *(u32x2*)(xbr + (lane + 64 * j) * 4) = o; }
        }
      }
    }
    if (MODE == 3) continue;
    float s = 0.f;
#pragma unroll
    for (int j = 0; j < 4; ++j) s += (v[j].x * v[j].x + v[j].y * v[j].y) + (v[j].z * v[j].z + v[j].w * v[j].w);
    const float r = rsqrtf(wave_sum(s, lane) * (1.f / D) + 1e-6f);
    if (MODE == 2) {
      if (lane == 0) rs[row] = r;
    }
    else {
#pragma unroll
      for (int j = 0; j < 4; ++j) {
        const f32x4 gg = *(const f32x4*)(gain + (lane + 64 * j) * 4);
        u32x2 o; o.x = cvt_pk_bf16(v[j].x * r * gg.x, v[j].y * r * gg.y); o.y = cvt_pk_bf16(v[j].z * r * gg.z, v[j].w * r * gg.w);
        *(u32x2*)(ub + (size_t)row * D + (lane + 64 * j) * 4) = o;
      }
    }
  }
}

__device__ __forceinline__ void s2_phase(const Params& p, int l) {
  unsigned char* ws = p.ws;
  const float* sb = (const float*)(ws + W_SB); bf16_t* hin = (bf16_t*)(ws + W_HIN);
  const int lane = tid_o() & 63, wv = tid_o() >> 6;
  float* ex = (float*)shm;
  constexpr int SEG = 129;
  for (int item = bid_o(); item < 128; item += gdim_o()) {
    const int b = item >> 6, g = item & 63;
    const float* a16 = (const float*)(ws + W_A16) + (((size_t)l * 64 + g) * 64 + lane) * 2;
    const float ar = a16[0], ai = a16[1];
    const int c0 = wv * SEG, c1 = (c0 + SEG) < 1025 ? (c0 + SEG) : 1025;
    const float* sp = sb + (size_t)(b * 1025) * 8192 + g * 128 + lane;
    bf16_t* hp = hin + (size_t)(b * 1025) * 8192 + g * 128 + lane;
    float hr = 0.f, hi = 0.f;
    {
      int c = c0;
      float sr[8], si[8], pr[8], pi[8];
      if (c + 8 <= c1) {
#pragma unroll
        for (int u = 0; u < 8; ++u) { sr[u] = sp[(size_t)(c + u) * 8192]; si[u] = sp[(size_t)(c + u) * 8192 + 64]; }
      }
      for (; c + 8 <= c1; c += 8) {
        const bool more = c + 16 <= c1;
        if (more) {
#pragma unroll
          for (int u = 0; u < 8; ++u) { pr[u] = sp[(size_t)(c + 8 + u) * 8192]; pi[u] = sp[(size_t)(c + 8 + u) * 8192 + 64]; }
        }
#pragma unroll
        for (int u = 0; u < 8; ++u) { const float nr = ar * hr - ai * hi + sr[u], ni = ar * hi + ai * hr + si[u]; hr = nr; hi = ni; }
#pragma unroll
        for (int u = 0; u < 8; ++u) { sr[u] = pr[u]; si[u] = pi[u]; }
      }
      for (; c < c1; ++c) { const float sr = sp[(size_t)c * 8192], si = sp[(size_t)c * 8192 + 64]; const float nr = ar * hr - ai * hi + sr, ni = ar * hi + ai * hr + si; hr = nr; hi = ni; }
    }
    ex[(wv * 2) * 64 + lane] = hr; ex[(wv * 2 + 1) * 64 + lane] = hi;
    float qr = ar, qi = ai;
#pragma unroll
    for (int s = 0; s < 7; ++s) { const float t = qr * qr - qi * qi; qi = 2.f * qr * qi; qr = t; }
    { const float t = qr * ar - qi * ai; qi = qr * ai + qi * ar; qr = t; }
    __syncthreads();
    hr = 0.f; hi = 0.f;
    for (int j = 0; j < wv; ++j) { const float er = ex[(j * 2) * 64 + lane], ei = ex[(j * 2 + 1) * 64 + lane]; const float nr = qr * hr - qi * hi + er, ni = qr * hi + qi * hr + ei; hr = nr; hi = ni; }
    {
      int c = c0;
      float sr[8], si[8], pr[8], pi[8];
      if (c + 8 <= c1) {
#pragma unroll
        for (int u = 0; u < 8; ++u) { sr[u] = sp[(size_t)(c + u) * 8192]; si[u] = sp[(size_t)(c + u) * 8192 + 64]; }
      }
      for (; c + 8 <= c1; c += 8) {
        const bool more = c + 16 <= c1;
        if (more) {
#pragma unroll
          for (int u = 0; u < 8; ++u) { pr[u] = sp[(size_t)(c + 8 + u) * 8192]; pi[u] = sp[(size_t)(c + 8 + u) * 8192 + 64]; }
        }
#pragma unroll
        for (int u = 0; u < 8; ++u) {
          hp[(size_t)(c + u) * 8192] = f2bf(hr); hp[(size_t)(c + u) * 8192 + 64] = f2bf(hi);
          const float nr = ar * hr - ai * hi + sr[u], ni = ar * hi + ai * hr + si[u]; hr = nr; hi = ni;
        }
#pragma unroll
        for (int u = 0; u < 8; ++u) { sr[u] = pr[u]; si[u] = pi[u]; }
      }
      for (; c < c1; ++c) {
        const float sr = sp[(size_t)c * 8192], si = sp[(size_t)c * 8192 + 64];
        hp[(size_t)c * 8192] = f2bf(hr); hp[(size_t)c * 8192 + 64] = f2bf(hi);
        const float nr = ar * hr - ai * hi + sr, ni = ar * hi + ai * hr + si; hr = nr; hi = ni;
      }
    }
    if (wv == 7) {
      p.out[O_PRE + (((size_t)l * NB + b) * 64 + g) * 64 + lane] = hr; p.out[O_PIM + (((size_t)l * NB + b) * 64 + g) * 64 + lane] = hi;
    }
    __syncthreads();
  }
  for (int q = bid_o() * 8 + wv; q < 2048; q += gdim_o() * 8) {
    const int i = q >> 6, g = q & 63, c0 = 2050 + 2 * i;
    const size_t so = (((size_t)l * DB + i) * 64 + g) * 64 + lane;
    float hr = p.in[2][so], hi = p.in[3][so];
    const float* a16 = (const float*)(ws + W_A16) + (((size_t)l * 64 + g) * 64 + lane) * 2;
    const float ar = a16[0], ai = a16[1];
    const float* sp = sb + (size_t)c0 * 8192 + g * 128 + lane;
    bf16_t* hp = hin + (size_t)c0 * 8192 + g * 128 + lane;
#pragma unroll
    for (int c = 0; c < 2; ++c) {
      const float sr = sp[(size_t)c * 8192], si = sp[(size_t)c * 8192 + 64];
      hp[(size_t)c * 8192] = f2bf(hr); hp[(size_t)c * 8192 + 64] = f2bf(hi);
      const float nr = ar * hr - ai * hi + sr, ni = ar * hi + ai * hr + si; hr = nr; hi = ni;
    }
    p.out[O_SRE + so] = hr; p.out[O_SIM + so] = hi;
  }
}

__device__ __forceinline__ void kvfin_phase(const Params& p) {
  unsigned char* ws = p.ws;
  const float* kv = (const float*)(ws + W_KVRAW); bf16_t* kb = (bf16_t*)(ws + W_KB); bf16_t* vt = (bf16_t*)(ws + W_VT);
  const int lane = tid_o() & 63, wv = tid_o() >> 6;
  for (int row = bid_o() * 8 + wv; row < R_REAL; row += gdim_o() * 8) {
    const float* src = kv + (size_t)row * 512 + lane * 8;
    const f32x4 a = *(const f32x4*)src, b = *(const f32x4*)(src + 4);
    float v[8] = {a.x, a.y, a.z, a.w, b.x, b.y, b.z, b.w};
    const int col = (lane & 31) * 8, kvh = col >> 6, d0 = col & 63;
    int krow; float* ok = nullptr; float* ov = nullptr;
    if (row < R_SAMPLE) { const int b_ = row >> 14, t = row & 16383; krow = row;
      if (t >= SEQ - 128) { ok = p.out + O_PK + ((size_t)b_ * 128 + (t - (SEQ - 128))) * 256; ov = p.out + O_PV + ((size_t)b_ * 128 + (t - (SEQ - 128))) * 256; } }
    else if (row < R_META) { const int q = row - R_SAMPLE, i = q >> 5, j = q & 31; krow = KS_BASE + i * 160 + 128 + j;
      ok = p.out + O_SK + (size_t)q * 256; ov = p.out + O_SV + (size_t)q * 256; }
    else { krow = KM_BASE + (row - R_META); }
    if (lane < 32) {
      float s = 0.f;
#pragma unroll
      for (int i = 0; i < 8; ++i) s += v[i] * v[i];
      s += shx(s, 1, lane); s += shx(s, 2, lane); s += shx(s, 4, lane);
      const float r = rsqrtf(s * (1.f / 64.f) + 1e-6f);
#pragma unroll
      for (int i = 0; i < 8; ++i) v[i] = v[i] * r * p.in[22][d0 + i];
      u32x4 o; o.x = cvt_pk_bf16(v[0], v[1]); o.y = cvt_pk_bf16(v[2], v[3]); o.z = cvt_pk_bf16(v[4], v[5]); o.w = cvt_pk_bf16(v[6], v[7]);
      *(u32x4*)(kb + kf_off(krow, kvh, d0 >> 4, (d0 >> 3) & 1)) = o;
      if (ok) { *(f32x4*)(ok + col) = (f32x4){v[0], v[1], v[2], v[3]}; *(f32x4*)(ok + col + 4) = (f32x4){v[4], v[5], v[6], v[7]}; }
    } else {
      float s = 0.f; s += shx(s, 1, lane); s += shx(s, 2, lane); s += shx(s, 4, lane);
#pragma unroll
      for (int i = 0; i < 8; ++i) vt[vf_off(krow, kvh, d0 + i)] = f2bf(v[i]);
      if (ov) { *(f32x4*)(ov + col) = (f32x4){v[0], v[1], v[2], v[3]}; *(f32x4*)(ov + col + 4) = (f32x4){v[4], v[5], v[6], v[7]}; }
    }
  }
}

__device__ __forceinline__ int rel_bucket(int rel) {
  const int n = rel < 0 ? -rel : rel;
  const float nf = (float)(n < 1 ? 1 : n);
  int large = 8 + (int)(logf(nf / 8.f) / 2.772588722239781f * 8.f);
  large = large < 15 ? large : 15;
  return (rel > 0 ? 16 : 0) + (n < 8 ? n : large);
}

struct AttnItem { int kvh, nt_band, ktile0, sj0, tpos, qrow0, qi0, head; bool active; };
__device__ __forceinline__ AttnItem attn_item(int item, int wv) {
  AttnItem a;
  if (item < 2048) {
    const int b = item >> 10, n = (item >> 2) & 255; a.kvh = item & 3; a.head = a.kvh * 4 + (wv >> 1); const int qt = wv & 1;
    a.qi0 = qt * 32; a.qrow0 = b * SEQ + n * 64 + a.qi0; a.tpos = n * 64 + a.qi0;
    const int c0 = n >= 2 ? n - 2 : 0;
    a.nt_band = (n - c0 + 1) * 2;
    a.ktile0 = (b * SEQ + c0 * 64) >> 5;
    a.sj0 = n >= 2 ? 0 : (2 - n) * 64; a.active = true;
  } else {
    const int q = item - 2048, i = q >> 2; a.kvh = q & 3; a.head = a.kvh * 4 + (wv & 3); a.active = wv < 4;
    a.qi0 = 0; a.qrow0 = R_SAMPLE + i * 32; a.tpos = 1024; a.nt_band = 5;
    a.ktile0 = (KS_BASE + i * 160) >> 5; a.sj0 = 0;
  }
  return a;
}
constexpr int AT_BUF0 = 16896, AT_KV = 28672, AT_BUF = 2 * AT_KV;
__device__ __forceinline__ void attn_stage(const bf16_t* kb, const bf16_t* vt, int item, int buf, int wv, int lane) {
  const AttnItem a = attn_item(item, 0);
  LAS unsigned char* lds = (LAS unsigned char*)shm + AT_BUF0 + buf * AT_BUF;
#pragma unroll
  for (int t = 0; t < 7; ++t) {
    if (t <= a.nt_band) {
      const int T = t == 0 ? (KM_BASE >> 5) : a.ktile0 + (t - 1);
      const bf16_t* src; unsigned dst;
      if (wv < 4) { src = kb + ((((size_t)T * 4 + a.kvh) * 4 + wv) * 64 + lane) * 8; dst = t * 4096 + wv * 1024; }
      else { const int s = (wv - 4) >> 1, dt = (wv - 4) & 1; src = vt + (((((size_t)T * 2 + s) * 4 + a.kvh) * 2 + dt) * 64 + lane) * 8; dst = AT_KV + t * 4096 + (wv - 4) * 1024; }
      __builtin_amdgcn_global_load_lds((const unsigned*)src, (LAS unsigned*)(lds + dst), 16, 0, 0);
    }
  }
}

__device__ __forceinline__ void attn_phase(const Params& p, int jl) {
  unsigned char* ws = p.ws;
  float* lut = (float*)shm;
  float* qg = lut + 16 * 256;
  for (int e = tid_o(); e < 16 * 256; e += 512) {
    const int h = e >> 8, idx = e & 255; const int rel = idx - 191;
    lut[e] = idx < 255 ? p.in[27][rel_bucket(rel) * 16 + h] * 1.44269504089f : 0.f;
  }
  if (tid_o() < 64) qg[tid_o()] = p.in[24][jl * 64 + tid_o()] * (0.125f * 1.44269504089f);
  const bf16_t* qb = (const bf16_t*)(ws + W_UB); const bf16_t* kb = (const bf16_t*)(ws + W_KB); const bf16_t* vt = (const bf16_t*)(ws + W_VT);
  bf16_t* ao = (bf16_t*)(ws + W_YG);
  const int tid = tid_o(), lane = tid & 63, wv = __builtin_amdgcn_readfirstlane(tid >> 6), ql = lane & 31, hh = lane >> 5;
  const int G = gdim_o(), item0 = bid_o(), NITEM = 2048 + 128;
  u32x4 qraw[4];
  if (item0 < NITEM) {
    attn_stage(kb, vt, item0, 0, wv, lane);
    const AttnItem a = attn_item(item0, wv);
    const bf16_t* qp = qb + (size_t)(a.qrow0 + ql) * D + a.head * 64 + hh * 8;
#pragma unroll
    for (int kk = 0; kk < 4; ++kk) qraw[kk] = *(const u32x4*)(qp + kk * 16);
  }
  int cur = 0;
  unsigned opk[16]; bf16_t* obase = nullptr;
#pragma unroll
  for (int r = 0; r < 16; ++r) opk[r] = 0u;
#pragma unroll 1
  for (int item = item0; item < NITEM; item += G, cur ^= 1) {
    asm volatile("s_waitcnt vmcnt(0)" ::: "memory");
    __syncthreads();
    const AttnItem a = attn_item(item, wv);
    u32x4 qcur[4];
#pragma unroll
    for (int kk = 0; kk < 4; ++kk) qcur[kk] = qraw[kk];
    if (item + G < NITEM) {
      attn_stage(kb, vt, item + G, cur ^ 1, wv, lane);
      const AttnItem an = attn_item(item + G, wv);
      const bf16_t* qp = qb + (size_t)(an.qrow0 + ql) * D + an.head * 64 + hh * 8;
#pragma unroll
      for (int kk = 0; kk < 4; ++kk) qraw[kk] = *(const u32x4*)(qp + kk * 16);
    }
    if (obase) {
#pragma unroll
      for (int r = 0; r < 16; ++r) { bf16_t* op = obase + (size_t)(8 * (r >> 2) + 4 * hh + (r & 3)) * D; op[0] = (bf16_t)(opk[r] & 0xffffu); op[32] = (bf16_t)(opk[r] >> 16); }
      obase = nullptr;
    }
    if (!a.active) continue;
    const int head = a.head, nt_band = a.nt_band, sj0 = a.sj0, qi0 = a.qi0, tpos = a.tpos, qrow0 = a.qrow0;
    const LAS unsigned char* kl = (const LAS unsigned char*)shm + AT_BUF0 + cur * AT_BUF + lane * 16;
    bf16x8 qf[4];
    {
      float qv[32]; float s = 0.f;
#pragma unroll
      for (int kk = 0; kk < 4; ++kk) {
        const unsigned w[4] = {qcur[kk].x, qcur[kk].y, qcur[kk].z, qcur[kk].w};
#pragma unroll
        for (int i = 0; i < 4; ++i) { qv[kk * 8 + 2 * i] = bf2f(w[i] & 0xffffu); qv[kk * 8 + 2 * i + 1] = bf2f(w[i] >> 16); }
      }
#pragma unroll
      for (int i = 0; i < 32; ++i) s += qv[i] * qv[i];
      s += shx(s, 32, lane);
      const float r = rsqrtf(s * (1.f / 64.f) + 1e-6f);
#pragma unroll
      for (int kk = 0; kk < 4; ++kk) {
        u32x4 o; const float* g8 = qg + kk * 16 + hh * 8;
        o.x = cvt_pk_bf16(qv[kk * 8 + 0] * r * g8[0], qv[kk * 8 + 1] * r * g8[1]); o.y = cvt_pk_bf16(qv[kk * 8 + 2] * r * g8[2], qv[kk * 8 + 3] * r * g8[3]);
        o.z = cvt_pk_bf16(qv[kk * 8 + 4] * r * g8[4], qv[kk * 8 + 5] * r * g8[5]); o.w = cvt_pk_bf16(qv[kk * 8 + 6] * r * g8[6], qv[kk * 8 + 7] * r * g8[7]);
        qf[kk] = __builtin_bit_cast(bf16x8, o);
      }
    }
    f32x16 sc[7];
#pragma unroll
    for (int t = 0; t < 7; ++t) {
      if (t <= nt_band) {
        f32x16 a_ = {0.f, 0.f, 0.f, 0.f, 0.f, 0.f, 0.f, 0.f, 0.f, 0.f, 0.f, 0.f, 0.f, 0.f, 0.f, 0.f};
#pragma unroll
        for (int kk = 0; kk < 4; ++kk) {
          const bf16x8 kf = *(const LAS bf16x8*)(kl + t * 4096 + kk * 1024);
          a_ = __builtin_amdgcn_mfma_f32_32x32x16_bf16(kf, qf[kk], a_, 0, 0, 0);
        }
        sc[t] = a_;
      }
    }
    const float sink = p.in[25][jl * 16 + head] * 1.44269504089f;
    const float* lh = lut + head * 256 + 191;
    float mx = sink;
    const int qi = qi0 + ql;
#pragma unroll
    for (int t = 0; t < 7; ++t) {
      if (t <= nt_band) {
#pragma unroll
        for (int r = 0; r < 16; ++r) {
          const int key = 8 * (r >> 2) + 4 * hh + (r & 3);
          float v;
          if (t == 0) {
            if (r < 8) { int rel = key - 16 - (tpos + ql); rel = rel < -191 ? -191 : rel; v = sc[t][r] + lh[rel]; } else v = -1e30f;
          } else {
            const int rel = sj0 + (t - 1) * 32 + key - 128 - qi;
            v = sc[t][r] + lh[rel];
          }
          sc[t][r] = v; mx = fmaxf(mx, v);
        }
      }
    }
    mx = fmaxf(mx, shx(mx, 32, lane));
    float sum = 0.f;
#pragma unroll
    for (int t = 0; t < 7; ++t) {
      if (t <= nt_band) {
#pragma unroll
        for (int r = 0; r < 16; ++r) { const float e = __builtin_amdgcn_exp2f(sc[t][r] - mx); sc[t][r] = e; sum += e; }
      }
    }
    sum += shx(sum, 32, lane);
    const float inv = 1.f / (sum + __builtin_amdgcn_exp2f(sink - mx));
    f32x16 o0 = {0.f, 0.f, 0.f, 0.f, 0.f, 0.f, 0.f, 0.f, 0.f, 0.f, 0.f, 0.f, 0.f, 0.f, 0.f, 0.f}, o1 = o0;
#pragma unroll
    for (int t = 0; t < 7; ++t) {
      if (t <= nt_band) {
#pragma unroll
        for (int s = 0; s < 2; ++s) {
          if (t == 0 && s == 1) continue;
          u32x4 pa; pa.x = cvt_pk_bf16(sc[t][8 * s + 0] * inv, sc[t][8 * s + 1] * inv); pa.y = cvt_pk_bf16(sc[t][8 * s + 2] * inv, sc[t][8 * s + 3] * inv);
          pa.z = cvt_pk_bf16(sc[t][8 * s + 4] * inv, sc[t][8 * s + 5] * inv); pa.w = cvt_pk_bf16(sc[t][8 * s + 6] * inv, sc[t][8 * s + 7] * inv);
          const bf16x8 pf = __builtin_bit_cast(bf16x8, pa);
          const bf16x8 b0 = *(const LAS bf16x8*)(kl + AT_KV + t * 4096 + s * 2048), b1 = *(const LAS bf16x8*)(kl + AT_KV + t * 4096 + s * 2048 + 1024);
          o0 = __builtin_amdgcn_mfma_f32_32x32x16_bf16(pf, b0, o0, 0, 0, 0);
          o1 = __builtin_amdgcn_mfma_f32_32x32x16_bf16(pf, b1, o1, 0, 0, 0);
        }
      }
    }
#pragma unroll
    for (int r = 0; r < 16; ++r) opk[r] = cvt_pk_bf16(o0[r], o1[r]);
    obase = ao + (size_t)qrow0 * D + head * 64 + ql;
  }
  if (obase) {
#pragma unroll
    for (int r = 0; r < 16; ++r) { bf16_t* op = obase + (size_t)(8 * (r >> 2) + 4 * hh + (r & 3)) * D; op[0] = (bf16_t)(opk[r] & 0xffffu); op[32] = (bf16_t)(opk[r] >> 16); }
  }
  asm volatile("s_waitcnt vmcnt(0)" ::: "memory");
  __syncthreads();
}

__global__ void __launch_bounds__(512) fwd_megakernel(Params p) {
  cg::grid_group grid = cg::this_grid();
  unsigned char* ws = p.ws;
  volatile LAS unsigned* xst = (volatile LAS unsigned*)((LAS unsigned char*)shm + XB_LDS_OFF);
  if (threadIdx.x < 4) xst[threadIdx.x] = 0u;
  __syncthreads();
  (void)xcd_barrier_post((unsigned*)(ws + W_BAR), xst);
  for (int it = bid_o(); it < 128; it += gdim_o()) s5_matrices(p, it >> 6, it & 63);
  weights_phase(p);
  cache_phase(p);
  norm_phase<0>(p, p.in[7], 0);
  if (p.ws == nullptr) grid.sync();
  xcd_barrier(p.ws);
#pragma unroll 1
  for (int l = 0; l < 4; ++l) {
    if (l < 2) {
      if (l == 1) { norm_phase<1>(p, p.in[7] + D, 11); xcd_barrier(p.ws); }
      gemm_phase<G_S1>(p, nullptr, 0, (const bf16_t*)(ws + W_BS1) + (size_t)l * 8192 * 512, 8192, 512);
      xcd_barrier(p.ws);
      if (PROBE == 9) { gemm_phase<G_S1>(p, nullptr, 0, (const bf16_t*)(ws + W_BS1) + (size_t)l * 8192 * 512, 8192, 512); xcd_barrier(p.ws); }
      s2_phase(p, l);
      xcd_barrier(p.ws);
      if (PROBE == 3) { s2_phase(p, l); xcd_barrier(p.ws); s2_phase(p, l); xcd_barrier(p.ws); }
      gemm_phase<G_S3>(p, nullptr, 0, (const bf16_t*)(ws + W_BS3) + (size_t)l * 16384 * 384, 16384, 384);
      xcd_barrier(p.ws);
      if (PROBE == 10) { gemm_phase<G_S3>(p, nullptr, 0, (const bf16_t*)(ws + W_BS3) + (size_t)l * 16384 * 384, 16384, 384); xcd_barrier(p.ws); }
      gemm_phase<G_GLU>(p, (const bf16_t*)(ws + W_YG), D, (const bf16_t*)(ws + W_WGLU) + (size_t)l * 2048 * 1024, 2048, 1024, l == 0);
      xcd_barrier(p.ws);
    } else {
      norm_phase<2>(p, nullptr, 11);
      xcd_barrier(p.ws);
      if (l == 2) gemm_phase<G_QKV>(p, (const bf16_t*)(ws + W_XB), D, (const bf16_t*)(ws + W_WQKV), 1536, 1024);
      else gemm_phase<G_QKV>(p, (const bf16_t*)(ws + W_XB), D, (const bf16_t*)(ws + W_WQKV) + (size_t)1536 * 1024, 1024, 1024);
      xcd_barrier(p.ws);
      if (l == 2) { kvfin_phase(p); xcd_barrier(p.ws); }
      attn_phase(p, l - 2);
      xcd_barrier(p.ws);
      if (PROBE == 4) { attn_phase(p, l - 2); xcd_barrier(p.ws); attn_phase(p, l - 2); xcd_barrier(p.ws); }
      gemm_phase<G_RESID>(p, (const bf16_t*)(ws + W_YG), D, (const bf16_t*)(ws + W_WO) + (size_t)(l - 2) * 1024 * 1024, 1024, 1024);
      xcd_barrier(p.ws);
    }
    norm_phase<2>(p, nullptr, l < 2 ? 0 : 4);
    xcd_barrier(p.ws);
    gemm_phase<G_FFIN>(p, (const bf16_t*)(ws + W_XB), D, (const bf16_t*)(ws + W_WIN) + (size_t)l * 5632 * 1024, 5632, 1024);
    xcd_barrier(p.ws);
    if (PROBE == 1) { gemm_phase<G_FFIN>(p, (const bf16_t*)(ws + W_XB), D, (const bf16_t*)(ws + W_WIN) + (size_t)l * 5632 * 1024, 5632, 1024); xcd_barrier(p.ws); }
    if (PROBE == 2) { for (int q = 0; q < 10; ++q) xcd_barrier(p.ws); }
    gemm_phase<G_RESID>(p, (const bf16_t*)(ws + W_HB), FF, (const bf16_t*)(ws + W_WOUT) + (size_t)l * 1024 * FF, 1024, FF, l == 3 ? 2 : 0);
    xcd_barrier(p.ws);
  }
  norm_phase<3>(p, nullptr, 11);
}

extern "C" void kernel_launch(void* const* d_in, const int* in_sizes, int n_in, void* d_out, int out_size, void* d_ws, size_t ws_size, hipStream_t stream) {
  static int grid_blocks = 0;
  if (grid_blocks == 0) {
    if (n_in != 28 || (size_t)out_size != O_END || ws_size < W_END) { fprintf(stderr, "kernel_launch: unexpected shapes (n_in %d out %d ws %zu need %zu)\n", n_in, out_size, ws_size, (size_t)W_END); grid_blocks = -1; return; }
    int dev = 0, cus = 0, per_cu = 0;
    hipGetDevice(&dev);
    hipDeviceGetAttribute(&cus, hipDeviceAttributeMultiprocessorCount, dev);
    if (hipFuncSetAttribute((const void*)fwd_megakernel, hipFuncAttributeMaxDynamicSharedMemorySize, LDS_BYTES) != hipSuccess) { fprintf(stderr, "kernel_launch: hipFuncSetAttribute failed\n"); }
    hipOccupancyMaxActiveBlocksPerMultiprocessor(&per_cu, (const void*)fwd_megakernel, 512, LDS_BYTES);
    if (per_cu < 1) { fprintf(stderr, "kernel_launch: occupancy query says %d blocks/CU\n", per_cu); per_cu = 1; }
    (void)hipGetLastError();
    grid_blocks = cus;
  }
  if (grid_blocks < 0) return;
  if (hipMemsetAsync((char*)d_ws + W_BAR, 0, 4096 * 4, stream) != hipSuccess) { fprintf(stderr, "kernel_launch: memset failed\n"); return; }
  Params p{};
  for (int i = 0; i < 28; ++i) p.in[i] = (const float*)d_in[i];
  p.out = (float*)d_out; p.ws = (unsigned char*)d_ws;
  void* args[] = {&p};
  hipError_t e = hipLaunchCooperativeKernel((const void*)fwd_megakernel, dim3(grid_blocks), dim3(512), args, LDS_BYTES, stream);
  if (e != hipSuccess) fprintf(stderr, "cooperative launch failed: %s (grid %d)\n", hipGetErrorString(e), grid_blocks);
}
```

```cpp
#include <hip/hip_runtime.h>
#include <hip/hip_cooperative_groups.h>
#include <cstdio>
#include <cstdint>
namespace cg = cooperative_groups;

typedef unsigned short bf16_t;
typedef short bf16x8 __attribute__((ext_vector_type(8)));
typedef float f32x4 __attribute__((ext_vector_type(4)));
typedef float f32x16 __attribute__((ext_vector_type(16)));
typedef unsigned u32x4 __attribute__((ext_vector_type(4)));
typedef unsigned u32x2 __attribute__((ext_vector_type(2)));

constexpr int D = 1024, SEQ = 16384, NB = 2, DB = 32, DS = 32, FF = 2816;
constexpr int R_PROMPT = 0, R_SAMPLE = 32768, R_META = 33792, R_REAL = 33808, R_PAD = 34048;
constexpr int NTM = R_PAD / 256;
constexpr int NCH = 2 * 1025 + 64, NCH_PAD = 2304;
constexpr int KROWS = 32768 + 32 * 160 + 16;
constexpr int KS_BASE = 32768, KM_BASE = 32768 + 5120;
constexpr size_t VT_S = (size_t)2 * 4 * 64 * 16384, VT_M = VT_S + (size_t)32 * 4 * 64 * 160;

constexpr size_t O_YP = 0, O_YS = 33554432, O_PRE = O_YS + 1048576, O_PIM = O_PRE + 16384, O_PK = O_PIM + 16384, O_PV = O_PK + 65536,
                 O_SRE = O_PV + 65536, O_SIM = O_SRE + 262144, O_SK = O_SIM + 262144, O_SV = O_SK + 262144, O_END = O_SV + 262144;

constexpr size_t al(size_t x) { return (x + 255) & ~(size_t)255; }
constexpr size_t W_XMETA = 0;
constexpr size_t W_XB = al(W_XMETA + (size_t)256 * D * 4);
constexpr size_t W_RS = al(W_XB + (size_t)R_PAD * D * 2);
constexpr size_t W_UB = al(W_RS + (size_t)R_PAD * 4);
constexpr size_t W_YG = al(W_UB + (size_t)R_PAD * D * 2);
constexpr size_t W_SB = al(W_YG + (size_t)R_PAD * D * 2);
constexpr size_t W_HIN = al(W_SB + (size_t)NCH_PAD * 8192 * 4);
constexpr size_t W_KB = al(W_HIN + (size_t)NCH_PAD * 8192 * 2);
constexpr size_t W_VT = al(W_KB + (size_t)(KROWS + 16) * 256 * 2);
constexpr size_t W_WGLU = al(W_VT + (size_t)(KROWS + 16) * 256 * 2);
constexpr size_t W_WIN = al(W_WGLU + (size_t)2 * 2048 * 1024 * 2);
constexpr size_t W_WOUT = al(W_WIN + (size_t)4 * 5632 * 1024 * 2);
constexpr size_t W_WQKV = al(W_WOUT + (size_t)4 * 1024 * FF * 2);
constexpr size_t W_WO = al(W_WQKV + (size_t)2560 * 1024 * 2);
constexpr size_t W_BS1 = al(W_WO + (size_t)2 * 1024 * 1024 * 2);
constexpr size_t W_BS3 = al(W_BS1 + (size_t)2 * 8192 * 512 * 2);
constexpr size_t W_A16 = al(W_BS3 + (size_t)2 * 16384 * 384 * 2);
constexpr size_t W_BAR = al(W_A16 + (size_t)2 * 64 * 64 * 8);
constexpr size_t W_END = al(W_BAR + (size_t)4096 * 4);
constexpr size_t W_HB = W_UB;
constexpr size_t W_KVRAW = W_SB;
constexpr size_t W_PART = W_UB + (size_t)R_PAD * FF * 2;
constexpr int SPLIT_ROW0 = 32768, SPLIT_ROWS = R_PAD - 32768, SPLIT_PM0 = 128;
static_assert(W_PART + (size_t)11 * SPLIT_ROWS * D * 4 <= W_KB, "partials overlay");
static_assert((size_t)R_PAD * FF * 2 <= W_HIN - W_UB, "hb overlay");
static_assert((size_t)R_PAD * 512 * 4 <= W_HIN - W_SB, "kvraw overlay");
static_assert(W_END <= (size_t)512 * 1024 * 1024, "workspace");

constexpr int LDS_BYTES = 147456;
constexpr int XB_LDS_OFF = LDS_BYTES - 16;
constexpr int PROBE = 0;

struct Params {
  const float* in[28];
  float* out;
  unsigned char* ws;
};

extern __shared__ __attribute__((aligned(16))) unsigned char shm[];

__device__ __forceinline__ unsigned cvt_pk_bf16(float lo, float hi) { unsigned r; asm volatile("v_cvt_pk_bf16_f32 %0, %1, %2" : "=v"(r) : "v"(lo), "v"(hi)); return r; }
__device__ __forceinline__ bf16_t f2bf(float f) { return (bf16_t)(cvt_pk_bf16(f, 0.f) & 0xffffu); }
__device__ __forceinline__ float bf2f(unsigned b) { return __uint_as_float(b << 16); }
__device__ __forceinline__ f32x4 unpack4(u32x2 r) { return (f32x4){__uint_as_float(r.x << 16), __uint_as_float(r.x & 0xffff0000u), __uint_as_float(r.y << 16), __uint_as_float(r.y & 0xffff0000u)}; }
__device__ __forceinline__ float shx(float v, int o, int lane) { return __int_as_float(__builtin_amdgcn_ds_bpermute((lane ^ o) << 2, __float_as_int(v))); }
__device__ __forceinline__ float wave_sum(float v, int lane) {
#pragma unroll
  for (int o = 1; o < 64; o <<= 1) v += shx(v, o, lane);
  return v;
}
__device__ __forceinline__ int tid_o() { int t = threadIdx.x; asm volatile("" : "+v"(t)); return t; }
__device__ __forceinline__ int bid_o() { int b = blockIdx.x; asm volatile("" : "+s"(b)); return b; }
__device__ __forceinline__ int gdim_o() { int b = gridDim.x; asm volatile("" : "+s"(b)); return b; }
__device__ __forceinline__ float sigmoidf_(float x) { return __builtin_amdgcn_rcpf(1.f + __expf(-x)); }
__device__ __forceinline__ float gelu_tanh(float x) {
  const float x2 = x * x;
  const float w = x * (-2.302208198f - 0.102943242f * x2);
  return x * __builtin_amdgcn_rcpf(1.f + __builtin_amdgcn_exp2f(w));
}
__device__ __forceinline__ float* xrow_ptr(const Params& p, int row) {
  return row < R_META ? p.out + (size_t)row * D : (float*)(p.ws + W_XMETA) + (size_t)(row - R_META) * D;
}
__device__ __forceinline__ const float* xsrc_ptr(const Params& p, int row) {
  return row < R_SAMPLE ? p.in[0] + (size_t)row * D : row < R_META ? p.in[1] + (size_t)(row - R_SAMPLE) * D : row < R_REAL ? p.in[6] + (size_t)(row - R_META) * D : nullptr;
}
__device__ __forceinline__ int chunk_row(int cgi) {
  if (cgi >= NCH) cgi = 0;
  if (cgi < 2050) { const int b = cgi >= 1025 ? 1 : 0; const int c = cgi - b * 1025; return c == 0 ? R_META : b * SEQ + (c - 1) * 16; }
  return R_SAMPLE + (cgi - 2050) * 16;
}

#define LAS __attribute__((address_space(3)))
constexpr int BM = 256, BK = 64, HALF = 128, HTB = HALF * BK * 2;
__device__ __forceinline__ int lds_byte(int r, int c) {
  int st = (r >> 4) * 2 + (c >> 5), rr = r & 15, cc = c & 31, ob = rr * 64 + cc * 2;
  return st * 1024 + (ob ^ (((ob >> 9) & 1) << 5));
}
__device__ __forceinline__ void stage_rc(int b, int& R, int& C) {
  int st = b / 1024, sb = b % 1024, swz = sb ^ (((sb >> 9) & 1) << 5);
  R = (st >> 1) * 16 + swz / 64; C = (st & 1) * 32 + (swz % 64) / 2;
}

typedef f32x4 acc_t[2][2][4][2];

struct ARow {
  const char* base; unsigned hstep; unsigned voff[2];
  __device__ __forceinline__ void init(const bf16_t* A, int lda, int brow) {
    base = (const char*)(A + (size_t)brow * lda); hstep = (unsigned)HALF * lda * 2u;
#pragma unroll
    for (int i = 0; i < 2; ++i) { int R, C; stage_rc(tid_o() * 16 + i * 8192, R, C); voff[i] = (unsigned)(R * lda + C) * 2u; }
  }
  __device__ __forceinline__ const char* ptr(int h, int i, int kt) const { return base + (size_t)h * hstep + (size_t)kt * 128 + voff[i]; }
};
struct AS1 {
  const char* ub; unsigned voff[2][2]; int pn;
  __device__ __forceinline__ void init(const bf16_t* u, int brow, int pn_) {
    ub = (const char*)u; pn = pn_;
#pragma unroll
    for (int h = 0; h < 2; ++h)
#pragma unroll
      for (int i = 0; i < 2; ++i) { int R, C; stage_rc(tid_o() * 16 + i * 8192, R, C);
        voff[h][i] = (unsigned)(chunk_row(brow + h * 128 + R) + (C >> 4)) * 2048u + (unsigned)(C & 15) * 2u; }
  }
  __device__ __forceinline__ const char* ptr(int h, int i, int kt) const { return ub + (size_t)((pn * 2 + (kt >> 2)) * 32 + (kt & 3) * 8192) + voff[h][i]; }
};
struct AS3 {
  const char* ub; const char* hin; unsigned voffu[2][2], voffh[2][2]; int g;
  __device__ __forceinline__ void init(const bf16_t* u, const bf16_t* hn, int brow, int g_) {
    ub = (const char*)u; hin = (const char*)hn; g = g_;
#pragma unroll
    for (int h = 0; h < 2; ++h)
#pragma unroll
      for (int i = 0; i < 2; ++i) { int R, C; stage_rc(tid_o() * 16 + i * 8192, R, C);
        int cgi = brow + h * 128 + R; if (cgi >= NCH) cgi = 0;
        voffu[h][i] = (unsigned)(chunk_row(cgi) + (C >> 4)) * 2048u + (unsigned)(C & 15) * 2u;
        voffh[h][i] = (unsigned)cgi * 16384u + (unsigned)C * 2u; }
  }
  __device__ __forceinline__ const char* ptr(int h, int i, int kt) const {
    return kt < 4 ? ub + (size_t)(g * 32 + kt * 8192) + voffu[h][i] : hin + (size_t)(g * 256 + (kt - 4) * 128) + voffh[h][i];
  }
};

template <class AF>
__device__ __forceinline__ void gemm_mainloop(acc_t& acc, const AF& A, const bf16_t* Bt, int K, int bcol, int nt) {
  LAS unsigned char* lds = (LAS unsigned char*)shm;
  const int tid = tid_o(), wid = __builtin_amdgcn_readfirstlane(tid >> 6), lane = tid & 63, wr = wid >> 2, wc = wid & 3, fr = lane & 15, fq = lane >> 4;
  unsigned voffB[2];
#pragma unroll
  for (int i = 0; i < 2; ++i) { int R, C; stage_rc(tid * 16 + i * 8192, R, C); voffB[i] = (unsigned)(R * K + C) * 2u; }
  const char* cB = (const char*)(Bt + (size_t)bcol * K);
  const size_t hstepB = (size_t)HALF * K * 2;
  const unsigned ldsw = (unsigned)wid * 1024u;
  const int aoff = lds_byte(wr * 64 + fr, fq * 8), boff = lds_byte(wc * 32 + fr, fq * 8);
#define SA(b, h) (((b) * 2 + (h)) * HTB)
#define SB(b, h) ((4 + (b) * 2 + (h)) * HTB)
#define STAGE_A(bufoff, h, kt) do { _Pragma("unroll") for (int _i = 0; _i < 2; ++_i) \
    __builtin_amdgcn_global_load_lds((const unsigned*)A.ptr(h, _i, kt), (LAS unsigned*)(lds + (bufoff) + ldsw + _i * 8192), 16, 0, 0); } while (0)
#define STAGE_B(bufoff, h, kt) do { _Pragma("unroll") for (int _i = 0; _i < 2; ++_i) \
    __builtin_amdgcn_global_load_lds((const unsigned*)(cB + (size_t)(h) * hstepB + (size_t)(kt) * 128 + voffB[_i]), (LAS unsigned*)(lds + (bufoff) + ldsw + _i * 8192), 16, 0, 0); } while (0)
#define LDA(dst, b, h) do { _Pragma("unroll") for (int m = 0; m < 4; ++m) _Pragma("unroll") for (int k = 0; k < 2; ++k) dst[m][k] = *(const LAS bf16x8*)(lds + SA(b, h) + aoff + m * 2048 + k * 1024); } while (0)
#define LDB(dst, b, h) do { _Pragma("unroll") for (int n = 0; n < 2; ++n) _Pragma("unroll") for (int k = 0; k < 2; ++k) dst[n][k] = *(const LAS bf16x8*)(lds + SB(b, h) + boff + n * 2048 + k * 1024); } while (0)
#define MMA(ai, bj, At_, Bt_) do { __builtin_amdgcn_s_setprio(1); _Pragma("unroll") for (int m = 0; m < 4; ++m) _Pragma("unroll") for (int n = 0; n < 2; ++n) _Pragma("unroll") for (int k = 0; k < 2; ++k) \
      acc[ai][bj][m][n] = __builtin_amdgcn_mfma_f32_16x16x32_bf16(Bt_[n][k], At_[m][k], acc[ai][bj][m][n], 0, 0, 0); \
    __builtin_amdgcn_s_setprio(0); } while (0)
#define WAIT_V(n) asm volatile("s_waitcnt vmcnt(" #n ")" ::: "memory")
#define WAIT_L(n) asm volatile("s_waitcnt lgkmcnt(" #n ")" ::: "memory")
#define BAR __builtin_amdgcn_s_barrier()
#define SCHED __builtin_amdgcn_sched_barrier(0)
#pragma unroll
  for (int a = 0; a < 2; ++a)
#pragma unroll
    for (int b = 0; b < 2; ++b)
#pragma unroll
      for (int m = 0; m < 4; ++m)
#pragma unroll
        for (int n = 0; n < 2; ++n) acc[a][b][m][n] = (f32x4){0.f, 0.f, 0.f, 0.f};
  bf16x8 At[4][2], B0[2][2], B1[2][2];
  STAGE_B(SB(0, 0), 0, 0); STAGE_A(SA(0, 0), 0, 0); STAGE_B(SB(0, 1), 1, 0); STAGE_A(SA(0, 1), 1, 0);
  if (wr == 1) BAR;
  WAIT_V(4); BAR;
  STAGE_B(SB(1, 0), 0, 1); STAGE_A(SA(1, 0), 0, 1); STAGE_B(SB(1, 1), 1, 1);
  WAIT_V(6); BAR;
#pragma unroll 1
  for (int t = 0; t < nt - 2; t += 2) {
    LDB(B0, 0, 0); SCHED; LDA(At, 0, 0); STAGE_A(SA(1, 1), 1, t + 1);
    WAIT_L(8); BAR; WAIT_L(0); MMA(0, 0, At, B0); BAR; SCHED;
    LDB(B1, 0, 1); STAGE_B(SB(0, 0), 0, t + 2);
    BAR; WAIT_L(0); MMA(0, 1, At, B1); BAR;
    LDA(At, 0, 1); STAGE_A(SA(0, 0), 0, t + 2);
    BAR; WAIT_L(0); MMA(1, 0, At, B0); BAR; SCHED;
    STAGE_B(SB(0, 1), 1, t + 2);
    WAIT_V(6); BAR; MMA(1, 1, At, B1); BAR;
    LDB(B0, 1, 0); SCHED; LDA(At, 1, 0); STAGE_A(SA(0, 1), 1, t + 2);
    WAIT_L(8); BAR; WAIT_L(0); MMA(0, 0, At, B0); BAR; SCHED;
    LDB(B1, 1, 1); STAGE_B(SB(1, 0), 0, t + 3);
    BAR; WAIT_L(0); MMA(0, 1, At, B1); BAR;
    LDA(At, 1, 1); STAGE_A(SA(1, 0), 0, t + 3);
    BAR; WAIT_L(0); MMA(1, 0, At, B0); BAR; SCHED;
    STAGE_B(SB(1, 1), 1, t + 3);
    WAIT_V(6); BAR; MMA(1, 1, At, B1); BAR;
  }
  { LDB(B0, 0, 0); LDA(At, 0, 0); STAGE_A(SA(1, 1), 1, nt - 1);
    BAR; WAIT_L(0); MMA(0, 0, At, B0); BAR;
    LDB(B1, 0, 1); BAR; WAIT_L(0); MMA(0, 1, At, B1); BAR;
    LDA(At, 0, 1); WAIT_V(4); BAR; WAIT_L(0); MMA(1, 0, At, B0); MMA(1, 1, At, B1); BAR; }
  { LDB(B0, 1, 0); LDA(At, 1, 0); WAIT_V(2); BAR; WAIT_L(0); MMA(0, 0, At, B0); BAR;
    LDB(B1, 1, 1); WAIT_V(0); BAR; WAIT_L(0); MMA(0, 1, At, B1); BAR;
    LDA(At, 1, 1); BAR; WAIT_L(0); MMA(1, 0, At, B0); MMA(1, 1, At, B1); BAR; }
  if (wr == 0) BAR;
#undef SA
#undef SB
}


#define XB_TMO      128
#define XB_XCNT(j)  (256  + 64 * (j))
#define XB_XSUB(j)  (1280 + 64 * (j))
#define XB_XGEN(j)  (2304 + 64 * (j))
#define XB_TOP      3328
#define XB_TOPGEN   3392
#define XCD_BAR_WORDS 3456
#define XB_SPIN_CAP (1u << 18)
__device__ __forceinline__ unsigned xb_ld(unsigned* p)              { return __hip_atomic_load(p, __ATOMIC_RELAXED, __HIP_MEMORY_SCOPE_AGENT); }
__device__ __forceinline__ unsigned xb_add(unsigned* p, unsigned v) { return __hip_atomic_fetch_add(p, v, __ATOMIC_RELAXED, __HIP_MEMORY_SCOPE_AGENT); }
__device__ __forceinline__ unsigned xb_xcc_id() { return (unsigned)__builtin_amdgcn_s_getreg((3 << 11) | 20) & 0xFu; }
#define XB_SPIN(cond, bar) do { unsigned _sp = 0; while (cond) { __builtin_amdgcn_s_sleep(1); \
    if ((++_sp & 255u) == 0u) { if (xb_ld(&(bar)[XB_TMO])) break; if (_sp > XB_SPIN_CAP) { atomicAdd(&(bar)[XB_TMO], 1u); break; } } } } while (0)
struct XcdBarrier { unsigned* bar; unsigned x; volatile LAS unsigned* st; };
__device__ __forceinline__ XcdBarrier xcd_barrier_post(unsigned* bar, volatile LAS unsigned* st) {
  XcdBarrier b; b.bar = bar; b.x = xb_xcc_id(); b.st = st;
  if (threadIdx.x == 0) (void)xb_add(&bar[XB_XCNT(b.x)], 1u);
  return b;
}
__device__ __forceinline__ void xcd_barrier_complete(unsigned* bar, unsigned x, unsigned& nloc, unsigned& nx) {
  const unsigned G = gridDim.x * gridDim.y * gridDim.z;
  unsigned sum, cnt, mine, sp = 0u;
  for (;;) {
    sum = 0u; cnt = 0u; mine = 0u;
#pragma unroll
    for (unsigned j = 0; j < 16; ++j) { const unsigned c = xb_ld(&bar[XB_XCNT(j)]); sum += c; cnt += (c > 0u) ? 1u : 0u; mine = (j == x) ? c : mine; }
    if (sum == G) break;
    __builtin_amdgcn_s_sleep(1);
    if ((++sp & 255u) == 0u) { if (xb_ld(&bar[XB_TMO])) break; if (sp > XB_SPIN_CAP) { atomicAdd(&bar[XB_TMO], 1u); break; } }
  }
  nloc = mine > 0u ? mine : 1u; nx = cnt > 0u ? cnt : 1u;
}
__device__ __forceinline__ void xcd_barrier(unsigned char* ws_) {
  XcdBarrier b; b.bar = (unsigned*)(ws_ + W_BAR); b.x = xb_xcc_id(); b.st = (volatile LAS unsigned*)((LAS unsigned char*)shm + XB_LDS_OFF);
  asm volatile("s_waitcnt vmcnt(0)" ::: "memory");
  __syncthreads();
  if (threadIdx.x == 0) {
    unsigned* bar = b.bar;
    __builtin_amdgcn_s_waitcnt(0);
    unsigned nloc = b.st[0], nx = b.st[1];
    if (nloc == 0u) { xcd_barrier_complete(bar, b.x, nloc, nx); b.st[0] = nloc; b.st[1] = nx; }
    const unsigned old = xb_add(&bar[XB_XSUB(b.x)], 1u);
    const unsigned gen = old / nloc;
    if (old + 1u == (gen + 1u) * nloc) {
      __builtin_amdgcn_fence(__ATOMIC_RELEASE, "agent");
      asm volatile("s_waitcnt vmcnt(0)" ::: "memory");
      const unsigned og = xb_add(&bar[XB_TOP], 1u);
      const unsigned tg = og / nx;
      if (og + 1u == (tg + 1u) * nx) xb_add(&bar[XB_TOPGEN], 1u);
      else XB_SPIN(xb_ld(&bar[XB_TOPGEN]) == tg, bar);
      __builtin_amdgcn_fence(__ATOMIC_ACQUIRE, "agent");
      xb_add(&bar[XB_XGEN(b.x)], 1u);
      asm volatile("s_waitcnt vmcnt(0)" ::: "memory");
    } else {
      XB_SPIN(xb_ld(&bar[XB_XGEN(b.x)]) == gen, bar);
      __builtin_amdgcn_fence(__ATOMIC_ACQUIRE, "agent");
      asm volatile("s_waitcnt vmcnt(0)" ::: "memory");
    }
  }
  __syncthreads();
}

__device__ __forceinline__ bool tile_at(long L, int nM, int nN, int& pm, int& pn) {
  const int nwg = nM * nN;
  if (L >= nwg) return false;
  int wgid = (int)L;
  { const int q = nwg / 8, r = nwg % 8, xcd = wgid % 8, off = wgid / 8; wgid = (xcd < r ? xcd * (q + 1) : r * (q + 1) + (xcd - r) * q) + off; }
  const int nig = 8 * nN, gid = wgid / nig, fm = gid * 8, gsz = (nM - fm) < 8 ? (nM - fm) : 8;
  pm = fm + ((wgid % nig) % gsz); pn = (wgid % nig) / gsz;
  return true;
}
__device__ __forceinline__ bool tile_next(int it, int nM, int nN, int& pm, int& pn) { return tile_at((long)it * gdim_o() + bid_o(), nM, nN, pm, pn); }

#define EPI_ROWS_BEGIN \
  const int wid = tid_o() >> 6, lane = tid_o() & 63, wr = wid >> 2, wc = wid & 3, fr = lane & 15, fq = lane >> 4; \
  _Pragma("unroll") for (int ai = 0; ai < 2; ++ai) _Pragma("unroll") for (int m = 0; m < 4; ++m) { \
    const int row = brow + ai * 128 + wr * 64 + m * 16 + fr;
#define EPI_ROWS_END }

enum { G_GLU = 0, G_FFIN = 1, G_RESID = 2, G_QKV = 3, G_S1 = 4, G_S3 = 5 };

template <int MODE>
__device__ __forceinline__ void gemm_phase(const Params& p, const bf16_t* A, int lda, const bf16_t* Bt, int N, int K, int first = 0) {
  const int nM = (MODE == G_S1 || MODE == G_S3) ? NCH_PAD / 256 : NTM, nN = N / 256, nt = K / BK;
  unsigned char* ws = p.ws;
  const int G = gdim_o(), ks = nt / 4, nsplit = (NTM - SPLIT_PM0) * nN * ks, nMw = (MODE == G_RESID) ? SPLIT_PM0 : nM;
  const int nfull_it = (nMw * nN + G - 1) / G;
#pragma unroll 1
  for (int it = 0;; ++it) {
    int pm, pn; bool split = false; int kt0 = 0, ntu = nt, ksi = 0;
    if (MODE == G_RESID && it >= nfull_it) {
      const int u = (it - nfull_it) * G + bid_o();
      if (u >= nsplit) break;
      ksi = u % ks; const int tq = u / ks; pn = tq % nN; pm = SPLIT_PM0 + tq / nN;
      split = true; kt0 = ksi * 4; ntu = 4;
    } else if (!tile_next(it, nMw, nN, pm, pn)) { if (MODE == G_RESID) continue; else break; }
    const int brow = pm * 256, bcol = pn * 256;
    float rsv[8];
    if (MODE == G_FFIN || MODE == G_QKV) {
      const int tid_ = tid_o(), wr_ = (tid_ >> 6) >> 2, fr_ = tid_ & 15;
      const float* rsp = (const float*)(ws + W_RS) + brow + wr_ * 64 + fr_;
#pragma unroll
      for (int q = 0; q < 8; ++q) rsv[q] = rsp[(q >> 2) * 128 + (q & 3) * 16];
    }
    acc_t acc;
    if (MODE == G_S1) { AS1 af; af.init((const bf16_t*)(ws + W_UB), brow, pn); gemm_mainloop(acc, af, Bt, K, bcol, nt); }
    else if (MODE == G_S3) { AS3 af; af.init((const bf16_t*)(ws + W_UB), (const bf16_t*)(ws + W_HIN), brow, pn); gemm_mainloop(acc, af, Bt, K, bcol, nt); }
    else { ARow af; af.init(A + kt0 * BK, lda, brow); gemm_mainloop(acc, af, Bt + kt0 * BK, K, bcol, ntu); }
    if (MODE == G_GLU) {
      bf16_t* xb = (bf16_t*)(ws + W_XB);
      EPI_ROWS_BEGIN
        bf16_t* xr = xb + (size_t)row * D;
        const int oc = (bcol >> 1) + wc * 32 + fq * 8;
        f32x4 x0, x1;
        if (first & 1) { const float* xs = xsrc_ptr(p, row); x0 = xs ? *(const f32x4*)(xs + oc) : (f32x4){0.f, 0.f, 0.f, 0.f}; x1 = xs ? *(const f32x4*)(xs + oc + 4) : (f32x4){0.f, 0.f, 0.f, 0.f}; }
        else { const u32x4 raw = *(const u32x4*)(xr + oc); x0 = unpack4((u32x2){raw.x, raw.y}); x1 = unpack4((u32x2){raw.z, raw.w}); }
#pragma unroll
        for (int j = 0; j < 4; ++j) { x0[j] += acc[ai][0][m][0][j] * sigmoidf_(acc[ai][1][m][0][j]); x1[j] += acc[ai][0][m][1][j] * sigmoidf_(acc[ai][1][m][1][j]); }
        u32x4 o; o.x = cvt_pk_bf16(x0[0], x0[1]); o.y = cvt_pk_bf16(x0[2], x0[3]); o.z = cvt_pk_bf16(x1[0], x1[1]); o.w = cvt_pk_bf16(x1[2], x1[3]);
        *(u32x4*)(xr + oc) = o;
      EPI_ROWS_END
    } else if (MODE == G_FFIN) {
      bf16_t* hb = (bf16_t*)(ws + W_HB); const float* rs = (const float*)(ws + W_RS);
      EPI_ROWS_BEGIN
        const float s = rsv[ai * 4 + m];
        const int oc = (bcol >> 1) + wc * 32 + fq * 8;
        float hv[8];
#pragma unroll
        for (int n = 0; n < 2; ++n)
#pragma unroll
          for (int j = 0; j < 4; ++j) { const float gt = acc[ai][0][m][n][j] * s, up = acc[ai][1][m][n][j] * s; hv[n * 4 + j] = gt * sigmoidf_(gt) * up; }
        u32x4 o; o.x = cvt_pk_bf16(hv[0], hv[1]); o.y = cvt_pk_bf16(hv[2], hv[3]); o.z = cvt_pk_bf16(hv[4], hv[5]); o.w = cvt_pk_bf16(hv[6], hv[7]);
        *(u32x4*)(hb + (size_t)row * FF + oc) = o;
      EPI_ROWS_END
    } else if (MODE == G_RESID) {
      bf16_t* xb = (bf16_t*)(ws + W_XB);
      EPI_ROWS_BEGIN
        bf16_t* xr = xb + (size_t)row * D;
#pragma unroll
        for (int bj = 0; bj < 2; ++bj)
#pragma unroll
          for (int n = 0; n < 2; ++n) {
            const int oc = bcol + bj * 128 + wc * 32 + n * 16 + fq * 4;
            if (split) {
              *(f32x4*)((float*)(ws + W_PART) + ((size_t)ksi * SPLIT_ROWS + (row - SPLIT_ROW0)) * D + oc) = acc[ai][bj][m][n];
            } else {
              f32x4 x = unpack4(*(const u32x2*)(xr + oc));
              x += acc[ai][bj][m][n];
              if (first & 2) *(f32x4*)(xrow_ptr(p, row) + oc) = x;
              else { u32x2 o; o.x = cvt_pk_bf16(x[0], x[1]); o.y = cvt_pk_bf16(x[2], x[3]); *(u32x2*)(xr + oc) = o; }
            }
          }
      EPI_ROWS_END
    } else if (MODE == G_QKV) {
      bf16_t* qb = (bf16_t*)(ws + W_UB); float* kv = (float*)(ws + W_KVRAW); const float* rs = (const float*)(ws + W_RS);
      EPI_ROWS_BEGIN
        const float s = rsv[ai * 4 + m];
#pragma unroll
        for (int bj = 0; bj < 2; ++bj)
#pragma unroll
          for (int n = 0; n < 2; ++n) {
            const int oc = bcol + bj * 128 + wc * 32 + n * 16 + fq * 4;
            const f32x4 v = acc[ai][bj][m][n] * s;
            if (bcol < 1024) { u32x2 o; o.x = cvt_pk_bf16(v[0], v[1]); o.y = cvt_pk_bf16(v[2], v[3]); *(u32x2*)(qb + (size_t)row * D + oc) = o; }
            else *(f32x4*)(kv + (size_t)row * 512 + (oc - 1024)) = v;
          }
      EPI_ROWS_END
    } else if (MODE == G_S1) {
      float* sb = (float*)(ws + W_SB);
      EPI_ROWS_BEGIN
#pragma unroll
        for (int bj = 0; bj < 2; ++bj)
#pragma unroll
          for (int n = 0; n < 2; ++n) {
            const int oc = bcol + bj * 128 + wc * 32 + n * 16 + fq * 4;
            *(f32x4*)(sb + (size_t)row * 8192 + oc) = acc[ai][bj][m][n];
          }
      EPI_ROWS_END
    } else if (MODE == G_S3) {
      bf16_t* yg = (bf16_t*)(ws + W_YG);
      EPI_ROWS_BEGIN
        const bool valid = row < NCH && row != 1025;
        const int tr = chunk_row(row);
        if (valid) {
#pragma unroll
          for (int bj = 0; bj < 2; ++bj)
#pragma unroll
            for (int n = 0; n < 2; ++n) {
              const int t = bj * 8 + wc * 2 + n;
              const f32x4 v = acc[ai][bj][m][n];
              u32x2 o; o.x = cvt_pk_bf16(gelu_tanh(v[0]), gelu_tanh(v[1])); o.y = cvt_pk_bf16(gelu_tanh(v[2]), gelu_tanh(v[3]));
              *(u32x2*)(yg + (size_t)(tr + t) * D + pn * 16 + fq * 4) = o;
            }
        }
      EPI_ROWS_END
    }
    __builtin_amdgcn_s_barrier();
  }
}

__device__ __forceinline__ int perm32(int rho) { return 8 * ((rho & 15) >> 2) + 4 * (rho >> 4) + (rho & 3); }
__device__ __forceinline__ int srccol(int np, int mode, int Nh) {
  if (mode == 0) return np;
  const int t256 = np >> 8, r = np & 255, bj = r >> 7, r128 = r & 127, out = t256 * 128 + (r128 & ~31) + perm32(r128 & 31);
  return bj ? Nh + out : out;
}
__device__ __forceinline__ void transpose_tile(const float* W, int K, int N, bf16_t* Wt, int np0, int k0, int mode, int Nh, const float* gain) {
  float* tile = (float*)shm;
  const int tid = tid_o(), c4 = tid & 63, r0 = tid >> 6;
  const int sc = srccol(np0 + c4 * 4, mode, Nh);
  f32x4 v[8];
#pragma unroll
  for (int q = 0; q < 8; ++q) v[q] = *(const f32x4*)(W + (size_t)(k0 + r0 + q * 8) * N + sc);
#pragma unroll
  for (int q = 0; q < 8; ++q) { const int r = r0 + q * 8; const float g = gain ? gain[k0 + r] : 1.f; float* t = tile + r * 257 + c4 * 4; t[0] = v[q].x * g; t[1] = v[q].y * g; t[2] = v[q].z * g; t[3] = v[q].w * g; }
  __syncthreads();
#pragma unroll
  for (int q = 0; q < 4; ++q) {
    const int e = tid + q * 512, n = e & 255, ks = e >> 8;
    const float* s = tile + (ks * 8) * 257 + n;
    u32x4 o; o.x = cvt_pk_bf16(s[0], s[257]); o.y = cvt_pk_bf16(s[2 * 257], s[3 * 257]); o.z = cvt_pk_bf16(s[4 * 257], s[5 * 257]); o.w = cvt_pk_bf16(s[6 * 257], s[7 * 257]);
    *(u32x4*)(Wt + (size_t)(np0 + n) * K + k0 + ks * 8) = o;
  }
  __syncthreads();
}

__device__ __forceinline__ void weights_phase(const Params& p) {
  unsigned char* ws = p.ws;
  const int total = 2 * 128 + 4 * 352 + 4 * 176 + 64 + 32 + 64 + 2 * 64;
  unsigned* qctr = (unsigned*)(ws + W_BAR) + 3600;
  volatile LAS int* qslot = (volatile LAS int*)((LAS unsigned char*)shm + XB_LDS_OFF + 8);
  for (;;) {
    __syncthreads();
    if (tid_o() == 0) *qslot = (int)__hip_atomic_fetch_add(qctr, 1u, __ATOMIC_RELAXED, __HIP_MEMORY_SCOPE_AGENT);
    __syncthreads();
    const int t = *qslot;
    if (t >= total) break;
    int r = t; const float* W; int K, N, mode = 0, Nh = 0; const float* gain = nullptr; bf16_t* dst;
    if (r < 256) { const int l = r / 128; r -= l * 128; W = p.in[17] + (size_t)l * 1024 * 2048; K = 1024; N = 2048; mode = 1; Nh = 1024; dst = (bf16_t*)(ws + W_WGLU) + (size_t)l * 2048 * 1024; }
    else if ((r -= 256) < 1408) { const int l = r / 352; r -= l * 352; W = p.in[18] + (size_t)l * 1024 * 5632; K = 1024; N = 5632; mode = 1; Nh = FF; gain = p.in[8] + l * D; dst = (bf16_t*)(ws + W_WIN) + (size_t)l * 5632 * 1024; }
    else if ((r -= 1408) < 704) { const int l = r / 176; r -= l * 176; W = p.in[19] + (size_t)l * FF * 1024; K = FF; N = 1024; dst = (bf16_t*)(ws + W_WOUT) + (size_t)l * 1024 * FF; }
    else if ((r -= 704) < 64) { W = p.in[23]; K = 1024; N = 1024; gain = p.in[7] + 2 * D; dst = (bf16_t*)(ws + W_WQKV); }
    else if ((r -= 64) < 32) { W = p.in[21]; K = 1024; N = 512; gain = p.in[20]; dst = (bf16_t*)(ws + W_WQKV) + (size_t)1024 * 1024; }
    else if ((r -= 32) < 64) { W = p.in[23] + (size_t)1024 * 1024; K = 1024; N = 1024; gain = p.in[7] + 3 * D; dst = (bf16_t*)(ws + W_WQKV) + (size_t)1536 * 1024; }
    else { r -= 64; const int l = r / 64; r -= l * 64; W = p.in[26] + (size_t)l * 1024 * 1024; K = 1024; N = 1024; dst = (bf16_t*)(ws + W_WO) + (size_t)l * 1024 * 1024; }
    const int nkt = K / 64, kt = r % nkt, nb = r / nkt;
    transpose_tile(W, K, N, dst, nb * 256, kt * 64, mode, Nh, gain);
  }
}

__device__ __forceinline__ void s5_matrices(const Params& p, int l, int g) {
  float* L = (float*)shm;
  float* apr = L;
  float* api = apr + 64 * 17;
  float* bbr = api + 64 * 17;
  float* bbi = bbr + 1024;
  float* ccr = bbi + 1024;
  float* cci = ccr + 1024;
  float* fre = cci + 1024;
  float* fim = fre + 64;
  float* Kv = fim + 64;
  const int tid = tid_o();
  unsigned char* ws = p.ws;
  const size_t lg = (size_t)l * 64 + g;
  if (tid < 64) {
    const int pp = tid;
    const double dt = exp((double)p.in[11][lg]);
    const double are = p.in[9][lg * 64 + pp], aim = p.in[10][lg * 64 + pp];
    const double mg = exp(are * dt), an = aim * dt, br = mg * cos(an), bi = mg * sin(an);
    { double pr = 1.0, pi = 0.0;
      for (int j = 0; j <= 16; ++j) { apr[pp * 17 + j] = (float)pr; api[pp * 17 + j] = (float)pi; const double t = pr * br - pi * bi; pi = pr * bi + pi * br; pr = t; } }
    const double nr = br - 1.0, ni = bi, inv = 1.0 / (are * are + aim * aim);
    fre[pp] = (float)((nr * are + ni * aim) * inv); fim[pp] = (float)((ni * are - nr * aim) * inv);
    float* a16 = (float*)(ws + W_A16) + (lg * 64 + pp) * 2;
    a16[0] = apr[pp * 17 + 16]; a16[1] = api[pp * 17 + 16];
  }
  __syncthreads();
  for (int e = tid; e < 1024; e += 512) {
    const int pp = e >> 4;
    const float br = p.in[12][lg * 1024 + e], bi = p.in[13][lg * 1024 + e];
    bbr[e] = fre[pp] * br - fim[pp] * bi; bbi[e] = fre[pp] * bi + fim[pp] * br;
    ccr[e] = p.in[14][lg * 1024 + e]; cci[e] = p.in[15][lg * 1024 + e];
  }
  __syncthreads();
  for (int e = tid; e < 4096; e += 512) {
    const int j = e >> 8, cp = (e >> 4) & 15, c = e & 15;
    float s = 0.f;
    for (int pp = 0; pp < 64; ++pp) {
      const float xr = ccr[cp * 64 + pp] * apr[pp * 17 + j] - cci[cp * 64 + pp] * api[pp * 17 + j];
      const float xi = ccr[cp * 64 + pp] * api[pp * 17 + j] + cci[cp * 64 + pp] * apr[pp * 17 + j];
      s += xr * bbr[pp * 16 + c] - xi * bbi[pp * 16 + c];
    }
    if (j == 0 && cp == c) s += p.in[16][lg * 16 + c];
    Kv[e] = s;
  }
  __syncthreads();
  bf16_t* bs3 = (bf16_t*)(ws + W_BS3) + ((size_t)l * 16384 + (size_t)g * 256) * 384;
  for (int e = tid; e < 256 * 48; e += 512) {
    const int n = e / 48, k8 = e % 48, t = n >> 4, cp = n & 15;
    float v[8];
    if (k8 < 32) {
      const int s = k8 >> 1, c0 = (k8 & 1) * 8;
#pragma unroll
      for (int i = 0; i < 8; ++i) v[i] = (s <= t) ? Kv[((t - s) * 16 + cp) * 16 + c0 + i] : 0.f;
    } else {
      const int kk = (k8 - 32) * 8;
#pragma unroll
      for (int i = 0; i < 8; ++i) {
        const int q = kk + i, pp = q & 63;
        const float cr = ccr[cp * 64 + pp], ci = cci[cp * 64 + pp], ar = apr[pp * 17 + t + 1], ai = api[pp * 17 + t + 1];
        v[i] = q < 64 ? (cr * ar - ci * ai) : -(cr * ai + ci * ar);
      }
    }
    u32x4 o; o.x = cvt_pk_bf16(v[0], v[1]); o.y = cvt_pk_bf16(v[2], v[3]); o.z = cvt_pk_bf16(v[4], v[5]); o.w = cvt_pk_bf16(v[6], v[7]);
    *(u32x4*)(bs3 + (size_t)n * 384 + k8 * 8) = o;
  }
  bf16_t* bs1 = (bf16_t*)(ws + W_BS1) + ((size_t)l * 8192 + (size_t)(g >> 1) * 256 + (g & 1) * 128) * 512;
  for (int e = tid; e < 128 * 64; e += 512) {
    const int jn = e >> 6, k8 = e & 63, k = k8 * 8, pp = jn & 63;
    float v[8];
    if ((k >> 8) == (g & 1)) {
      const int s = (k & 255) >> 4, c0 = k & 15;
      const float ar = apr[pp * 17 + 15 - s], ai = api[pp * 17 + 15 - s];
#pragma unroll
      for (int i = 0; i < 8; ++i) {
        const float br = bbr[pp * 16 + c0 + i], bi = bbi[pp * 16 + c0 + i];
        v[i] = jn < 64 ? (ar * br - ai * bi) : (ar * bi + ai * br);
      }
    } else {
#pragma unroll
      for (int i = 0; i < 8; ++i) v[i] = 0.f;
    }
    u32x4 o; o.x = cvt_pk_bf16(v[0], v[1]); o.y = cvt_pk_bf16(v[2], v[3]); o.z = cvt_pk_bf16(v[4], v[5]); o.w = cvt_pk_bf16(v[6], v[7]);
    *(u32x4*)(bs1 + (size_t)jn * 512 + k) = o;
  }
  __syncthreads();
}

__device__ __forceinline__ size_t kf_off(int krow, int kvh, int kk, int hh) { return ((((size_t)(krow >> 5) * 4 + kvh) * 4 + kk) * 64 + hh * 32 + (krow & 31)) * 8; }
__device__ __forceinline__ size_t vf_off(int krow, int kvh, int d) {
  const int kin = krow & 15, hh = (kin >> 2) & 1, j = (kin >> 3) * 4 + (kin & 3);
  return ((((size_t)(krow >> 4) * 4 + kvh) * 2 + (d >> 5)) * 64 + hh * 32 + (d & 31)) * 8 + j;
}
__device__ __forceinline__ void cache_phase(const Params& p) {
  unsigned char* ws = p.ws;
  bf16_t* kb = (bf16_t*)(ws + W_KB); bf16_t* vt = (bf16_t*)(ws + W_VT);
  const int gt = bid_o() * 512 + tid_o(), nth = gdim_o() * 512;
  for (int e = gt; e < 32 * 128 * 32; e += nth) {
    const int i = e / (128 * 32), w = (e / 32) % 128, c8 = e % 32, kvh = c8 >> 3, d0 = (c8 & 7) * 8;
    const int krow = KS_BASE + i * 160 + w;
    const float* s = p.in[4] + ((size_t)i * 128 + w) * 256 + c8 * 8;
    const f32x4 a = *(const f32x4*)s, b = *(const f32x4*)(s + 4);
    u32x4 o; o.x = cvt_pk_bf16(a.x, a.y); o.y = cvt_pk_bf16(a.z, a.w); o.z = cvt_pk_bf16(b.x, b.y); o.w = cvt_pk_bf16(b.z, b.w);
    *(u32x4*)(kb + kf_off(krow, kvh, d0 >> 4, (d0 >> 3) & 1)) = o;
  }
  for (int e = gt; e < 32 * 128 * 256; e += nth) {
    const int i = e / (128 * 256), w = (e / 256) % 128, c = e % 256;
    vt[vf_off(KS_BASE + i * 160 + w, c >> 6, c & 63)] = f2bf(p.in[5][e]);
  }
}

template <int MODE>
__device__ __forceinline__ void norm_phase(const Params& p, const float* gain, int nks) {
  unsigned char* ws = p.ws;
  const int lane = tid_o() & 63, wv = tid_o() >> 6;
  bf16_t* ub = (bf16_t*)(ws + W_UB); float* rs = (float*)(ws + W_RS);
  if (MODE == 2) {
    const bf16_t* xb = (const bf16_t*)(ws + W_XB);
    for (int row = (bid_o() * 8 + wv) * 8; row < SPLIT_ROW0; row += gdim_o() * 64) {
      u32x2 raw[8][4];
#pragma unroll
      for (int q = 0; q < 8; ++q)
#pragma unroll
        for (int j = 0; j < 4; ++j) raw[q][j] = *(const u32x2*)(xb + (size_t)(row + q) * D + (lane + 64 * j) * 4);
#pragma unroll
      for (int q = 0; q < 8; ++q) {
        float s = 0.f;
#pragma unroll
        for (int j = 0; j < 4; ++j) { const f32x4 v = unpack4(raw[q][j]); s += (v.x * v.x + v.y * v.y) + (v.z * v.z + v.w * v.w); }
        const float r = rsqrtf(wave_sum(s, lane) * (1.f / D) + 1e-6f);
        if (lane == 0) rs[row + q] = r;
      }
    }
  }
  for (int row = ((MODE == 3 || MODE == 2) ? SPLIT_ROW0 : 0) + bid_o() * 8 + wv; row < R_PAD; row += gdim_o() * 8) {
    float* xr = xrow_ptr(p, row);
    f32x4 v[4];
    if (MODE == 0) {
      const float* src = xsrc_ptr(p, row);
#pragma unroll
      for (int j = 0; j < 4; ++j) v[j] = src ? *(const f32x4*)(src + (lane + 64 * j) * 4) : (f32x4){0.f, 0.f, 0.f, 0.f};
    } else {
      bf16_t* xbr = (bf16_t*)(ws + W_XB) + (size_t)row * D;
#pragma unroll
      for (int j = 0; j < 4; ++j) v[j] = unpack4(*(const u32x2*)(xbr + (lane + 64 * j) * 4));
      if (nks > 0 && row >= SPLIT_ROW0) {
        const float* pp = (const float*)(ws + W_PART) + (size_t)(row - SPLIT_ROW0) * D + lane * 4;
        for (int k = 0; k < nks; k += 4) {
          f32x4 t[4][4];
#pragma unroll
          for (int kk = 0; kk < 4; ++kk)
#pragma unroll
            for (int j = 0; j < 4; ++j) t[kk][j] = (k + kk < nks) ? *(const f32x4*)(pp + (size_t)(k + kk) * SPLIT_ROWS * D + 256 * j) : (f32x4){0.f, 0.f, 0.f, 0.f};
#pragma unroll
          for (int kk = 0; kk < 4; ++kk)
#pragma unroll
            for (int j = 0; j < 4; ++j) v[j] += t[kk][j];
        }
        if (MODE == 3) {
#pragma unroll
          for (int j = 0; j < 4; ++j) *(f32x4*)(xr + (lane + 64 * j) * 4) = v[j];
        } else {
#pragma unroll
          for (int j = 0; j < 4; ++j) { u32x2 o; o.x = cvt_pk_bf16(v[j].x, v[j].y); o.y = cvt_pk_bf16(v[j].z, v[j].w); *(u32x2*)(xbr + (lane + 64 * j) * 4) = o; }
        }
      }
    }
    if (MODE == 3) continue;
    float s = 0.f;
#pragma unroll
    for (int j = 0; j < 4; ++j) s += (v[j].x * v[j].x + v[j].y * v[j].y) + (v[j].z * v[j].z + v[j].w * v[j].w);
    const float r = rsqrtf(wave_sum(s, lane) * (1.f / D) + 1e-6f);
    if (MODE == 2) {
      if (lane == 0) rs[row] = r;
    }
    else {
#pragma unroll
      for (int j = 0; j < 4; ++j) {
        const f32x4 gg = *(const f32x4*)(gain + (lane + 64 * j) * 4);
        u32x2 o; o.x = cvt_pk_bf16(v[j].x * r * gg.x, v[j].y * r * gg.y); o.y = cvt_pk_bf16(v[j].z * r * gg.z, v[j].w * r * gg.w);
        *(u32x2*)(ub + (size_t)row * D + (lane + 64 * j) * 4) = o;
      }
    }
  }
}

__device__ __forceinline__ void s2_phase(const Params& p, int l) {
  unsigned char* ws = p.ws;
  const float* sb = (const float*)(ws + W_SB); bf16_t* hin = (bf16_t*)(ws + W_HIN);
  const int lane = tid_o() & 63, wv = tid_o() >> 6;
  float* ex = (float*)shm;
  constexpr int SEG = 129;
  for (int item = bid_o(); item < 128; item += gdim_o()) {
    const int b = item >> 6, g = item & 63;
    const float* a16 = (const float*)(ws + W_A16) + (((size_t)l * 64 + g) * 64 + lane) * 2;
    const float ar = a16[0], ai = a16[1];
    const int c0 = wv * SEG, c1 = (c0 + SEG) < 1025 ? (c0 + SEG) : 1025;
    const float* sp = sb + (size_t)(b * 1025) * 8192 + g * 128 + lane;
    bf16_t* hp = hin + (size_t)(b * 1025) * 8192 + g * 128 + lane;
    float hr = 0.f, hi = 0.f;
    {
      int c = c0;
      float sr[8], si[8], pr[8], pi[8];
      if (c + 8 <= c1) {
#pragma unroll
        for (int u = 0; u < 8; ++u) { sr[u] = sp[(size_t)(c + u) * 8192]; si[u] = sp[(size_t)(c + u) * 8192 + 64]; }
      }
      for (; c + 8 <= c1; c += 8) {
        const bool more = c + 16 <= c1;
        if (more) {
#pragma unroll
          for (int u = 0; u < 8; ++u) { pr[u] = sp[(size_t)(c + 8 + u) * 8192]; pi[u] = sp[(size_t)(c + 8 + u) * 8192 + 64]; }
        }
#pragma unroll
        for (int u = 0; u < 8; ++u) { const float nr = ar * hr - ai * hi + sr[u], ni = ar * hi + ai * hr + si[u]; hr = nr; hi = ni; }
#pragma unroll
        for (int u = 0; u < 8; ++u) { sr[u] = pr[u]; si[u] = pi[u]; }
      }
      for (; c < c1; ++c) { const float sr = sp[(size_t)c * 8192], si = sp[(size_t)c * 8192 + 64]; const float nr = ar * hr - ai * hi + sr, ni = ar * hi + ai * hr + si; hr = nr; hi = ni; }
    }
    ex[(wv * 2) * 64 + lane] = hr; ex[(wv * 2 + 1) * 64 + lane] = hi;
    float qr = ar, qi = ai;
#pragma unroll
    for (int s = 0; s < 7; ++s) { const float t = qr * qr - qi * qi; qi = 2.f * qr * qi; qr = t; }
    { const float t = qr * ar - qi * ai; qi = qr * ai + qi * ar; qr = t; }
    __syncthreads();
    hr = 0.f; hi = 0.f;
    for (int j = 0; j < wv; ++j) { const float er = ex[(j * 2) * 64 + lane], ei = ex[(j * 2 + 1) * 64 + lane]; const float nr = qr * hr - qi * hi + er, ni = qr * hi + qi * hr + ei; hr = nr; hi = ni; }
    {
      int c = c0;
      float sr[8], si[8], pr[8], pi[8];
      if (c + 8 <= c1) {
#pragma unroll
        for (int u = 0; u < 8; ++u) { sr[u] = sp[(size_t)(c + u) * 8192]; si[u] = sp[(size_t)(c + u) * 8192 + 64]; }
      }
      for (; c + 8 <= c1; c += 8) {
        const bool more = c + 16 <= c1;
        if (more) {
#pragma unroll
          for (int u = 0; u < 8; ++u) { pr[u] = sp[(size_t)(c + 8 + u) * 8192]; pi[u] = sp[(size_t)(c + 8 + u) * 8192 + 64]; }
        }
#pragma unroll
        for (int u = 0; u < 8; ++u) {
          hp[(size_t)(c + u) * 8192] = f2bf(hr); hp[(size_t)(c + u) * 8192 + 64] = f2bf(hi);
          const float nr = ar * hr - ai * hi + sr[u], ni = ar * hi + ai * hr + si[u]; hr = nr; hi = ni;
        }
#pragma unroll
        for (int u = 0; u < 8; ++u) { sr[u] = pr[u]; si[u] = pi[u]; }
      }
      for (; c < c1; ++c) {
        const float sr = sp[(size_t)c * 8192], si = sp[(size_t)c * 8192 + 64];
        hp[(size_t)c * 8192] = f2bf(hr); hp[(size_t)c * 8192 + 64] = f2bf(hi);
        const float nr = ar * hr - ai * hi + sr, ni = ar * hi + ai * hr + si; hr = nr; hi = ni;
      }
    }
    if (wv == 7) {
      p.out[O_PRE + (((size_t)l * NB + b) * 64 + g) * 64 + lane] = hr; p.out[O_PIM + (((size_t)l * NB + b) * 64 + g) * 64 + lane] = hi;
    }
    __syncthreads();
  }
  for (int q = bid_o() * 8 + wv; q < 2048; q += gdim_o() * 8) {
    const int i = q >> 6, g = q & 63, c0 = 2050 + 2 * i;
    const size_t so = (((size_t)l * DB + i) * 64 + g) * 64 + lane;
    float hr = p.in[2][so], hi = p.in[3][so];
    const float* a16 = (const float*)(ws + W_A16) + (((size_t)l * 64 + g) * 64 + lane) * 2;
    const float ar = a16[0], ai = a16[1];
    const float* sp = sb + (size_t)c0 * 8192 + g * 128 + lane;
    bf16_t* hp = hin + (size_t)c0 * 8192 + g * 128 + lane;
#pragma unroll
    for (int c = 0; c < 2; ++c) {
      const float sr = sp[(size_t)c * 8192], si = sp[(size_t)c * 8192 + 64];
      hp[(size_t)c * 8192] = f2bf(hr); hp[(size_t)c * 8192 + 64] = f2bf(hi);
      const float nr = ar * hr - ai * hi + sr, ni = ar * hi + ai * hr + si; hr = nr; hi = ni;
    }
    p.out[O_SRE + so] = hr; p.out[O_SIM + so] = hi;
  }
}

__device__ __forceinline__ void kvfin_phase(const Params& p) {
  unsigned char* ws = p.ws;
  const float* kv = (const float*)(ws + W_KVRAW); bf16_t* kb = (bf16_t*)(ws + W_KB); bf16_t* vt = (bf16_t*)(ws + W_VT);
  const int lane = tid_o() & 63, wv = tid_o() >> 6;
  for (int row = bid_o() * 8 + wv; row < R_REAL; row += gdim_o() * 8) {
    const float* src = kv + (size_t)row * 512 + lane * 8;
    const f32x4 a = *(const f32x4*)src, b = *(const f32x4*)(src + 4);
    float v[8] = {a.x, a.y, a.z, a.w, b.x, b.y, b.z, b.w};
    const int col = (lane & 31) * 8, kvh = col >> 6, d0 = col & 63;
    int krow; float* ok = nullptr; float* ov = nullptr;
    if (row < R_SAMPLE) { const int b_ = row >> 14, t = row & 16383; krow = row;
      if (t >= SEQ - 128) { ok = p.out + O_PK + ((size_t)b_ * 128 + (t - (SEQ - 128))) * 256; ov = p.out + O_PV + ((size_t)b_ * 128 + (t - (SEQ - 128))) * 256; } }
    else if (row < R_META) { const int q = row - R_SAMPLE, i = q >> 5, j = q & 31; krow = KS_BASE + i * 160 + 128 + j;
      ok = p.out + O_SK + (size_t)q * 256; ov = p.out + O_SV + (size_t)q * 256; }
    else { krow = KM_BASE + (row - R_META); }
    if (lane < 32) {
      float s = 0.f;
#pragma unroll
      for (int i = 0; i < 8; ++i) s += v[i] * v[i];
      s += shx(s, 1, lane); s += shx(s, 2, lane); s += shx(s, 4, lane);
      const float r = rsqrtf(s * (1.f / 64.f) + 1e-6f);
#pragma unroll
      for (int i = 0; i < 8; ++i) v[i] = v[i] * r * p.in[22][d0 + i];
      u32x4 o; o.x = cvt_pk_bf16(v[0], v[1]); o.y = cvt_pk_bf16(v[2], v[3]); o.z = cvt_pk_bf16(v[4], v[5]); o.w = cvt_pk_bf16(v[6], v[7]);
      *(u32x4*)(kb + kf_off(krow, kvh, d0 >> 4, (d0 >> 3) & 1)) = o;
      if (ok) { *(f32x4*)(ok + col) = (f32x4){v[0], v[1], v[2], v[3]}; *(f32x4*)(ok + col + 4) = (f32x4){v[4], v[5], v[6], v[7]}; }
    } else {
      float s = 0.f; s += shx(s, 1, lane); s += shx(s, 2, lane); s += shx(s, 4, lane);
#pragma unroll
      for (int i = 0; i < 8; ++i) vt[vf_off(krow, kvh, d0 + i)] = f2bf(v[i]);
      if (ov) { *(f32x4*)(ov + col) = (f32x4){v[0], v[1], v[2], v[3]}; *(f32x4*)(ov + col + 4) = (f32x4){v[4], v[5], v[6], v[7]}; }
    }
  }
}

__device__ __forceinline__ int rel_bucket(int rel) {
  const int n = rel < 0 ? -rel : rel;
  const float nf = (float)(n < 1 ? 1 : n);
  int large = 8 + (int)(logf(nf / 8.f) / 2.772588722239781f * 8.f);
  large = large < 15 ? large : 15;
  return (rel > 0 ? 16 : 0) + (n < 8 ? n : large);
}

struct AttnItem { int kvh, nt_band, ktile0, sj0, tpos, qrow0, qi0, head; bool active; };
__device__ __forceinline__ AttnItem attn_item(int item, int wv) {
  AttnItem a;
  if (item < 2048) {
    const int b = item >> 10, n = (item >> 2) & 255; a.kvh = item & 3; a.head = a.kvh * 4 + (wv >> 1); const int qt = wv & 1;
    a.qi0 = qt * 32; a.qrow0 = b * SEQ + n * 64 + a.qi0; a.tpos = n * 64 + a.qi0;
    const int c0 = n >= 2 ? n - 2 : 0;
    a.nt_band = (n - c0 + 1) * 2;
    a.ktile0 = (b * SEQ + c0 * 64) >> 5;
    a.sj0 = n >= 2 ? 0 : (2 - n) * 64; a.active = true;
  } else {
    const int q = item - 2048, i = q >> 2; a.kvh = q & 3; a.head = a.kvh * 4 + (wv & 3); a.active = wv < 4;
    a.qi0 = 0; a.qrow0 = R_SAMPLE + i * 32; a.tpos = 1024; a.nt_band = 5;
    a.ktile0 = (KS_BASE + i * 160) >> 5; a.sj0 = 0;
  }
  return a;
}
constexpr int AT_BUF0 = 16896, AT_KV = 28672, AT_BUF = 2 * AT_KV;
__device__ __forceinline__ void attn_stage(const bf16_t* kb, const bf16_t* vt, int item, int buf, int wv, int lane) {
  const AttnItem a = attn_item(item, 0);
  LAS unsigned char* lds = (LAS unsigned char*)shm + AT_BUF0 + buf * AT_BUF;
#pragma unroll
  for (int t = 0; t < 7; ++t) {
    if (t <= a.nt_band) {
      const int T = t == 0 ? (KM_BASE >> 5) : a.ktile0 + (t - 1);
      const bf16_t* src; unsigned dst;
      if (wv < 4) { src = kb + ((((size_t)T * 4 + a.kvh) * 4 + wv) * 64 + lane) * 8; dst = t * 4096 + wv * 1024; }
      else { const int s = (wv - 4) >> 1, dt = (wv - 4) & 1; src = vt + (((((size_t)T * 2 + s) * 4 + a.kvh) * 2 + dt) * 64 + lane) * 8; dst = AT_KV + t * 4096 + (wv - 4) * 1024; }
      __builtin_amdgcn_global_load_lds((const unsigned*)src, (LAS unsigned*)(lds + dst), 16, 0, 0);
    }
  }
}

__device__ __forceinline__ void attn_phase(const Params& p, int jl) {
  unsigned char* ws = p.ws;
  float* lut = (float*)shm;
  float* qg = lut + 16 * 256;
  for (int e = tid_o(); e < 16 * 256; e += 512) {
    const int h = e >> 8, idx = e & 255; const int rel = idx - 191;
    lut[e] = idx < 255 ? p.in[27][rel_bucket(rel) * 16 + h] * 1.44269504089f : 0.f;
  }
  if (tid_o() < 64) qg[tid_o()] = p.in[24][jl * 64 + tid_o()] * (0.125f * 1.44269504089f);
  const bf16_t* qb = (const bf16_t*)(ws + W_UB); const bf16_t* kb = (const bf16_t*)(ws + W_KB); const bf16_t* vt = (const bf16_t*)(ws + W_VT);
  bf16_t* ao = (bf16_t*)(ws + W_YG);
  const int tid = tid_o(), lane = tid & 63, wv = __builtin_amdgcn_readfirstlane(tid >> 6), ql = lane & 31, hh = lane >> 5;
  const int G = gdim_o(), item0 = bid_o(), NITEM = 2048 + 128;
  u32x4 qraw[4];
  if (item0 < NITEM) {
    attn_stage(kb, vt, item0, 0, wv, lane);
    const AttnItem a = attn_item(item0, wv);
    const bf16_t* qp = qb + (size_t)(a.qrow0 + ql) * D + a.head * 64 + hh * 8;
#pragma unroll
    for (int kk = 0; kk < 4; ++kk) qraw[kk] = *(const u32x4*)(qp + kk * 16);
  }
  int cur = 0;
#pragma unroll 1
  for (int item = item0; item < NITEM; item += G, cur ^= 1) {
    asm volatile("s_waitcnt vmcnt(0)" ::: "memory");
    __syncthreads();
    const AttnItem a = attn_item(item, wv);
    u32x4 qcur[4];
#pragma unroll
    for (int kk = 0; kk < 4; ++kk) qcur[kk] = qraw[kk];
    if (item + G < NITEM) {
      attn_stage(kb, vt, item + G, cur ^ 1, wv, lane);
      const AttnItem an = attn_item(item + G, wv);
      const bf16_t* qp = qb + (size_t)(an.qrow0 + ql) * D + an.head * 64 + hh * 8;
#pragma unroll
      for (int kk = 0; kk < 4; ++kk) qraw[kk] = *(const u32x4*)(qp + kk * 16);
    }
    if (!a.active) continue;
    const int head = a.head, nt_band = a.nt_band, sj0 = a.sj0, qi0 = a.qi0, tpos = a.tpos, qrow0 = a.qrow0;
    const LAS unsigned char* kl = (const LAS unsigned char*)shm + AT_BUF0 + cur * AT_BUF + lane * 16;
    bf16x8 qf[4];
    {
      float qv[32]; float s = 0.f;
#pragma unroll
      for (int kk = 0; kk < 4; ++kk) {
        const unsigned w[4] = {qcur[kk].x, qcur[kk].y, qcur[kk].z, qcur[kk].w};
#pragma unroll
        for (int i = 0; i < 4; ++i) { qv[kk * 8 + 2 * i] = bf2f(w[i] & 0xffffu); qv[kk * 8 + 2 * i + 1] = bf2f(w[i] >> 16); }
      }
#pragma unroll
      for (int i = 0; i < 32; ++i) s += qv[i] * qv[i];
      s += shx(s, 32, lane);
      const float r = rsqrtf(s * (1.f / 64.f) + 1e-6f);
#pragma unroll
      for (int kk = 0; kk < 4; ++kk) {
        u32x4 o; const float* g8 = qg + kk * 16 + hh * 8;
        o.x = cvt_pk_bf16(qv[kk * 8 + 0] * r * g8[0], qv[kk * 8 + 1] * r * g8[1]); o.y = cvt_pk_bf16(qv[kk * 8 + 2] * r * g8[2], qv[kk * 8 + 3] * r * g8[3]);
        o.z = cvt_pk_bf16(qv[kk * 8 + 4] * r * g8[4], qv[kk * 8 + 5] * r * g8[5]); o.w = cvt_pk_bf16(qv[kk * 8 + 6] * r * g8[6], qv[kk * 8 + 7] * r * g8[7]);
        qf[kk] = __builtin_bit_cast(bf16x8, o);
      }
    }
    f32x16 sc[7];
#pragma unroll
    for (int t = 0; t < 7; ++t) {
      if (t <= nt_band) {
        f32x16 a_ = {0.f, 0.f, 0.f, 0.f, 0.f, 0.f, 0.f, 0.f, 0.f, 0.f, 0.f, 0.f, 0.f, 0.f, 0.f, 0.f};
#pragma unroll
        for (int kk = 0; kk < 4; ++kk) {
          const bf16x8 kf = *(const LAS bf16x8*)(kl + t * 4096 + kk * 1024);
          a_ = __builtin_amdgcn_mfma_f32_32x32x16_bf16(kf, qf[kk], a_, 0, 0, 0);
        }
        sc[t] = a_;
      }
    }
    const float sink = p.in[25][jl * 16 + head] * 1.44269504089f;
    const float* lh = lut + head * 256 + 191;
    float mx = sink;
    const int qi = qi0 + ql;
#pragma unroll
    for (int t = 0; t < 7; ++t) {
      if (t <= nt_band) {
#pragma unroll
        for (int r = 0; r < 16; ++r) {
          const int key = 8 * (r >> 2) + 4 * hh + (r & 3);
          float v;
          if (t == 0) {
            if (r < 8) { int rel = key - 16 - (tpos + ql); rel = rel < -191 ? -191 : rel; v = sc[t][r] + lh[rel]; } else v = -1e30f;
          } else {
            const int rel = sj0 + (t - 1) * 32 + key - 128 - qi;
            v = sc[t][r] + lh[rel];
          }
          sc[t][r] = v; mx = fmaxf(mx, v);
        }
      }
    }
    mx = fmaxf(mx, shx(mx, 32, lane));
    float sum = 0.f;
#pragma unroll
    for (int t = 0; t < 7; ++t) {
      if (t <= nt_band) {
#pragma unroll
        for (int r = 0; r < 16; ++r) { const float e = __builtin_amdgcn_exp2f(sc[t][r] - mx); sc[t][r] = e; sum += e; }
      }
    }
    sum += shx(sum, 32, lane);
    const float inv = 1.f / (sum + __builtin_amdgcn_exp2f(sink - mx));
    f32x16 o0 = {0.f, 0.f, 0.f, 0.f, 0.f, 0.f, 0.f, 0.f, 0.f, 0.f, 0.f, 0.f, 0.f, 0.f, 0.f, 0.f}, o1 = o0;
#pragma unroll
    for (int t = 0; t < 7; ++t) {
      if (t <= nt_band) {
#pragma unroll
        for (int s = 0; s < 2; ++s) {
          if (t == 0 && s == 1) continue;
          u32x4 pa; pa.x = cvt_pk_bf16(sc[t][8 * s + 0] * inv, sc[t][8 * s + 1] * inv); pa.y = cvt_pk_bf16(sc[t][8 * s + 2] * inv, sc[t][8 * s + 3] * inv);
          pa.z = cvt_pk_bf16(sc[t][8 * s + 4] * inv, sc[t][8 * s + 5] * inv); pa.w = cvt_pk_bf16(sc[t][8 * s + 6] * inv, sc[t][8 * s + 7] * inv);
          const bf16x8 pf = __builtin_bit_cast(bf16x8, pa);
          const bf16x8 b0 = *(const LAS bf16x8*)(kl + AT_KV + t * 4096 + s * 2048), b1 = *(const LAS bf16x8*)(kl + AT_KV + t * 4096 + s * 2048 + 1024);
          o0 = __builtin_amdgcn_mfma_f32_32x32x16_bf16(pf, b0, o0, 0, 0, 0);
          o1 = __builtin_amdgcn_mfma_f32_32x32x16_bf16(pf, b1, o1, 0, 0, 0);
        }
      }
    }
#pragma unroll
    for (int r = 0; r < 16; ++r) {
      const int q = 8 * (r >> 2) + 4 * hh + (r & 3);
      bf16_t* op = ao + (size_t)(qrow0 + q) * D + head * 64 + ql;
      op[0] = f2bf(o0[r]); op[32] = f2bf(o1[r]);
    }
  }
  asm volatile("s_waitcnt vmcnt(0)" ::: "memory");
  __syncthreads();
}

__global__ void __launch_bounds__(512) fwd_megakernel(Params p) {
  cg::grid_group grid = cg::this_grid();
  unsigned char* ws = p.ws;
  volatile LAS unsigned* xst = (volatile LAS unsigned*)((LAS unsigned char*)shm + XB_LDS_OFF);
  if (threadIdx.x < 4) xst[threadIdx.x] = 0u;
  __syncthreads();
  (void)xcd_barrier_post((unsigned*)(ws + W_BAR), xst);
  for (int it = bid_o(); it < 128; it += gdim_o()) s5_matrices(p, it >> 6, it & 63);
  weights_phase(p);
  cache_phase(p);
  norm_phase<0>(p, p.in[7], 0);
  if (p.ws == nullptr) grid.sync();
  xcd_barrier(p.ws);
#pragma unroll 1
  for (int l = 0; l < 4; ++l) {
    if (l < 2) {
      if (l == 1) { norm_phase<1>(p, p.in[7] + D, 11); xcd_barrier(p.ws); }
      gemm_phase<G_S1>(p, nullptr, 0, (const bf16_t*)(ws + W_BS1) + (size_t)l * 8192 * 512, 8192, 512);
      xcd_barrier(p.ws);
      if (PROBE == 9) { gemm_phase<G_S1>(p, nullptr, 0, (const bf16_t*)(ws + W_BS1) + (size_t)l * 8192 * 512, 8192, 512); xcd_barrier(p.ws); }
      s2_phase(p, l);
      xcd_barrier(p.ws);
      if (PROBE == 3) { s2_phase(p, l); xcd_barrier(p.ws); s2_phase(p, l); xcd_barrier(p.ws); }
      gemm_phase<G_S3>(p, nullptr, 0, (const bf16_t*)(ws + W_BS3) + (size_t)l * 16384 * 384, 16384, 384);
      xcd_barrier(p.ws);
      if (PROBE == 10) { gemm_phase<G_S3>(p, nullptr, 0, (const bf16_t*)(ws + W_BS3) + (size_t)l * 16384 * 384, 16384, 384); xcd_barrier(p.ws); }
      gemm_phase<G_GLU>(p, (const bf16_t*)(ws + W_YG), D, (const bf16_t*)(ws + W_WGLU) + (size_t)l * 2048 * 1024, 2048, 1024, l == 0);
      xcd_barrier(p.ws);
    } else {
      norm_phase<2>(p, nullptr, 11);
      xcd_barrier(p.ws);
      if (l == 2) gemm_phase<G_QKV>(p, (const bf16_t*)(ws + W_XB), D, (const bf16_t*)(ws + W_WQKV), 1536, 1024);
      else gemm_phase<G_QKV>(p, (const bf16_t*)(ws + W_XB), D, (const bf16_t*)(ws + W_WQKV) + (size_t)1536 * 1024, 1024, 1024);
      xcd_barrier(p.ws);
      if (l == 2) { kvfin_phase(p); xcd_barrier(p.ws); }
      attn_phase(p, l - 2);
      xcd_barrier(p.ws);
      if (PROBE == 4) { attn_phase(p, l - 2); xcd_barrier(p.ws); attn_phase(p, l - 2); xcd_barrier(p.ws); }
      gemm_phase<G_RESID>(p, (const bf16_t*)(ws + W_YG), D, (const bf16_t*)(ws + W_WO) + (size_t)(l - 2) * 1024 * 1024, 1024, 1024);
      xcd_barrier(p.ws);
    }
    norm_phase<2>(p, nullptr, l < 2 ? 0 : 4);
    xcd_barrier(p.ws);
    gemm_phase<G_FFIN>(p, (const bf16_t*)(ws + W_XB), D, (const bf16_t*)(ws + W_WIN) + (size_t)l * 5632 * 1024, 5632, 1024);
    xcd_barrier(p.ws);
    if (PROBE == 1) { gemm_phase<G_FFIN>(p, (const bf16_t*)(ws + W_XB), D, (const bf16_t*)(ws + W_WIN) + (size_t)l * 5632 * 1024, 5632, 1024); xcd_barrier(p.ws); }
    if (PROBE == 2) { for (int q = 0; q < 10; ++q) xcd_barrier(p.ws); }
    gemm_phase<G_RESID>(p, (const bf16_t*)(ws + W_HB), FF, (const bf16_t*)(ws + W_WOUT) + (size_t)l * 1024 * FF, 1024, FF, l == 3 ? 2 : 0);
    xcd_barrier(p.ws);
  }
  norm_phase<3>(p, nullptr, 11);
}

extern "C" void kernel_launch(void* const* d_in, const int* in_sizes, int n_in, void* d_out, int out_size, void* d_ws, size_t ws_size, hipStream_t stream) {
  static int grid_blocks = 0;
  if (grid_blocks == 0) {
    if (n_in != 28 || (size_t)out_size != O_END || ws_size < W_END) { fprintf(stderr, "kernel_launch: unexpected shapes (n_in %d out %d ws %zu need %zu)\n", n_in, out_size, ws_size, (size_t)W_END); grid_blocks = -1; return; }
    int dev = 0, cus = 0, per_cu = 0;
    hipGetDevice(&dev);
    hipDeviceGetAttribute(&cus, hipDeviceAttributeMultiprocessorCount, dev);
    if (hipFuncSetAttribute((const void*)fwd_megakernel, hipFuncAttributeMaxDynamicSharedMemorySize, LDS_BYTES) != hipSuccess) { fprintf(stderr, "kernel_launch: hipFuncSetAttribute failed\n"); }
    hipOccupancyMaxActiveBlocksPerMultiprocessor(&per_cu, (const void*)fwd_megakernel, 512, LDS_BYTES);
    if (per_cu < 1) { fprintf(stderr, "kernel_launch: occupancy query says %d blocks/CU\n", per_cu); per_cu = 1; }
    (void)hipGetLastError();
    grid_blocks = cus;
  }
  if (grid_blocks < 0) return;
  if (hipMemsetAsync((char*)d_ws + W_BAR, 0, 4096 * 4, stream) != hipSuccess) { fprintf(stderr, "kernel_launch: memset failed\n"); return; }
  Params p{};
  for (int i = 0; i < 28; ++i) p.in[i] = (const float*)d_in[i];
  p.out = (float*)d_out; p.ws = (unsigned char*)d_ws;
  void* args[] = {&p};
  hipError_t e = hipLaunchCooperativeKernel((const void*)fwd_megakernel, dim3(grid_blocks), dim3(512), args, LDS_BYTES, stream);
  if (e != hipSuccess) fprintf(stderr, "cooperative launch failed: %s (grid %d)\n", hipGetErrorString(e), grid_blocks);
}
```

```cpp
#include <hip/hip_runtime.h>
#include <hip/hip_cooperative_groups.h>
#include <cstdio>
#include <cstdint>
namespace cg = cooperative_groups;

typedef unsigned short bf16_t;
typedef short bf16x8 __attribute__((ext_vector_type(8)));
typedef float f32x4 __attribute__((ext_vector_type(4)));
typedef float f32x16 __attribute__((ext_vector_type(16)));
typedef unsigned u32x4 __attribute__((ext_vector_type(4)));
typedef unsigned u32x2 __attribute__((ext_vector_type(2)));

constexpr int D = 1024, SEQ = 16384, NB = 2, DB = 32, DS = 32, FF = 2816;
constexpr int R_PROMPT = 0, R_SAMPLE = 32768, R_META = 33792, R_REAL = 33808, R_PAD = 34048;
constexpr int NTM = R_PAD / 256;
constexpr int NCH = 2 * 1025 + 64, NCH_PAD = 2304;
constexpr int KROWS = 32768 + 32 * 160 + 16;
constexpr int KS_BASE = 32768, KM_BASE = 32768 + 5120;
constexpr size_t VT_S = (size_t)2 * 4 * 64 * 16384, VT_M = VT_S + (size_t)32 * 4 * 64 * 160;

constexpr size_t O_YP = 0, O_YS = 33554432, O_PRE = O_YS + 1048576, O_PIM = O_PRE + 16384, O_PK = O_PIM + 16384, O_PV = O_PK + 65536,
                 O_SRE = O_PV + 65536, O_SIM = O_SRE + 262144, O_SK = O_SIM + 262144, O_SV = O_SK + 262144, O_END = O_SV + 262144;

constexpr size_t al(size_t x) { return (x + 255) & ~(size_t)255; }
constexpr size_t W_XMETA = 0;
constexpr size_t W_XB = al(W_XMETA + (size_t)256 * D * 4);
constexpr size_t W_RS = al(W_XB + (size_t)R_PAD * D * 2);
constexpr size_t W_UB = al(W_RS + (size_t)R_PAD * 4);
constexpr size_t W_YG = al(W_UB + (size_t)R_PAD * D * 2);
constexpr size_t W_SB = al(W_YG + (size_t)R_PAD * D * 2);
constexpr size_t W_HIN = al(W_SB + (size_t)NCH_PAD * 8192 * 4);
constexpr size_t W_KB = al(W_HIN + (size_t)NCH_PAD * 8192 * 2);
constexpr size_t W_VT = al(W_KB + (size_t)(KROWS + 16) * 256 * 2);
constexpr size_t W_WGLU = al(W_VT + (size_t)(KROWS + 16) * 256 * 2);
constexpr size_t W_WIN = al(W_WGLU + (size_t)2 * 2048 * 1024 * 2);
constexpr size_t W_WOUT = al(W_WIN + (size_t)4 * 5632 * 1024 * 2);
constexpr size_t W_WQKV = al(W_WOUT + (size_t)4 * 1024 * FF * 2);
constexpr size_t W_WO = al(W_WQKV + (size_t)2560 * 1024 * 2);
constexpr size_t W_BS1 = al(W_WO + (size_t)2 * 1024 * 1024 * 2);
constexpr size_t W_BS3 = al(W_BS1 + (size_t)2 * 8192 * 512 * 2);
constexpr size_t W_A16 = al(W_BS3 + (size_t)2 * 16384 * 384 * 2);
constexpr size_t W_BAR = al(W_A16 + (size_t)2 * 64 * 64 * 8);
constexpr size_t W_END = al(W_BAR + (size_t)4096 * 4);
constexpr size_t W_HB = W_UB;
constexpr size_t W_KVRAW = W_SB;
constexpr size_t W_PART = W_UB + (size_t)R_PAD * FF * 2;
constexpr int SPLIT_ROW0 = 32768, SPLIT_ROWS = R_PAD - 32768, SPLIT_PM0 = 128;
static_assert(W_PART + (size_t)11 * SPLIT_ROWS * D * 4 <= W_KB, "partials overlay");
static_assert((size_t)R_PAD * FF * 2 <= W_HIN - W_UB, "hb overlay");
static_assert((size_t)R_PAD * 512 * 4 <= W_HIN - W_SB, "kvraw overlay");
static_assert(W_END <= (size_t)512 * 1024 * 1024, "workspace");

constexpr int LDS_BYTES = 147456;
constexpr int XB_LDS_OFF = LDS_BYTES - 16;
constexpr int PROBE = 0;

struct Params {
  const float* in[28];
  float* out;
  unsigned char* ws;
};

extern __shared__ __attribute__((aligned(16))) unsigned char shm[];

__device__ __forceinline__ unsigned cvt_pk_bf16(float lo, float hi) { unsigned r; asm volatile("v_cvt_pk_bf16_f32 %0, %1, %2" : "=v"(r) : "v"(lo), "v"(hi)); return r; }
__device__ __forceinline__ bf16_t f2bf(float f) { return (bf16_t)(cvt_pk_bf16(f, 0.f) & 0xffffu); }
__device__ __forceinline__ float bf2f(unsigned b) { return __uint_as_float(b << 16); }
__device__ __forceinline__ f32x4 unpack4(u32x2 r) { return (f32x4){__uint_as_float(r.x << 16), __uint_as_float(r.x & 0xffff0000u), __uint_as_float(r.y << 16), __uint_as_float(r.y & 0xffff0000u)}; }
__device__ __forceinline__ float shx(float v, int o, int lane) { return __int_as_float(__builtin_amdgcn_ds_bpermute((lane ^ o) << 2, __float_as_int(v))); }
__device__ __forceinline__ float wave_sum(float v, int lane) {
#pragma unroll
  for (int o = 1; o < 64; o <<= 1) v += shx(v, o, lane);
  return v;
}
__device__ __forceinline__ int tid_o() { int t = threadIdx.x; asm volatile("" : "+v"(t)); return t; }
__device__ __forceinline__ int bid_o() { int b = blockIdx.x; asm volatile("" : "+s"(b)); return b; }
__device__ __forceinline__ int gdim_o() { int b = gridDim.x; asm volatile("" : "+s"(b)); return b; }
__device__ __forceinline__ float sigmoidf_(float x) { return __builtin_amdgcn_rcpf(1.f + __expf(-x)); }
__device__ __forceinline__ float gelu_tanh(float x) {
  const float x2 = x * x;
  const float w = x * (-2.302208198f - 0.102943242f * x2);
  return x * __builtin_amdgcn_rcpf(1.f + __builtin_amdgcn_exp2f(w));
}
__device__ __forceinline__ float* xrow_ptr(const Params& p, int row) {
  return row < R_META ? p.out + (size_t)row * D : (float*)(p.ws + W_XMETA) + (size_t)(row - R_META) * D;
}
__device__ __forceinline__ const float* xsrc_ptr(const Params& p, int row) {
  return row < R_SAMPLE ? p.in[0] + (size_t)row * D : row < R_META ? p.in[1] + (size_t)(row - R_SAMPLE) * D : row < R_REAL ? p.in[6] + (size_t)(row - R_META) * D : nullptr;
}
__device__ __forceinline__ int chunk_row(int cgi) {
  if (cgi >= NCH) cgi = 0;
  if (cgi < 2050) { const int b = cgi >= 1025 ? 1 : 0; const int c = cgi - b * 1025; return c == 0 ? R_META : b * SEQ + (c - 1) * 16; }
  return R_SAMPLE + (cgi - 2050) * 16;
}

#define LAS __attribute__((address_space(3)))
constexpr int BM = 256, BK = 64, HALF = 128, HTB = HALF * BK * 2;
__device__ __forceinline__ int lds_byte(int r, int c) {
  int st = (r >> 4) * 2 + (c >> 5), rr = r & 15, cc = c & 31, ob = rr * 64 + cc * 2;
  return st * 1024 + (ob ^ (((ob >> 9) & 1) << 5));
}
__device__ __forceinline__ void stage_rc(int b, int& R, int& C) {
  int st = b / 1024, sb = b % 1024, swz = sb ^ (((sb >> 9) & 1) << 5);
  R = (st >> 1) * 16 + swz / 64; C = (st & 1) * 32 + (swz % 64) / 2;
}

typedef f32x4 acc_t[2][2][4][2];

struct ARow {
  const char* base; unsigned hstep; unsigned voff[2];
  __device__ __forceinline__ void init(const bf16_t* A, int lda, int brow) {
    base = (const char*)(A + (size_t)brow * lda); hstep = (unsigned)HALF * lda * 2u;
#pragma unroll
    for (int i = 0; i < 2; ++i) { int R, C; stage_rc(tid_o() * 16 + i * 8192, R, C); voff[i] = (unsigned)(R * lda + C) * 2u; }
  }
  __device__ __forceinline__ const char* ptr(int h, int i, int kt) const { return base + (size_t)h * hstep + (size_t)kt * 128 + voff[i]; }
};
struct AS1 {
  const char* ub; unsigned voff[2][2]; int pn;
  __device__ __forceinline__ void init(const bf16_t* u, int brow, int pn_) {
    ub = (const char*)u; pn = pn_;
#pragma unroll
    for (int h = 0; h < 2; ++h)
#pragma unroll
      for (int i = 0; i < 2; ++i) { int R, C; stage_rc(tid_o() * 16 + i * 8192, R, C);
        voff[h][i] = (unsigned)(chunk_row(brow + h * 128 + R) + (C >> 4)) * 2048u + (unsigned)(C & 15) * 2u; }
  }
  __device__ __forceinline__ const char* ptr(int h, int i, int kt) const { return ub + (size_t)((pn * 2 + (kt >> 2)) * 32 + (kt & 3) * 8192) + voff[h][i]; }
};
struct AS3 {
  const char* ub; const char* hin; unsigned voffu[2][2], voffh[2][2]; int g;
  __device__ __forceinline__ void init(const bf16_t* u, const bf16_t* hn, int brow, int g_) {
    ub = (const char*)u; hin = (const char*)hn; g = g_;
#pragma unroll
    for (int h = 0; h < 2; ++h)
#pragma unroll
      for (int i = 0; i < 2; ++i) { int R, C; stage_rc(tid_o() * 16 + i * 8192, R, C);
        int cgi = brow + h * 128 + R; if (cgi >= NCH) cgi = 0;
        voffu[h][i] = (unsigned)cgi * 32768u + (unsigned)C * 2u;
        voffh[h][i] = (unsigned)cgi * 16384u + (unsigned)C * 2u; }
  }
  __device__ __forceinline__ const char* ptr(int h, int i, int kt) const {
    return kt < 4 ? ub + (size_t)(g * 512 + kt * 128) + voffu[h][i] : hin + (size_t)(g * 256 + (kt - 4) * 128) + voffh[h][i];
  }
};

template <class AF>
__device__ __forceinline__ void gemm_mainloop(acc_t& acc, const AF& A, const bf16_t* Bt, int K, int bcol, int nt) {
  LAS unsigned char* lds = (LAS unsigned char*)shm;
  const int tid = tid_o(), wid = __builtin_amdgcn_readfirstlane(tid >> 6), lane = tid & 63, wr = wid >> 2, wc = wid & 3, fr = lane & 15, fq = lane >> 4;
  unsigned voffB[2];
#pragma unroll
  for (int i = 0; i < 2; ++i) { int R, C; stage_rc(tid * 16 + i * 8192, R, C); voffB[i] = (unsigned)(R * K + C) * 2u; }
  const char* cB = (const char*)(Bt + (size_t)bcol * K);
  const size_t hstepB = (size_t)HALF * K * 2;
  const unsigned ldsw = (unsigned)wid * 1024u;
  const int aoff = lds_byte(wr * 64 + fr, fq * 8), boff = lds_byte(wc * 32 + fr, fq * 8);
#define SA(b, h) (((b) * 2 + (h)) * HTB)
#define SB(b, h) ((4 + (b) * 2 + (h)) * HTB)
#define STAGE_A(bufoff, h, kt) do { _Pragma("unroll") for (int _i = 0; _i < 2; ++_i) \
    __builtin_amdgcn_global_load_lds((const unsigned*)A.ptr(h, _i, kt), (LAS unsigned*)(lds + (bufoff) + ldsw + _i * 8192), 16, 0, 0); } while (0)
#define STAGE_B(bufoff, h, kt) do { _Pragma("unroll") for (int _i = 0; _i < 2; ++_i) \
    __builtin_amdgcn_global_load_lds((const unsigned*)(cB + (size_t)(h) * hstepB + (size_t)(kt) * 128 + voffB[_i]), (LAS unsigned*)(lds + (bufoff) + ldsw + _i * 8192), 16, 0, 0); } while (0)
#define LDA(dst, b, h) do { _Pragma("unroll") for (int m = 0; m < 4; ++m) _Pragma("unroll") for (int k = 0; k < 2; ++k) dst[m][k] = *(const LAS bf16x8*)(lds + SA(b, h) + aoff + m * 2048 + k * 1024); } while (0)
#define LDB(dst, b, h) do { _Pragma("unroll") for (int n = 0; n < 2; ++n) _Pragma("unroll") for (int k = 0; k < 2; ++k) dst[n][k] = *(const LAS bf16x8*)(lds + SB(b, h) + boff + n * 2048 + k * 1024); } while (0)
#define MMA(ai, bj, At_, Bt_) do { __builtin_amdgcn_s_setprio(1); _Pragma("unroll") for (int m = 0; m < 4; ++m) _Pragma("unroll") for (int n = 0; n < 2; ++n) _Pragma("unroll") for (int k = 0; k < 2; ++k) \
      acc[ai][bj][m][n] = __builtin_amdgcn_mfma_f32_16x16x32_bf16(Bt_[n][k], At_[m][k], acc[ai][bj][m][n], 0, 0, 0); \
    __builtin_amdgcn_s_setprio(0); } while (0)
#define WAIT_V(n) asm volatile("s_waitcnt vmcnt(" #n ")" ::: "memory")
#define WAIT_L(n) asm volatile("s_waitcnt lgkmcnt(" #n ")" ::: "memory")
#define BAR __builtin_amdgcn_s_barrier()
#define SCHED __builtin_amdgcn_sched_barrier(0)
#pragma unroll
  for (int a = 0; a < 2; ++a)
#pragma unroll
    for (int b = 0; b < 2; ++b)
#pragma unroll
      for (int m = 0; m < 4; ++m)
#pragma unroll
        for (int n = 0; n < 2; ++n) acc[a][b][m][n] = (f32x4){0.f, 0.f, 0.f, 0.f};
  bf16x8 At[4][2], B0[2][2], B1[2][2];
  STAGE_B(SB(0, 0), 0, 0); STAGE_A(SA(0, 0), 0, 0); STAGE_B(SB(0, 1), 1, 0); STAGE_A(SA(0, 1), 1, 0);
  if (wr == 1) BAR;
  WAIT_V(4); BAR;
  STAGE_B(SB(1, 0), 0, 1); STAGE_A(SA(1, 0), 0, 1); STAGE_B(SB(1, 1), 1, 1);
  WAIT_V(6); BAR;
#pragma unroll 1
  for (int t = 0; t < nt - 2; t += 2) {
    LDB(B0, 0, 0); SCHED; LDA(At, 0, 0); STAGE_A(SA(1, 1), 1, t + 1);
    WAIT_L(8); BAR; WAIT_L(0); MMA(0, 0, At, B0); BAR; SCHED;
    LDB(B1, 0, 1); STAGE_B(SB(0, 0), 0, t + 2);
    BAR; WAIT_L(0); MMA(0, 1, At, B1); BAR;
    LDA(At, 0, 1); STAGE_A(SA(0, 0), 0, t + 2);
    BAR; WAIT_L(0); MMA(1, 0, At, B0); BAR; SCHED;
    STAGE_B(SB(0, 1), 1, t + 2);
    WAIT_V(6); BAR; MMA(1, 1, At, B1); BAR;
    LDB(B0, 1, 0); SCHED; LDA(At, 1, 0); STAGE_A(SA(0, 1), 1, t + 2);
    WAIT_L(8); BAR; WAIT_L(0); MMA(0, 0, At, B0); BAR; SCHED;
    LDB(B1, 1, 1); STAGE_B(SB(1, 0), 0, t + 3);
    BAR; WAIT_L(0); MMA(0, 1, At, B1); BAR;
    LDA(At, 1, 1); STAGE_A(SA(1, 0), 0, t + 3);
    BAR; WAIT_L(0); MMA(1, 0, At, B0); BAR; SCHED;
    STAGE_B(SB(1, 1), 1, t + 3);
    WAIT_V(6); BAR; MMA(1, 1, At, B1); BAR;
  }
  { LDB(B0, 0, 0); LDA(At, 0, 0); STAGE_A(SA(1, 1), 1, nt - 1);
    BAR; WAIT_L(0); MMA(0, 0, At, B0); BAR;
    LDB(B1, 0, 1); BAR; WAIT_L(0); MMA(0, 1, At, B1); BAR;
    LDA(At, 0, 1); WAIT_V(4); BAR; WAIT_L(0); MMA(1, 0, At, B0); MMA(1, 1, At, B1); BAR; }
  { LDB(B0, 1, 0); LDA(At, 1, 0); WAIT_V(2); BAR; WAIT_L(0); MMA(0, 0, At, B0); BAR;
    LDB(B1, 1, 1); WAIT_V(0); BAR; WAIT_L(0); MMA(0, 1, At, B1); BAR;
    LDA(At, 1, 1); BAR; WAIT_L(0); MMA(1, 0, At, B0); MMA(1, 1, At, B1); BAR; }
  if (wr == 0) BAR;
#undef SA
#undef SB
}


#define XB_TMO      128
#define XB_XCNT(j)  (256  + 64 * (j))
#define XB_XSUB(j)  (1280 + 64 * (j))
#define XB_XGEN(j)  (2304 + 64 * (j))
#define XB_TOP      3328
#define XB_TOPGEN   3392
#define XCD_BAR_WORDS 3456
#define XB_SPIN_CAP (1u << 18)
__device__ __forceinline__ unsigned xb_ld(unsigned* p)              { return __hip_atomic_load(p, __ATOMIC_RELAXED, __HIP_MEMORY_SCOPE_AGENT); }
__device__ __forceinline__ unsigned xb_add(unsigned* p, unsigned v) { return __hip_atomic_fetch_add(p, v, __ATOMIC_RELAXED, __HIP_MEMORY_SCOPE_AGENT); }
__device__ __forceinline__ unsigned xb_xcc_id() { return (unsigned)__builtin_amdgcn_s_getreg((3 << 11) | 20) & 0xFu; }
#define XB_SPIN(cond, bar) do { unsigned _sp = 0; while (cond) { __builtin_amdgcn_s_sleep(1); \
    if ((++_sp & 255u) == 0u) { if (xb_ld(&(bar)[XB_TMO])) break; if (_sp > XB_SPIN_CAP) { atomicAdd(&(bar)[XB_TMO], 1u); break; } } } } while (0)
struct XcdBarrier { unsigned* bar; unsigned x; volatile LAS unsigned* st; };
__device__ __forceinline__ XcdBarrier xcd_barrier_post(unsigned* bar, volatile LAS unsigned* st) {
  XcdBarrier b; b.bar = bar; b.x = xb_xcc_id(); b.st = st;
  if (threadIdx.x == 0) (void)xb_add(&bar[XB_XCNT(b.x)], 1u);
  return b;
}
__device__ __forceinline__ void xcd_barrier_complete(unsigned* bar, unsigned x, unsigned& nloc, unsigned& nx) {
  const unsigned G = gridDim.x * gridDim.y * gridDim.z;
  unsigned sum, cnt, mine, sp = 0u;
  for (;;) {
    sum = 0u; cnt = 0u; mine = 0u;
#pragma unroll
    for (unsigned j = 0; j < 16; ++j) { const unsigned c = xb_ld(&bar[XB_XCNT(j)]); sum += c; cnt += (c > 0u) ? 1u : 0u; mine = (j == x) ? c : mine; }
    if (sum == G) break;
    __builtin_amdgcn_s_sleep(1);
    if ((++sp & 255u) == 0u) { if (xb_ld(&bar[XB_TMO])) break; if (sp > XB_SPIN_CAP) { atomicAdd(&bar[XB_TMO], 1u); break; } }
  }
  nloc = mine > 0u ? mine : 1u; nx = cnt > 0u ? cnt : 1u;
}
__device__ __forceinline__ void xcd_barrier(unsigned char* ws_) {
  XcdBarrier b; b.bar = (unsigned*)(ws_ + W_BAR); b.x = xb_xcc_id(); b.st = (volatile LAS unsigned*)((LAS unsigned char*)shm + XB_LDS_OFF);
  asm volatile("s_waitcnt vmcnt(0)" ::: "memory");
  __syncthreads();
  if (threadIdx.x == 0) {
    unsigned* bar = b.bar;
    __builtin_amdgcn_s_waitcnt(0);
    unsigned nloc = b.st[0], nx = b.st[1];
    if (nloc == 0u) { xcd_barrier_complete(bar, b.x, nloc, nx); b.st[0] = nloc; b.st[1] = nx; }
    const unsigned old = xb_add(&bar[XB_XSUB(b.x)], 1u);
    const unsigned gen = old / nloc;
    if (old + 1u == (gen + 1u) * nloc) {
      __builtin_amdgcn_fence(__ATOMIC_RELEASE, "agent");
      asm volatile("s_waitcnt vmcnt(0)" ::: "memory");
      const unsigned og = xb_add(&bar[XB_TOP], 1u);
      const unsigned tg = og / nx;
      if (og + 1u == (tg + 1u) * nx) xb_add(&bar[XB_TOPGEN], 1u);
      else XB_SPIN(xb_ld(&bar[XB_TOPGEN]) == tg, bar);
      __builtin_amdgcn_fence(__ATOMIC_ACQUIRE, "agent");
      xb_add(&bar[XB_XGEN(b.x)], 1u);
      asm volatile("s_waitcnt vmcnt(0)" ::: "memory");
    } else {
      XB_SPIN(xb_ld(&bar[XB_XGEN(b.x)]) == gen, bar);
      __builtin_amdgcn_fence(__ATOMIC_ACQUIRE, "agent");
      asm volatile("s_waitcnt vmcnt(0)" ::: "memory");
    }
  }
  __syncthreads();
}

__device__ __forceinline__ bool tile_at(long L, int nM, int nN, int& pm, int& pn) {
  const int nwg = nM * nN;
  if (L >= nwg) return false;
  int wgid = (int)L;
  { const int q = nwg / 8, r = nwg % 8, xcd = wgid % 8, off = wgid / 8; wgid = (xcd < r ? xcd * (q + 1) : r * (q + 1) + (xcd - r) * q) + off; }
  const int nig = 8 * nN, gid = wgid / nig, fm = gid * 8, gsz = (nM - fm) < 8 ? (nM - fm) : 8;
  pm = fm + ((wgid % nig) % gsz); pn = (wgid % nig) / gsz;
  return true;
}
__device__ __forceinline__ bool tile_next(int it, int nM, int nN, int& pm, int& pn) { return tile_at((long)it * gdim_o() + bid_o(), nM, nN, pm, pn); }

#define EPI_ROWS_BEGIN \
  const int wid = tid_o() >> 6, lane = tid_o() & 63, wr = wid >> 2, wc = wid & 3, fr = lane & 15, fq = lane >> 4; \
  _Pragma("unroll") for (int ai = 0; ai < 2; ++ai) _Pragma("unroll") for (int m = 0; m < 4; ++m) { \
    const int row = brow + ai * 128 + wr * 64 + m * 16 + fr;
#define EPI_ROWS_END }

enum { G_GLU = 0, G_FFIN = 1, G_RESID = 2, G_QKV = 3, G_S1 = 4, G_S3 = 5 };

template <int MODE>
__device__ __forceinline__ void gemm_phase(const Params& p, const bf16_t* A, int lda, const bf16_t* Bt, int N, int K, int first = 0) {
  const int nM = (MODE == G_S1 || MODE == G_S3) ? NCH_PAD / 256 : NTM, nN = N / 256, nt = K / BK;
  unsigned char* ws = p.ws;
  const int G = gdim_o(), ks = nt / 4, nsplit = (NTM - SPLIT_PM0) * nN * ks, nMw = (MODE == G_RESID) ? SPLIT_PM0 : nM;
  const int nfull_it = (nMw * nN + G - 1) / G;
#pragma unroll 1
  for (int it = 0;; ++it) {
    int pm, pn; bool split = false; int kt0 = 0, ntu = nt, ksi = 0;
    if (MODE == G_RESID && it >= nfull_it) {
      const int u = (it - nfull_it) * G + bid_o();
      if (u >= nsplit) break;
      ksi = u % ks; const int tq = u / ks; pn = tq % nN; pm = SPLIT_PM0 + tq / nN;
      split = true; kt0 = ksi * 4; ntu = 4;
    } else if (!tile_next(it, nMw, nN, pm, pn)) { if (MODE == G_RESID) continue; else break; }
    const int brow = pm * 256, bcol = pn * 256;
    float rsv[8];
    if (MODE == G_FFIN || MODE == G_QKV) {
      const int tid_ = tid_o(), wr_ = (tid_ >> 6) >> 2, fr_ = tid_ & 15;
      const float* rsp = (const float*)(ws + W_RS) + brow + wr_ * 64 + fr_;
#pragma unroll
      for (int q = 0; q < 8; ++q) rsv[q] = rsp[(q >> 2) * 128 + (q & 3) * 16];
    }
    acc_t acc;
    if (MODE == G_S1) { ARow af; af.init((const bf16_t*)(ws + W_UB) + pn * 512, 16384, brow); gemm_mainloop(acc, af, Bt, K, bcol, nt); }
    else if (MODE == G_S3) { AS3 af; af.init((const bf16_t*)(ws + W_UB), (const bf16_t*)(ws + W_HIN), brow, pn); gemm_mainloop(acc, af, Bt, K, bcol, nt); }
    else { ARow af; af.init(A + kt0 * BK, lda, brow); gemm_mainloop(acc, af, Bt + kt0 * BK, K, bcol, ntu); }
    if (MODE == G_GLU) {
      bf16_t* xb = (bf16_t*)(ws + W_XB);
      EPI_ROWS_BEGIN
        bf16_t* xr = xb + (size_t)row * D;
        const int oc = (bcol >> 1) + wc * 32 + fq * 8;
        f32x4 x0, x1;
        if (first & 1) { const float* xs = xsrc_ptr(p, row); x0 = xs ? *(const f32x4*)(xs + oc) : (f32x4){0.f, 0.f, 0.f, 0.f}; x1 = xs ? *(const f32x4*)(xs + oc + 4) : (f32x4){0.f, 0.f, 0.f, 0.f}; }
        else { const u32x4 raw = *(const u32x4*)(xr + oc); x0 = unpack4((u32x2){raw.x, raw.y}); x1 = unpack4((u32x2){raw.z, raw.w}); }
#pragma unroll
        for (int j = 0; j < 4; ++j) { x0[j] += acc[ai][0][m][0][j] * sigmoidf_(acc[ai][1][m][0][j]); x1[j] += acc[ai][0][m][1][j] * sigmoidf_(acc[ai][1][m][1][j]); }
        u32x4 o; o.x = cvt_pk_bf16(x0[0], x0[1]); o.y = cvt_pk_bf16(x0[2], x0[3]); o.z = cvt_pk_bf16(x1[0], x1[1]); o.w = cvt_pk_bf16(x1[2], x1[3]);
        *(u32x4*)(xr + oc) = o;
      EPI_ROWS_END
    } else if (MODE == G_FFIN) {
      bf16_t* hb = (bf16_t*)(ws + W_HB); const float* rs = (const float*)(ws + W_RS);
      EPI_ROWS_BEGIN
        const float s = rsv[ai * 4 + m];
        const int oc = (bcol >> 1) + wc * 32 + fq * 8;
        float hv[8];
#pragma unroll
        for (int n = 0; n < 2; ++n)
#pragma unroll
          for (int j = 0; j < 4; ++j) { const float gt = acc[ai][0][m][n][j] * s, up = acc[ai][1][m][n][j] * s; hv[n * 4 + j] = gt * sigmoidf_(gt) * up; }
        u32x4 o; o.x = cvt_pk_bf16(hv[0], hv[1]); o.y = cvt_pk_bf16(hv[2], hv[3]); o.z = cvt_pk_bf16(hv[4], hv[5]); o.w = cvt_pk_bf16(hv[6], hv[7]);
        *(u32x4*)(hb + (size_t)row * FF + oc) = o;
      EPI_ROWS_END
    } else if (MODE == G_RESID) {
      bf16_t* xb = (bf16_t*)(ws + W_XB);
      EPI_ROWS_BEGIN
        bf16_t* xr = xb + (size_t)row * D;
#pragma unroll
        for (int bj = 0; bj < 2; ++bj)
#pragma unroll
          for (int n = 0; n < 2; ++n) {
            const int oc = bcol + bj * 128 + wc * 32 + n * 16 + fq * 4;
            if (split) {
              *(f32x4*)((float*)(ws + W_PART) + ((size_t)ksi * SPLIT_ROWS + (row - SPLIT_ROW0)) * D + oc) = acc[ai][bj][m][n];
            } else {
              f32x4 x = unpack4(*(const u32x2*)(xr + oc));
              x += acc[ai][bj][m][n];
              if (first & 2) *(f32x4*)(xrow_ptr(p, row) + oc) = x;
              else { u32x2 o; o.x = cvt_pk_bf16(x[0], x[1]); o.y = cvt_pk_bf16(x[2], x[3]); *(u32x2*)(xr + oc) = o; }
            }
          }
      EPI_ROWS_END
    } else if (MODE == G_QKV) {
      bf16_t* qb = (bf16_t*)(ws + W_UB); float* kv = (float*)(ws + W_KVRAW); const float* rs = (const float*)(ws + W_RS);
      EPI_ROWS_BEGIN
        const float s = rsv[ai * 4 + m];
#pragma unroll
        for (int bj = 0; bj < 2; ++bj)
#pragma unroll
          for (int n = 0; n < 2; ++n) {
            const int oc = bcol + bj * 128 + wc * 32 + n * 16 + fq * 4;
            const f32x4 v = acc[ai][bj][m][n] * s;
            if (bcol < 1024) { u32x2 o; o.x = cvt_pk_bf16(v[0], v[1]); o.y = cvt_pk_bf16(v[2], v[3]); *(u32x2*)(qb + (size_t)row * D + oc) = o; }
            else *(f32x4*)(kv + (size_t)row * 512 + (oc - 1024)) = v;
          }
      EPI_ROWS_END
    } else if (MODE == G_S1) {
      float* sb = (float*)(ws + W_SB);
      EPI_ROWS_BEGIN
#pragma unroll
        for (int bj = 0; bj < 2; ++bj)
#pragma unroll
          for (int n = 0; n < 2; ++n) {
            const int oc = bcol + bj * 128 + wc * 32 + n * 16 + fq * 4;
            *(f32x4*)(sb + (size_t)row * 8192 + oc) = acc[ai][bj][m][n];
          }
      EPI_ROWS_END
    } else if (MODE == G_S3) {
      bf16_t* yg = (bf16_t*)(ws + W_YG);
      EPI_ROWS_BEGIN
        const bool valid = row < NCH && row != 1025;
        const int tr = chunk_row(row);
        if (valid) {
#pragma unroll
          for (int bj = 0; bj < 2; ++bj)
#pragma unroll
            for (int n = 0; n < 2; ++n) {
              const int t = bj * 8 + wc * 2 + n;
              const f32x4 v = acc[ai][bj][m][n];
              u32x2 o; o.x = cvt_pk_bf16(gelu_tanh(v[0]), gelu_tanh(v[1])); o.y = cvt_pk_bf16(gelu_tanh(v[2]), gelu_tanh(v[3]));
              *(u32x2*)(yg + (size_t)(tr + t) * D + pn * 16 + fq * 4) = o;
            }
        }
      EPI_ROWS_END
    }
    __builtin_amdgcn_s_barrier();
  }
}

__device__ __forceinline__ int perm32(int rho) { return 8 * ((rho & 15) >> 2) + 4 * (rho >> 4) + (rho & 3); }
__device__ __forceinline__ int srccol(int np, int mode, int Nh) {
  if (mode == 0) return np;
  const int t256 = np >> 8, r = np & 255, bj = r >> 7, r128 = r & 127, out = t256 * 128 + (r128 & ~31) + perm32(r128 & 31);
  return bj ? Nh + out : out;
}
__device__ __forceinline__ void transpose_tile(const float* W, int K, int N, bf16_t* Wt, int np0, int k0, int mode, int Nh, const float* gain) {
  float* tile = (float*)shm;
  const int tid = tid_o(), c4 = tid & 63, r0 = tid >> 6;
  const int sc = srccol(np0 + c4 * 4, mode, Nh);
  f32x4 v[8];
#pragma unroll
  for (int q = 0; q < 8; ++q) v[q] = *(const f32x4*)(W + (size_t)(k0 + r0 + q * 8) * N + sc);
#pragma unroll
  for (int q = 0; q < 8; ++q) { const int r = r0 + q * 8; const float g = gain ? gain[k0 + r] : 1.f; float* t = tile + r * 257 + c4 * 4; t[0] = v[q].x * g; t[1] = v[q].y * g; t[2] = v[q].z * g; t[3] = v[q].w * g; }
  __syncthreads();
#pragma unroll
  for (int q = 0; q < 4; ++q) {
    const int e = tid + q * 512, n = e & 255, ks = e >> 8;
    const float* s = tile + (ks * 8) * 257 + n;
    u32x4 o; o.x = cvt_pk_bf16(s[0], s[257]); o.y = cvt_pk_bf16(s[2 * 257], s[3 * 257]); o.z = cvt_pk_bf16(s[4 * 257], s[5 * 257]); o.w = cvt_pk_bf16(s[6 * 257], s[7 * 257]);
    *(u32x4*)(Wt + (size_t)(np0 + n) * K + k0 + ks * 8) = o;
  }
  __syncthreads();
}

__device__ __forceinline__ void weights_phase(const Params& p) {
  unsigned char* ws = p.ws;
  const int total = 2 * 128 + 4 * 352 + 4 * 176 + 64 + 32 + 64 + 2 * 64;
  unsigned* qctr = (unsigned*)(ws + W_BAR) + 3600;
  volatile LAS int* qslot = (volatile LAS int*)((LAS unsigned char*)shm + XB_LDS_OFF + 8);
  for (;;) {
    __syncthreads();
    if (tid_o() == 0) *qslot = (int)__hip_atomic_fetch_add(qctr, 1u, __ATOMIC_RELAXED, __HIP_MEMORY_SCOPE_AGENT);
    __syncthreads();
    const int t = *qslot;
    if (t >= total) break;
    int r = t; const float* W; int K, N, mode = 0, Nh = 0; const float* gain = nullptr; bf16_t* dst;
    if (r < 256) { const int l = r / 128; r -= l * 128; W = p.in[17] + (size_t)l * 1024 * 2048; K = 1024; N = 2048; mode = 1; Nh = 1024; dst = (bf16_t*)(ws + W_WGLU) + (size_t)l * 2048 * 1024; }
    else if ((r -= 256) < 1408) { const int l = r / 352; r -= l * 352; W = p.in[18] + (size_t)l * 1024 * 5632; K = 1024; N = 5632; mode = 1; Nh = FF; gain = p.in[8] + l * D; dst = (bf16_t*)(ws + W_WIN) + (size_t)l * 5632 * 1024; }
    else if ((r -= 1408) < 704) { const int l = r / 176; r -= l * 176; W = p.in[19] + (size_t)l * FF * 1024; K = FF; N = 1024; dst = (bf16_t*)(ws + W_WOUT) + (size_t)l * 1024 * FF; }
    else if ((r -= 704) < 64) { W = p.in[23]; K = 1024; N = 1024; gain = p.in[7] + 2 * D; dst = (bf16_t*)(ws + W_WQKV); }
    else if ((r -= 64) < 32) { W = p.in[21]; K = 1024; N = 512; gain = p.in[20]; dst = (bf16_t*)(ws + W_WQKV) + (size_t)1024 * 1024; }
    else if ((r -= 32) < 64) { W = p.in[23] + (size_t)1024 * 1024; K = 1024; N = 1024; gain = p.in[7] + 3 * D; dst = (bf16_t*)(ws + W_WQKV) + (size_t)1536 * 1024; }
    else { r -= 64; const int l = r / 64; r -= l * 64; W = p.in[26] + (size_t)l * 1024 * 1024; K = 1024; N = 1024; dst = (bf16_t*)(ws + W_WO) + (size_t)l * 1024 * 1024; }
    const int nkt = K / 64, kt = r % nkt, nb = r / nkt;
    transpose_tile(W, K, N, dst, nb * 256, kt * 64, mode, Nh, gain);
  }
}

__device__ __forceinline__ void s5_matrices(const Params& p, int l, int g) {
  float* L = (float*)shm;
  float* apr = L;
  float* api = apr + 64 * 17;
  float* bbr = api + 64 * 17;
  float* bbi = bbr + 1024;
  float* ccr = bbi + 1024;
  float* cci = ccr + 1024;
  float* fre = cci + 1024;
  float* fim = fre + 64;
  float* Kv = fim + 64;
  const int tid = tid_o();
  unsigned char* ws = p.ws;
  const size_t lg = (size_t)l * 64 + g;
  if (tid < 64) {
    const int pp = tid;
    const double dt = exp((double)p.in[11][lg]);
    const double are = p.in[9][lg * 64 + pp], aim = p.in[10][lg * 64 + pp];
    const double mg = exp(are * dt), an = aim * dt, br = mg * cos(an), bi = mg * sin(an);
    { double pr = 1.0, pi = 0.0;
      for (int j = 0; j <= 16; ++j) { apr[pp * 17 + j] = (float)pr; api[pp * 17 + j] = (float)pi; const double t = pr * br - pi * bi; pi = pr * bi + pi * br; pr = t; } }
    const double nr = br - 1.0, ni = bi, inv = 1.0 / (are * are + aim * aim);
    fre[pp] = (float)((nr * are + ni * aim) * inv); fim[pp] = (float)((ni * are - nr * aim) * inv);
    float* a16 = (float*)(ws + W_A16) + (lg * 64 + pp) * 2;
    a16[0] = apr[pp * 17 + 16]; a16[1] = api[pp * 17 + 16];
  }
  __syncthreads();
  for (int e = tid; e < 1024; e += 512) {
    const int pp = e >> 4;
    const float br = p.in[12][lg * 1024 + e], bi = p.in[13][lg * 1024 + e];
    bbr[e] = fre[pp] * br - fim[pp] * bi; bbi[e] = fre[pp] * bi + fim[pp] * br;
    ccr[e] = p.in[14][lg * 1024 + e]; cci[e] = p.in[15][lg * 1024 + e];
  }
  __syncthreads();
  for (int e = tid; e < 4096; e += 512) {
    const int j = e >> 8, cp = (e >> 4) & 15, c = e & 15;
    float s = 0.f;
    for (int pp = 0; pp < 64; ++pp) {
      const float xr = ccr[cp * 64 + pp] * apr[pp * 17 + j] - cci[cp * 64 + pp] * api[pp * 17 + j];
      const float xi = ccr[cp * 64 + pp] * api[pp * 17 + j] + cci[cp * 64 + pp] * apr[pp * 17 + j];
      s += xr * bbr[pp * 16 + c] - xi * bbi[pp * 16 + c];
    }
    if (j == 0 && cp == c) s += p.in[16][lg * 16 + c];
    Kv[e] = s;
  }
  __syncthreads();
  bf16_t* bs3 = (bf16_t*)(ws + W_BS3) + ((size_t)l * 16384 + (size_t)g * 256) * 384;
  for (int e = tid; e < 256 * 48; e += 512) {
    const int n = e / 48, k8 = e % 48, t = n >> 4, cp = n & 15;
    float v[8];
    if (k8 < 32) {
      const int s = k8 >> 1, c0 = (k8 & 1) * 8;
#pragma unroll
      for (int i = 0; i < 8; ++i) v[i] = (s <= t) ? Kv[((t - s) * 16 + cp) * 16 + c0 + i] : 0.f;
    } else {
      const int kk = (k8 - 32) * 8;
#pragma unroll
      for (int i = 0; i < 8; ++i) {
        const int q = kk + i, pp = q & 63;
        const float cr = ccr[cp * 64 + pp], ci = cci[cp * 64 + pp], ar = apr[pp * 17 + t + 1], ai = api[pp * 17 + t + 1];
        v[i] = q < 64 ? (cr * ar - ci * ai) : -(cr * ai + ci * ar);
      }
    }
    u32x4 o; o.x = cvt_pk_bf16(v[0], v[1]); o.y = cvt_pk_bf16(v[2], v[3]); o.z = cvt_pk_bf16(v[4], v[5]); o.w = cvt_pk_bf16(v[6], v[7]);
    *(u32x4*)(bs3 + (size_t)n * 384 + k8 * 8) = o;
  }
  bf16_t* bs1 = (bf16_t*)(ws + W_BS1) + ((size_t)l * 8192 + (size_t)(g >> 1) * 256 + (g & 1) * 128) * 512;
  for (int e = tid; e < 128 * 64; e += 512) {
    const int jn = e >> 6, k8 = e & 63, k = k8 * 8, pp = jn & 63;
    float v[8];
    if ((k >> 8) == (g & 1)) {
      const int s = (k & 255) >> 4, c0 = k & 15;
      const float ar = apr[pp * 17 + 15 - s], ai = api[pp * 17 + 15 - s];
#pragma unroll
      for (int i = 0; i < 8; ++i) {
        const float br = bbr[pp * 16 + c0 + i], bi = bbi[pp * 16 + c0 + i];
        v[i] = jn < 64 ? (ar * br - ai * bi) : (ar * bi + ai * br);
      }
    } else {
#pragma unroll
      for (int i = 0; i < 8; ++i) v[i] = 0.f;
    }
    u32x4 o; o.x = cvt_pk_bf16(v[0], v[1]); o.y = cvt_pk_bf16(v[2], v[3]); o.z = cvt_pk_bf16(v[4], v[5]); o.w = cvt_pk_bf16(v[6], v[7]);
    *(u32x4*)(bs1 + (size_t)jn * 512 + k) = o;
  }
  __syncthreads();
}

__device__ __forceinline__ size_t kf_off(int krow, int kvh, int kk, int hh) { return ((((size_t)(krow >> 5) * 4 + kvh) * 4 + kk) * 64 + hh * 32 + (krow & 31)) * 8; }
__device__ __forceinline__ size_t vf_off(int krow, int kvh, int d) {
  const int kin = krow & 15, hh = (kin >> 2) & 1, j = (kin >> 3) * 4 + (kin & 3);
  return ((((size_t)(krow >> 4) * 4 + kvh) * 2 + (d >> 5)) * 64 + hh * 32 + (d & 31)) * 8 + j;
}
__device__ __forceinline__ void cache_phase(const Params& p) {
  unsigned char* ws = p.ws;
  bf16_t* kb = (bf16_t*)(ws + W_KB); bf16_t* vt = (bf16_t*)(ws + W_VT);
  const int gt = bid_o() * 512 + tid_o(), nth = gdim_o() * 512;
  for (int e = gt; e < 32 * 128 * 32; e += nth) {
    const int i = e / (128 * 32), w = (e / 32) % 128, c8 = e % 32, kvh = c8 >> 3, d0 = (c8 & 7) * 8;
    const int krow = KS_BASE + i * 160 + w;
    const float* s = p.in[4] + ((size_t)i * 128 + w) * 256 + c8 * 8;
    const f32x4 a = *(const f32x4*)s, b = *(const f32x4*)(s + 4);
    u32x4 o; o.x = cvt_pk_bf16(a.x, a.y); o.y = cvt_pk_bf16(a.z, a.w); o.z = cvt_pk_bf16(b.x, b.y); o.w = cvt_pk_bf16(b.z, b.w);
    *(u32x4*)(kb + kf_off(krow, kvh, d0 >> 4, (d0 >> 3) & 1)) = o;
  }
  for (int e = gt; e < 32 * 128 * 256; e += nth) {
    const int i = e / (128 * 256), w = (e / 256) % 128, c = e % 256;
    vt[vf_off(KS_BASE + i * 160 + w, c >> 6, c & 63)] = f2bf(p.in[5][e]);
  }
}

template <int MODE>
__device__ __forceinline__ void norm_phase(const Params& p, const float* gain, int nks) {
  unsigned char* ws = p.ws;
  const int lane = tid_o() & 63, wv = tid_o() >> 6;
  bf16_t* ub = (bf16_t*)(ws + W_UB); float* rs = (float*)(ws + W_RS);
  if (MODE == 2) {
    const bf16_t* xb = (const bf16_t*)(ws + W_XB);
    for (int row = (bid_o() * 8 + wv) * 4; row < SPLIT_ROW0; row += gdim_o() * 32) {
      u32x2 raw[4][4];
#pragma unroll
      for (int q = 0; q < 4; ++q)
#pragma unroll
        for (int j = 0; j < 4; ++j) raw[q][j] = *(const u32x2*)(xb + (size_t)(row + q) * D + (lane + 64 * j) * 4);
#pragma unroll
      for (int q = 0; q < 4; ++q) {
        float s = 0.f;
#pragma unroll
        for (int j = 0; j < 4; ++j) { const f32x4 v = unpack4(raw[q][j]); s += (v.x * v.x + v.y * v.y) + (v.z * v.z + v.w * v.w); }
        const float r = rsqrtf(wave_sum(s, lane) * (1.f / D) + 1e-6f);
        if (lane == 0) rs[row + q] = r;
      }
    }
  }
  for (int row = ((MODE == 3 || MODE == 2) ? SPLIT_ROW0 : 0) + bid_o() * 8 + wv; row < R_PAD; row += gdim_o() * 8) {
    float* xr = xrow_ptr(p, row);
    f32x4 v[4];
    if (MODE == 0) {
      const float* src = xsrc_ptr(p, row);
#pragma unroll
      for (int j = 0; j < 4; ++j) v[j] = src ? *(const f32x4*)(src + (lane + 64 * j) * 4) : (f32x4){0.f, 0.f, 0.f, 0.f};
    } else {
      bf16_t* xbr = (bf16_t*)(ws + W_XB) + (size_t)row * D;
#pragma unroll
      for (int j = 0; j < 4; ++j) v[j] = unpack4(*(const u32x2*)(xbr + (lane + 64 * j) * 4));
      if (nks > 0 && row >= SPLIT_ROW0) {
        const float* pp = (const float*)(ws + W_PART) + (size_t)(row - SPLIT_ROW0) * D + lane * 4;
        for (int k = 0; k < nks; k += 4) {
          f32x4 t[4][4];
#pragma unroll
          for (int kk = 0; kk < 4; ++kk)
#pragma unroll
            for (int j = 0; j < 4; ++j) t[kk][j] = (k + kk < nks) ? *(const f32x4*)(pp + (size_t)(k + kk) * SPLIT_ROWS * D + 256 * j) : (f32x4){0.f, 0.f, 0.f, 0.f};
#pragma unroll
          for (int kk = 0; kk < 4; ++kk)
#pragma unroll
            for (int j = 0; j < 4; ++j) v[j] += t[kk][j];
        }
        if (MODE == 3) {
#pragma unroll
          for (int j = 0; j < 4; ++j) *(f32x4*)(xr + (lane + 64 * j) * 4) = v[j];
        } else {
#pragma unroll
          for (int j = 0; j < 4; ++j) { u32x2 o; o.x = cvt_pk_bf16(v[j].x, v[j].y); o.y = cvt_pk_bf16(v[j].z, v[j].w); *(u32x2*)(xbr + (lane + 64 * j) * 4) = o; }
        }
      }
    }
    if (MODE == 3) continue;
    float s = 0.f;
#pragma unroll
    for (int j = 0; j < 4; ++j) s += (v[j].x * v[j].x + v[j].y * v[j].y) + (v[j].z * v[j].z + v[j].w * v[j].w);
    const float r = rsqrtf(wave_sum(s, lane) * (1.f / D) + 1e-6f);
    if (MODE == 2) {
      if (lane == 0) rs[row] = r;
    }
    else {
#pragma unroll
      for (int j = 0; j < 4; ++j) {
        const f32x4 gg = *(const f32x4*)(gain + (lane + 64 * j) * 4);
        u32x2 o; o.x = cvt_pk_bf16(v[j].x * r * gg.x, v[j].y * r * gg.y); o.y = cvt_pk_bf16(v[j].z * r * gg.z, v[j].w * r * gg.w);
        const int col0 = (lane + 64 * j) * 4;
        if (row < R_REAL) {
          int cgi, s_;
          if (row < R_SAMPLE) { const int b_ = row >> 14, t = row & 16383; cgi = b_ * 1025 + 1 + (t >> 4); s_ = t & 15; }
          else if (row < R_META) { const int q = row - R_SAMPLE; cgi = 2050 + (q >> 4); s_ = q & 15; }
          else { cgi = 0; s_ = row - R_META; }
          const size_t off = (size_t)cgi * 16384 + (col0 >> 4) * 256 + s_ * 16 + (col0 & 15);
          *(u32x2*)(ub + off) = o;
          if (row >= R_META) *(u32x2*)(ub + off + (size_t)1025 * 16384) = o;
        }
      }
    }
  }
}

__device__ __forceinline__ void s2_phase(const Params& p, int l) {
  unsigned char* ws = p.ws;
  const float* sb = (const float*)(ws + W_SB); bf16_t* hin = (bf16_t*)(ws + W_HIN);
  const int lane = tid_o() & 63, wv = tid_o() >> 6;
  float* ex = (float*)shm;
  constexpr int SEG = 129;
  for (int item = bid_o(); item < 128; item += gdim_o()) {
    const int b = item >> 6, g = item & 63;
    const float* a16 = (const float*)(ws + W_A16) + (((size_t)l * 64 + g) * 64 + lane) * 2;
    const float ar = a16[0], ai = a16[1];
    const int c0 = wv * SEG, c1 = (c0 + SEG) < 1025 ? (c0 + SEG) : 1025;
    const float* sp = sb + (size_t)(b * 1025) * 8192 + g * 128 + lane;
    bf16_t* hp = hin + (size_t)(b * 1025) * 8192 + g * 128 + lane;
    float hr = 0.f, hi = 0.f;
    {
      int c = c0;
      float sr[8], si[8], pr[8], pi[8];
      if (c + 8 <= c1) {
#pragma unroll
        for (int u = 0; u < 8; ++u) { sr[u] = sp[(size_t)(c + u) * 8192]; si[u] = sp[(size_t)(c + u) * 8192 + 64]; }
      }
      for (; c + 8 <= c1; c += 8) {
        const bool more = c + 16 <= c1;
        if (more) {
#pragma unroll
          for (int u = 0; u < 8; ++u) { pr[u] = sp[(size_t)(c + 8 + u) * 8192]; pi[u] = sp[(size_t)(c + 8 + u) * 8192 + 64]; }
        }
#pragma unroll
        for (int u = 0; u < 8; ++u) { const float nr = ar * hr - ai * hi + sr[u], ni = ar * hi + ai * hr + si[u]; hr = nr; hi = ni; }
#pragma unroll
        for (int u = 0; u < 8; ++u) { sr[u] = pr[u]; si[u] = pi[u]; }
      }
      for (; c < c1; ++c) { const float sr = sp[(size_t)c * 8192], si = sp[(size_t)c * 8192 + 64]; const float nr = ar * hr - ai * hi + sr, ni = ar * hi + ai * hr + si; hr = nr; hi = ni; }
    }
    ex[(wv * 2) * 64 + lane] = hr; ex[(wv * 2 + 1) * 64 + lane] = hi;
    float qr = ar, qi = ai;
#pragma unroll
    for (int s = 0; s < 7; ++s) { const float t = qr * qr - qi * qi; qi = 2.f * qr * qi; qr = t; }
    { const float t = qr * ar - qi * ai; qi = qr * ai + qi * ar; qr = t; }
    __syncthreads();
    hr = 0.f; hi = 0.f;
    for (int j = 0; j < wv; ++j) { const float er = ex[(j * 2) * 64 + lane], ei = ex[(j * 2 + 1) * 64 + lane]; const float nr = qr * hr - qi * hi + er, ni = qr * hi + qi * hr + ei; hr = nr; hi = ni; }
    {
      int c = c0;
      float sr[8], si[8], pr[8], pi[8];
      if (c + 8 <= c1) {
#pragma unroll
        for (int u = 0; u < 8; ++u) { sr[u] = sp[(size_t)(c + u) * 8192]; si[u] = sp[(size_t)(c + u) * 8192 + 64]; }
      }
      for (; c + 8 <= c1; c += 8) {
        const bool more = c + 16 <= c1;
        if (more) {
#pragma unroll
          for (int u = 0; u < 8; ++u) { pr[u] = sp[(size_t)(c + 8 + u) * 8192]; pi[u] = sp[(size_t)(c + 8 + u) * 8192 + 64]; }
        }
#pragma unroll
        for (int u = 0; u < 8; ++u) {
          hp[(size_t)(c + u) * 8192] = f2bf(hr); hp[(size_t)(c + u) * 8192 + 64] = f2bf(hi);
          const float nr = ar * hr - ai * hi + sr[u], ni = ar * hi + ai * hr + si[u]; hr = nr; hi = ni;
        }
#pragma unroll
        for (int u = 0; u < 8; ++u) { sr[u] = pr[u]; si[u] = pi[u]; }
      }
      for (; c < c1; ++c) {
        const float sr = sp[(size_t)c * 8192], si = sp[(size_t)c * 8192 + 64];
        hp[(size_t)c * 8192] = f2bf(hr); hp[(size_t)c * 8192 + 64] = f2bf(hi);
        const float nr = ar * hr - ai * hi + sr, ni = ar * hi + ai * hr + si; hr = nr; hi = ni;
      }
    }
    if (wv == 7) {
      p.out[O_PRE + (((size_t)l * NB + b) * 64 + g) * 64 + lane] = hr; p.out[O_PIM + (((size_t)l * NB + b) * 64 + g) * 64 + lane] = hi;
    }
    __syncthreads();
  }
  for (int q = bid_o() * 8 + wv; q < 2048; q += gdim_o() * 8) {
    const int i = q >> 6, g = q & 63, c0 = 2050 + 2 * i;
    const size_t so = (((size_t)l * DB + i) * 64 + g) * 64 + lane;
    float hr = p.in[2][so], hi = p.in[3][so];
    const float* a16 = (const float*)(ws + W_A16) + (((size_t)l * 64 + g) * 64 + lane) * 2;
    const float ar = a16[0], ai = a16[1];
    const float* sp = sb + (size_t)c0 * 8192 + g * 128 + lane;
    bf16_t* hp = hin + (size_t)c0 * 8192 + g * 128 + lane;
#pragma unroll
    for (int c = 0; c < 2; ++c) {
      const float sr = sp[(size_t)c * 8192], si = sp[(size_t)c * 8192 + 64];
      hp[(size_t)c * 8192] = f2bf(hr); hp[(size_t)c * 8192 + 64] = f2bf(hi);
      const float nr = ar * hr - ai * hi + sr, ni = ar * hi + ai * hr + si; hr = nr; hi = ni;
    }
    p.out[O_SRE + so] = hr; p.out[O_SIM + so] = hi;
  }
}

__device__ __forceinline__ void kvfin_phase(const Params& p) {
  unsigned char* ws = p.ws;
  const float* kv = (const float*)(ws + W_KVRAW); bf16_t* kb = (bf16_t*)(ws + W_KB); bf16_t* vt = (bf16_t*)(ws + W_VT);
  const int lane = tid_o() & 63, wv = tid_o() >> 6;
  for (int row = bid_o() * 8 + wv; row < R_REAL; row += gdim_o() * 8) {
    const float* src = kv + (size_t)row * 512 + lane * 8;
    const f32x4 a = *(const f32x4*)src, b = *(const f32x4*)(src + 4);
    float v[8] = {a.x, a.y, a.z, a.w, b.x, b.y, b.z, b.w};
    const int col = (lane & 31) * 8, kvh = col >> 6, d0 = col & 63;
    int krow; float* ok = nullptr; float* ov = nullptr;
    if (row < R_SAMPLE) { const int b_ = row >> 14, t = row & 16383; krow = row;
      if (t >= SEQ - 128) { ok = p.out + O_PK + ((size_t)b_ * 128 + (t - (SEQ - 128))) * 256; ov = p.out + O_PV + ((size_t)b_ * 128 + (t - (SEQ - 128))) * 256; } }
    else if (row < R_META) { const int q = row - R_SAMPLE, i = q >> 5, j = q & 31; krow = KS_BASE + i * 160 + 128 + j;
      ok = p.out + O_SK + (size_t)q * 256; ov = p.out + O_SV + (size_t)q * 256; }
    else { krow = KM_BASE + (row - R_META); }
    if (lane < 32) {
      float s = 0.f;
#pragma unroll
      for (int i = 0; i < 8; ++i) s += v[i] * v[i];
      s += shx(s, 1, lane); s += shx(s, 2, lane); s += shx(s, 4, lane);
      const float r = rsqrtf(s * (1.f / 64.f) + 1e-6f);
#pragma unroll
      for (int i = 0; i < 8; ++i) v[i] = v[i] * r * p.in[22][d0 + i];
      u32x4 o; o.x = cvt_pk_bf16(v[0], v[1]); o.y = cvt_pk_bf16(v[2], v[3]); o.z = cvt_pk_bf16(v[4], v[5]); o.w = cvt_pk_bf16(v[6], v[7]);
      *(u32x4*)(kb + kf_off(krow, kvh, d0 >> 4, (d0 >> 3) & 1)) = o;
      if (ok) { *(f32x4*)(ok + col) = (f32x4){v[0], v[1], v[2], v[3]}; *(f32x4*)(ok + col + 4) = (f32x4){v[4], v[5], v[6], v[7]}; }
    } else {
      float s = 0.f; s += shx(s, 1, lane); s += shx(s, 2, lane); s += shx(s, 4, lane);
#pragma unroll
      for (int i = 0; i < 8; ++i) vt[vf_off(krow, kvh, d0 + i)] = f2bf(v[i]);
      if (ov) { *(f32x4*)(ov + col) = (f32x4){v[0], v[1], v[2], v[3]}; *(f32x4*)(ov + col + 4) = (f32x4){v[4], v[5], v[6], v[7]}; }
    }
  }
}

__device__ __forceinline__ int rel_bucket(int rel) {
  const int n = rel < 0 ? -rel : rel;
  const float nf = (float)(n < 1 ? 1 : n);
  int large = 8 + (int)(logf(nf / 8.f) / 2.772588722239781f * 8.f);
  large = large < 15 ? large : 15;
  return (rel > 0 ? 16 : 0) + (n < 8 ? n : large);
}

struct AttnItem { int kvh, nt_band, ktile0, sj0, tpos, qrow0, qi0, head; bool active; };
__device__ __forceinline__ AttnItem attn_item(int item, int wv) {
  AttnItem a;
  if (item < 2048) {
    const int b = item >> 10, n = (item >> 2) & 255; a.kvh = item & 3; a.head = a.kvh * 4 + (wv >> 1); const int qt = wv & 1;
    a.qi0 = qt * 32; a.qrow0 = b * SEQ + n * 64 + a.qi0; a.tpos = n * 64 + a.qi0;
    const int c0 = n >= 2 ? n - 2 : 0;
    a.nt_band = (n - c0 + 1) * 2;
    a.ktile0 = (b * SEQ + c0 * 64) >> 5;
    a.sj0 = n >= 2 ? 0 : (2 - n) * 64; a.active = true;
  } else {
    const int q = item - 2048, i = q >> 2; a.kvh = q & 3; a.head = a.kvh * 4 + (wv & 3); a.active = wv < 4;
    a.qi0 = 0; a.qrow0 = R_SAMPLE + i * 32; a.tpos = 1024; a.nt_band = 5;
    a.ktile0 = (KS_BASE + i * 160) >> 5; a.sj0 = 0;
  }
  return a;
}
constexpr int AT_BUF0 = 16896, AT_KV = 28672, AT_BUF = 2 * AT_KV;
__device__ __forceinline__ void attn_stage(const bf16_t* kb, const bf16_t* vt, int item, int buf, int wv, int lane) {
  const AttnItem a = attn_item(item, 0);
  LAS unsigned char* lds = (LAS unsigned char*)shm + AT_BUF0 + buf * AT_BUF;
#pragma unroll
  for (int t = 0; t < 7; ++t) {
    if (t <= a.nt_band) {
      const int T = t == 0 ? (KM_BASE >> 5) : a.ktile0 + (t - 1);
      const bf16_t* src; unsigned dst;
      if (wv < 4) { src = kb + ((((size_t)T * 4 + a.kvh) * 4 + wv) * 64 + lane) * 8; dst = t * 4096 + wv * 1024; }
      else { const int s = (wv - 4) >> 1, dt = (wv - 4) & 1; src = vt + (((((size_t)T * 2 + s) * 4 + a.kvh) * 2 + dt) * 64 + lane) * 8; dst = AT_KV + t * 4096 + (wv - 4) * 1024; }
      __builtin_amdgcn_global_load_lds((const unsigned*)src, (LAS unsigned*)(lds + dst), 16, 0, 0);
    }
  }
}

__device__ __forceinline__ void attn_phase(const Params& p, int jl) {
  unsigned char* ws = p.ws;
  float* lut = (float*)shm;
  float* qg = lut + 16 * 256;
  for (int e = tid_o(); e < 16 * 256; e += 512) {
    const int h = e >> 8, idx = e & 255; const int rel = idx - 191;
    lut[e] = idx < 255 ? p.in[27][rel_bucket(rel) * 16 + h] * 1.44269504089f : 0.f;
  }
  if (tid_o() < 64) qg[tid_o()] = p.in[24][jl * 64 + tid_o()] * (0.125f * 1.44269504089f);
  const bf16_t* qb = (const bf16_t*)(ws + W_UB); const bf16_t* kb = (const bf16_t*)(ws + W_KB); const bf16_t* vt = (const bf16_t*)(ws + W_VT);
  bf16_t* ao = (bf16_t*)(ws + W_YG);
  const int tid = tid_o(), lane = tid & 63, wv = __builtin_amdgcn_readfirstlane(tid >> 6), ql = lane & 31, hh = lane >> 5;
  const int G = gdim_o(), item0 = bid_o(), NITEM = 2048 + 128;
  u32x4 qraw[4];
  if (item0 < NITEM) {
    attn_stage(kb, vt, item0, 0, wv, lane);
    const AttnItem a = attn_item(item0, wv);
    const bf16_t* qp = qb + (size_t)(a.qrow0 + ql) * D + a.head * 64 + hh * 8;
#pragma unroll
    for (int kk = 0; kk < 4; ++kk) qraw[kk] = *(const u32x4*)(qp + kk * 16);
  }
  int cur = 0;
#pragma unroll 1
  for (int item = item0; item < NITEM; item += G, cur ^= 1) {
    asm volatile("s_waitcnt vmcnt(0)" ::: "memory");
    __syncthreads();
    const AttnItem a = attn_item(item, wv);
    u32x4 qcur[4];
#pragma unroll
    for (int kk = 0; kk < 4; ++kk) qcur[kk] = qraw[kk];
    if (item + G < NITEM) {
      attn_stage(kb, vt, item + G, cur ^ 1, wv, lane);
      const AttnItem an = attn_item(item + G, wv);
      const bf16_t* qp = qb + (size_t)(an.qrow0 + ql) * D + an.head * 64 + hh * 8;
#pragma unroll
      for (int kk = 0; kk < 4; ++kk) qraw[kk] = *(const u32x4*)(qp + kk * 16);
    }
    if (!a.active) continue;
    const int head = a.head, nt_band = a.nt_band, sj0 = a.sj0, qi0 = a.qi0, tpos = a.tpos, qrow0 = a.qrow0;
    const LAS unsigned char* kl = (const LAS unsigned char*)shm + AT_BUF0 + cur * AT_BUF + lane * 16;
    bf16x8 qf[4];
    {
      float qv[32]; float s = 0.f;
#pragma unroll
      for (int kk = 0; kk < 4; ++kk) {
        const unsigned w[4] = {qcur[kk].x, qcur[kk].y, qcur[kk].z, qcur[kk].w};
#pragma unroll
        for (int i = 0; i < 4; ++i) { qv[kk * 8 + 2 * i] = bf2f(w[i] & 0xffffu); qv[kk * 8 + 2 * i + 1] = bf2f(w[i] >> 16); }
      }
#pragma unroll
      for (int i = 0; i < 32; ++i) s += qv[i] * qv[i];
      s += shx(s, 32, lane);
      const float r = rsqrtf(s * (1.f / 64.f) + 1e-6f);
#pragma unroll
      for (int kk = 0; kk < 4; ++kk) {
        u32x4 o; const float* g8 = qg + kk * 16 + hh * 8;
        o.x = cvt_pk_bf16(qv[kk * 8 + 0] * r * g8[0], qv[kk * 8 + 1] * r * g8[1]); o.y = cvt_pk_bf16(qv[kk * 8 + 2] * r * g8[2], qv[kk * 8 + 3] * r * g8[3]);
        o.z = cvt_pk_bf16(qv[kk * 8 + 4] * r * g8[4], qv[kk * 8 + 5] * r * g8[5]); o.w = cvt_pk_bf16(qv[kk * 8 + 6] * r * g8[6], qv[kk * 8 + 7] * r * g8[7]);
        qf[kk] = __builtin_bit_cast(bf16x8, o);
      }
    }
    f32x16 sc[7];
#pragma unroll
    for (int t = 0; t < 7; ++t) {
      if (t <= nt_band) {
        f32x16 a_ = {0.f, 0.f, 0.f, 0.f, 0.f, 0.f, 0.f, 0.f, 0.f, 0.f, 0.f, 0.f, 0.f, 0.f, 0.f, 0.f};
#pragma unroll
        for (int kk = 0; kk < 4; ++kk) {
          const bf16x8 kf = *(const LAS bf16x8*)(kl + t * 4096 + kk * 1024);
          a_ = __builtin_amdgcn_mfma_f32_32x32x16_bf16(kf, qf[kk], a_, 0, 0, 0);
        }
        sc[t] = a_;
      }
    }
    const float sink = p.in[25][jl * 16 + head] * 1.44269504089f;
    const float* lh = lut + head * 256 + 191;
    float mx = sink;
    const int qi = qi0 + ql;
#pragma unroll
    for (int t = 0; t < 7; ++t) {
      if (t <= nt_band) {
#pragma unroll
        for (int r = 0; r < 16; ++r) {
          const int key = 8 * (r >> 2) + 4 * hh + (r & 3);
          float v;
          if (t == 0) {
            if (r < 8) { int rel = key - 16 - (tpos + ql); rel = rel < -191 ? -191 : rel; v = sc[t][r] + lh[rel]; } else v = -1e30f;
          } else {
            const int rel = sj0 + (t - 1) * 32 + key - 128 - qi;
            v = sc[t][r] + lh[rel];
          }
          sc[t][r] = v; mx = fmaxf(mx, v);
        }
      }
    }
    mx = fmaxf(mx, shx(mx, 32, lane));
    float sum = 0.f;
#pragma unroll
    for (int t = 0; t < 7; ++t) {
      if (t <= nt_band) {
#pragma unroll
        for (int r = 0; r < 16; ++r) { const float e = __builtin_amdgcn_exp2f(sc[t][r] - mx); sc[t][r] = e; sum += e; }
      }
    }
    sum += shx(sum, 32, lane);
    const float inv = 1.f / (sum + __builtin_amdgcn_exp2f(sink - mx));
    f32x16 o0 = {0.f, 0.f, 0.f, 0.f, 0.f, 0.f, 0.f, 0.f, 0.f, 0.f, 0.f, 0.f, 0.f, 0.f, 0.f, 0.f}, o1 = o0;
#pragma unroll
    for (int t = 0; t < 7; ++t) {
      if (t <= nt_band) {
#pragma unroll
        for (int s = 0; s < 2; ++s) {
          if (t == 0 && s == 1) continue;
          u32x4 pa; pa.x = cvt_pk_bf16(sc[t][8 * s + 0] * inv, sc[t][8 * s + 1] * inv); pa.y = cvt_pk_bf16(sc[t][8 * s + 2] * inv, sc[t][8 * s + 3] * inv);
          pa.z = cvt_pk_bf16(sc[t][8 * s + 4] * inv, sc[t][8 * s + 5] * inv); pa.w = cvt_pk_bf16(sc[t][8 * s + 6] * inv, sc[t][8 * s + 7] * inv);
          const bf16x8 pf = __builtin_bit_cast(bf16x8, pa);
          const bf16x8 b0 = *(const LAS bf16x8*)(kl + AT_KV + t * 4096 + s * 2048), b1 = *(const LAS bf16x8*)(kl + AT_KV + t * 4096 + s * 2048 + 1024);
          o0 = __builtin_amdgcn_mfma_f32_32x32x16_bf16(pf, b0, o0, 0, 0, 0);
          o1 = __builtin_amdgcn_mfma_f32_32x32x16_bf16(pf, b1, o1, 0, 0, 0);
        }
      }
    }
#pragma unroll
    for (int r = 0; r < 16; ++r) {
      const int q = 8 * (r >> 2) + 4 * hh + (r & 3);
      bf16_t* op = ao + (size_t)(qrow0 + q) * D + head * 64 + ql;
      op[0] = f2bf(o0[r]); op[32] = f2bf(o1[r]);
    }
  }
  asm volatile("s_waitcnt vmcnt(0)" ::: "memory");
  __syncthreads();
}

__global__ void __launch_bounds__(512) fwd_megakernel(Params p) {
  cg::grid_group grid = cg::this_grid();
  unsigned char* ws = p.ws;
  volatile LAS unsigned* xst = (volatile LAS unsigned*)((LAS unsigned char*)shm + XB_LDS_OFF);
  if (threadIdx.x < 4) xst[threadIdx.x] = 0u;
  __syncthreads();
  (void)xcd_barrier_post((unsigned*)(ws + W_BAR), xst);
  for (int it = bid_o(); it < 128; it += gdim_o()) s5_matrices(p, it >> 6, it & 63);
  weights_phase(p);
  cache_phase(p);
  norm_phase<0>(p, p.in[7], 0);
  if (p.ws == nullptr) grid.sync();
  xcd_barrier(p.ws);
#pragma unroll 1
  for (int l = 0; l < 4; ++l) {
    if (l < 2) {
      if (l == 1) { norm_phase<1>(p, p.in[7] + D, 11); xcd_barrier(p.ws); }
      gemm_phase<G_S1>(p, nullptr, 0, (const bf16_t*)(ws + W_BS1) + (size_t)l * 8192 * 512, 8192, 512);
      xcd_barrier(p.ws);
      if (PROBE == 9) { gemm_phase<G_S1>(p, nullptr, 0, (const bf16_t*)(ws + W_BS1) + (size_t)l * 8192 * 512, 8192, 512); xcd_barrier(p.ws); }
      s2_phase(p, l);
      xcd_barrier(p.ws);
      if (PROBE == 3) { s2_phase(p, l); xcd_barrier(p.ws); s2_phase(p, l); xcd_barrier(p.ws); }
      gemm_phase<G_S3>(p, nullptr, 0, (const bf16_t*)(ws + W_BS3) + (size_t)l * 16384 * 384, 16384, 384);
      xcd_barrier(p.ws);
      if (PROBE == 10) { gemm_phase<G_S3>(p, nullptr, 0, (const bf16_t*)(ws + W_BS3) + (size_t)l * 16384 * 384, 16384, 384); xcd_barrier(p.ws); }
      gemm_phase<G_GLU>(p, (const bf16_t*)(ws + W_YG), D, (const bf16_t*)(ws + W_WGLU) + (size_t)l * 2048 * 1024, 2048, 1024, l == 0);
      xcd_barrier(p.ws);
    } else {
      norm_phase<2>(p, nullptr, 11);
      xcd_barrier(p.ws);
      if (l == 2) gemm_phase<G_QKV>(p, (const bf16_t*)(ws + W_XB), D, (const bf16_t*)(ws + W_WQKV), 1536, 1024);
      else gemm_phase<G_QKV>(p, (const bf16_t*)(ws + W_XB), D, (const bf16_t*)(ws + W_WQKV) + (size_t)1536 * 1024, 1024, 1024);
      xcd_barrier(p.ws);
      if (l == 2) { kvfin_phase(p); xcd_barrier(p.ws); }
      attn_phase(p, l - 2);
      xcd_barrier(p.ws);
      if (PROBE == 4) { attn_phase(p, l - 2); xcd_barrier(p.ws); attn_phase(p, l - 2); xcd_barrier(p.ws); }
      gemm_phase<G_RESID>(p, (const bf16_t*)(ws + W_YG), D, (const bf16_t*)(ws + W_WO) + (size_t)(l - 2) * 1024 * 1024, 1024, 1024);
      xcd_barrier(p.ws);
    }
    norm_phase<2>(p, nullptr, l < 2 ? 0 : 4);
    xcd_barrier(p.ws);
    gemm_phase<G_FFIN>(p, (const bf16_t*)(ws + W_XB), D, (const bf16_t*)(ws + W_WIN) + (size_t)l * 5632 * 1024, 5632, 1024);
    xcd_barrier(p.ws);
    if (PROBE == 1) { gemm_phase<G_FFIN>(p, (const bf16_t*)(ws + W_XB), D, (const bf16_t*)(ws + W_WIN) + (size_t)l * 5632 * 1024, 5632, 1024); xcd_barrier(p.ws); }
    if (PROBE == 2) { for (int q = 0; q < 10; ++q) xcd_barrier(p.ws); }
    gemm_phase<G_RESID>(p, (const bf16_t*)(ws + W_HB), FF, (const bf16_t*)(ws + W_WOUT) + (size_t)l * 1024 * FF, 1024, FF, l == 3 ? 2 : 0);
    xcd_barrier(p.ws);
  }
  norm_phase<3>(p, nullptr, 11);
}

extern "C" void kernel_launch(void* const* d_in, const int* in_sizes, int n_in, void* d_out, int out_size, void* d_ws, size_t ws_size, hipStream_t stream) {
  static int grid_blocks = 0;
  if (grid_blocks == 0) {
    if (n_in != 28 || (size_t)out_size != O_END || ws_size < W_END) { fprintf(stderr, "kernel_launch: unexpected shapes (n_in %d out %d ws %zu need %zu)\n", n_in, out_size, ws_size, (size_t)W_END); grid_blocks = -1; return; }
    int dev = 0, cus = 0, per_cu = 0;
    hipGetDevice(&dev);
    hipDeviceGetAttribute(&cus, hipDeviceAttributeMultiprocessorCount, dev);
    if (hipFuncSetAttribute((const void*)fwd_megakernel, hipFuncAttributeMaxDynamicSharedMemorySize, LDS_BYTES) != hipSuccess) { fprintf(stderr, "kernel_launch: hipFuncSetAttribute failed\n"); }
    hipOccupancyMaxActiveBlocksPerMultiprocessor(&per_cu, (const void*)fwd_megakernel, 512, LDS_BYTES);
    if (per_cu < 1) { fprintf(stderr, "kernel_launch: occupancy query says %d blocks/CU\n", per_cu); per_cu = 1; }
    (void)hipGetLastError();
    grid_blocks = cus;
  }
  if (grid_blocks < 0) return;
  if (hipMemsetAsync((char*)d_ws + W_BAR, 0, 4096 * 4, stream) != hipSuccess) { fprintf(stderr, "kernel_launch: memset failed\n"); return; }
  Params p{};
  for (int i = 0; i < 28; ++i) p.in[i] = (const float*)d_in[i];
  p.out = (float*)d_out; p.ws = (unsigned char*)d_ws;
  void* args[] = {&p};
  hipError_t e = hipLaunchCooperativeKernel((const void*)fwd_megakernel, dim3(grid_blocks), dim3(512), args, LDS_BYTES, stream);
  if (e != hipSuccess) fprintf(stderr, "cooperative launch failed: %s (grid %d)\n", hipGetErrorString(e), grid_blocks);
}
```

```cpp
#include <hip/hip_runtime.h>
#include <hip/hip_cooperative_groups.h>
#include <cstdio>
#include <cstdint>
namespace cg = cooperative_groups;

typedef unsigned short bf16_t;
typedef short bf16x8 __attribute__((ext_vector_type(8)));
typedef float f32x4 __attribute__((ext_vector_type(4)));
typedef float f32x16 __attribute__((ext_vector_type(16)));
typedef unsigned u32x4 __attribute__((ext_vector_type(4)));
typedef unsigned u32x2 __attribute__((ext_vector_type(2)));

constexpr int D = 1024, SEQ = 16384, NB = 2, DB = 32, DS = 32, FF = 2816;
constexpr int R_PROMPT = 0, R_SAMPLE = 32768, R_META = 33792, R_REAL = 33808, R_PAD = 34048;
constexpr int NTM = R_PAD / 256;
constexpr int NCH = 2 * 1025 + 64, NCH_PAD = 2304;
constexpr int KROWS = 32768 + 32 * 160 + 16;
constexpr int KS_BASE = 32768, KM_BASE = 32768 + 5120;
constexpr size_t VT_S = (size_t)2 * 4 * 64 * 16384, VT_M = VT_S + (size_t)32 * 4 * 64 * 160;

constexpr size_t O_YP = 0, O_YS = 33554432, O_PRE = O_YS + 1048576, O_PIM = O_PRE + 16384, O_PK = O_PIM + 16384, O_PV = O_PK + 65536,
                 O_SRE = O_PV + 65536, O_SIM = O_SRE + 262144, O_SK = O_SIM + 262144, O_SV = O_SK + 262144, O_END = O_SV + 262144;

constexpr size_t al(size_t x) { return (x + 255) & ~(size_t)255; }
constexpr size_t W_XMETA = 0;
constexpr size_t W_XB = al(W_XMETA + (size_t)256 * D * 4);
constexpr size_t W_RS = al(W_XB + (size_t)R_PAD * D * 2);
constexpr size_t W_UB = al(W_RS + (size_t)R_PAD * 4);
constexpr size_t W_YG = al(W_UB + (size_t)R_PAD * D * 2);
constexpr size_t W_SB = al(W_YG + (size_t)R_PAD * D * 2);
constexpr size_t W_HIN = al(W_SB + (size_t)NCH_PAD * 8192 * 4);
constexpr size_t W_KB = al(W_HIN + (size_t)NCH_PAD * 8192 * 2);
constexpr size_t W_VT = al(W_KB + (size_t)(KROWS + 16) * 256 * 2);
constexpr size_t W_WGLU = al(W_VT + (size_t)(KROWS + 16) * 256 * 2);
constexpr size_t W_WIN = al(W_WGLU + (size_t)2 * 2048 * 1024 * 2);
constexpr size_t W_WOUT = al(W_WIN + (size_t)4 * 5632 * 1024 * 2);
constexpr size_t W_WQKV = al(W_WOUT + (size_t)4 * 1024 * FF * 2);
constexpr size_t W_WO = al(W_WQKV + (size_t)2560 * 1024 * 2);
constexpr size_t W_BS1 = al(W_WO + (size_t)2 * 1024 * 1024 * 2);
constexpr size_t W_BS3 = al(W_BS1 + (size_t)2 * 8192 * 512 * 2);
constexpr size_t W_A16 = al(W_BS3 + (size_t)2 * 16384 * 384 * 2);
constexpr size_t W_BAR = al(W_A16 + (size_t)2 * 64 * 64 * 8);
constexpr size_t W_END = al(W_BAR + (size_t)4096 * 4);
constexpr size_t W_HB = W_UB;
constexpr size_t W_KVRAW = W_SB;
constexpr size_t W_PART = W_UB + (size_t)R_PAD * FF * 2;
constexpr int SPLIT_ROW0 = 32768, SPLIT_ROWS = R_PAD - 32768, SPLIT_PM0 = 128;
static_assert(W_PART + (size_t)11 * SPLIT_ROWS * D * 4 <= W_KB, "partials overlay");
static_assert((size_t)R_PAD * FF * 2 <= W_HIN - W_UB, "hb overlay");
static_assert((size_t)R_PAD * 512 * 4 <= W_HIN - W_SB, "kvraw overlay");
static_assert(W_END <= (size_t)512 * 1024 * 1024, "workspace");

constexpr int LDS_BYTES = 147456;
constexpr int XB_LDS_OFF = LDS_BYTES - 16;
constexpr int PROBE = 0;

struct Params {
  const float* in[28];
  float* out;
  unsigned char* ws;
};

extern __shared__ __attribute__((aligned(16))) unsigned char shm[];

__device__ __forceinline__ unsigned cvt_pk_bf16(float lo, float hi) { unsigned r; asm volatile("v_cvt_pk_bf16_f32 %0, %1, %2" : "=v"(r) : "v"(lo), "v"(hi)); return r; }
__device__ __forceinline__ bf16_t f2bf(float f) { return (bf16_t)(cvt_pk_bf16(f, 0.f) & 0xffffu); }
__device__ __forceinline__ float bf2f(unsigned b) { return __uint_as_float(b << 16); }
__device__ __forceinline__ f32x4 unpack4(u32x2 r) { return (f32x4){__uint_as_float(r.x << 16), __uint_as_float(r.x & 0xffff0000u), __uint_as_float(r.y << 16), __uint_as_float(r.y & 0xffff0000u)}; }
__device__ __forceinline__ float shx(float v, int o, int lane) { return __int_as_float(__builtin_amdgcn_ds_bpermute((lane ^ o) << 2, __float_as_int(v))); }
__device__ __forceinline__ float wave_sum(float v, int lane) {
#pragma unroll
  for (int o = 1; o < 64; o <<= 1) v += shx(v, o, lane);
  return v;
}
__device__ __forceinline__ int tid_o() { int t = threadIdx.x; asm volatile("" : "+v"(t)); return t; }
__device__ __forceinline__ int bid_o() { int b = blockIdx.x; asm volatile("" : "+s"(b)); return b; }
__device__ __forceinline__ int gdim_o() { int b = gridDim.x; asm volatile("" : "+s"(b)); return b; }
__device__ __forceinline__ float sigmoidf_(float x) { return __builtin_amdgcn_rcpf(1.f + __expf(-x)); }
__device__ __forceinline__ float gelu_tanh(float x) {
  const float x2 = x * x;
  const float w = x * (-2.302208198f - 0.102943242f * x2);
  return x * __builtin_amdgcn_rcpf(1.f + __builtin_amdgcn_exp2f(w));
}
__device__ __forceinline__ float* xrow_ptr(const Params& p, int row) {
  return row < R_META ? p.out + (size_t)row * D : (float*)(p.ws + W_XMETA) + (size_t)(row - R_META) * D;
}
__device__ __forceinline__ const float* xsrc_ptr(const Params& p, int row) {
  return row < R_SAMPLE ? p.in[0] + (size_t)row * D : row < R_META ? p.in[1] + (size_t)(row - R_SAMPLE) * D : row < R_REAL ? p.in[6] + (size_t)(row - R_META) * D : nullptr;
}
__device__ __forceinline__ int chunk_row(int cgi) {
  if (cgi >= NCH) cgi = 0;
  if (cgi < 2050) { const int b = cgi >= 1025 ? 1 : 0; const int c = cgi - b * 1025; return c == 0 ? R_META : b * SEQ + (c - 1) * 16; }
  return R_SAMPLE + (cgi - 2050) * 16;
}

#define LAS __attribute__((address_space(3)))
constexpr int BM = 256, BK = 64, HALF = 128, HTB = HALF * BK * 2;
__device__ __forceinline__ int lds_byte(int r, int c) {
  int st = (r >> 4) * 2 + (c >> 5), rr = r & 15, cc = c & 31, ob = rr * 64 + cc * 2;
  return st * 1024 + (ob ^ (((ob >> 9) & 1) << 5));
}
__device__ __forceinline__ void stage_rc(int b, int& R, int& C) {
  int st = b / 1024, sb = b % 1024, swz = sb ^ (((sb >> 9) & 1) << 5);
  R = (st >> 1) * 16 + swz / 64; C = (st & 1) * 32 + (swz % 64) / 2;
}

typedef f32x4 acc_t[2][2][4][2];

struct ARow {
  const char* base; unsigned hstep; unsigned voff[2];
  __device__ __forceinline__ void init(const bf16_t* A, int lda, int brow) {
    base = (const char*)(A + (size_t)brow * lda); hstep = (unsigned)HALF * lda * 2u;
#pragma unroll
    for (int i = 0; i < 2; ++i) { int R, C; stage_rc(tid_o() * 16 + i * 8192, R, C); voff[i] = (unsigned)(R * lda + C) * 2u; }
  }
  __device__ __forceinline__ const char* ptr(int h, int i, int kt) const { return base + (size_t)h * hstep + (size_t)kt * 128 + voff[i]; }
};
struct AS1 {
  const char* ub; unsigned voff[2][2]; int pn;
  __device__ __forceinline__ void init(const bf16_t* u, int brow, int pn_) {
    ub = (const char*)u; pn = pn_;
#pragma unroll
    for (int h = 0; h < 2; ++h)
#pragma unroll
      for (int i = 0; i < 2; ++i) { int R, C; stage_rc(tid_o() * 16 + i * 8192, R, C);
        voff[h][i] = (unsigned)(chunk_row(brow + h * 128 + R) + (C >> 4)) * 2048u + (unsigned)(C & 15) * 2u; }
  }
  __device__ __forceinline__ const char* ptr(int h, int i, int kt) const { return ub + (size_t)((pn * 2 + (kt >> 2)) * 32 + (kt & 3) * 8192) + voff[h][i]; }
};
struct AS3 {
  const char* ub; const char* hin; unsigned voffu[2][2], voffh[2][2]; int g;
  __device__ __forceinline__ void init(const bf16_t* u, const bf16_t* hn, int brow, int g_) {
    ub = (const char*)u; hin = (const char*)hn; g = g_;
#pragma unroll
    for (int h = 0; h < 2; ++h)
#pragma unroll
      for (int i = 0; i < 2; ++i) { int R, C; stage_rc(tid_o() * 16 + i * 8192, R, C);
        int cgi = brow + h * 128 + R; if (cgi >= NCH) cgi = 0;
        voffu[h][i] = (unsigned)cgi * 32768u + (unsigned)C * 2u;
        voffh[h][i] = (unsigned)cgi * 16384u + (unsigned)C * 2u; }
  }
  __device__ __forceinline__ const char* ptr(int h, int i, int kt) const {
    return kt < 4 ? ub + (size_t)(g * 512 + kt * 128) + voffu[h][i] : hin + (size_t)(g * 256 + (kt - 4) * 128) + voffh[h][i];
  }
};

template <class AF>
__device__ __forceinline__ void gemm_mainloop(acc_t& acc, const AF& A, const bf16_t* Bt, int K, int bcol, int nt) {
  LAS unsigned char* lds = (LAS unsigned char*)shm;
  const int tid = tid_o(), wid = __builtin_amdgcn_readfirstlane(tid >> 6), lane = tid & 63, wr = wid >> 2, wc = wid & 3, fr = lane & 15, fq = lane >> 4;
  unsigned voffB[2];
#pragma unroll
  for (int i = 0; i < 2; ++i) { int R, C; stage_rc(tid * 16 + i * 8192, R, C); voffB[i] = (unsigned)(R * K + C) * 2u; }
  const char* cB = (const char*)(Bt + (size_t)bcol * K);
  const size_t hstepB = (size_t)HALF * K * 2;
  const unsigned ldsw = (unsigned)wid * 1024u;
  const int aoff = lds_byte(wr * 64 + fr, fq * 8), boff = lds_byte(wc * 32 + fr, fq * 8);
#define SA(b, h) (((b) * 2 + (h)) * HTB)
#define SB(b, h) ((4 + (b) * 2 + (h)) * HTB)
#define STAGE_A(bufoff, h, kt) do { _Pragma("unroll") for (int _i = 0; _i < 2; ++_i) \
    __builtin_amdgcn_global_load_lds((const unsigned*)A.ptr(h, _i, kt), (LAS unsigned*)(lds + (bufoff) + ldsw + _i * 8192), 16, 0, 0); } while (0)
#define STAGE_B(bufoff, h, kt) do { _Pragma("unroll") for (int _i = 0; _i < 2; ++_i) \
    __builtin_amdgcn_global_load_lds((const unsigned*)(cB + (size_t)(h) * hstepB + (size_t)(kt) * 128 + voffB[_i]), (LAS unsigned*)(lds + (bufoff) + ldsw + _i * 8192), 16, 0, 0); } while (0)
#define LDA(dst, b, h) do { _Pragma("unroll") for (int m = 0; m < 4; ++m) _Pragma("unroll") for (int k = 0; k < 2; ++k) dst[m][k] = *(const LAS bf16x8*)(lds + SA(b, h) + aoff + m * 2048 + k * 1024); } while (0)
#define LDB(dst, b, h) do { _Pragma("unroll") for (int n = 0; n < 2; ++n) _Pragma("unroll") for (int k = 0; k < 2; ++k) dst[n][k] = *(const LAS bf16x8*)(lds + SB(b, h) + boff + n * 2048 + k * 1024); } while (0)
#define MMA(ai, bj, At_, Bt_) do { __builtin_amdgcn_s_setprio(1); _Pragma("unroll") for (int m = 0; m < 4; ++m) _Pragma("unroll") for (int n = 0; n < 2; ++n) _Pragma("unroll") for (int k = 0; k < 2; ++k) \
      acc[ai][bj][m][n] = __builtin_amdgcn_mfma_f32_16x16x32_bf16(Bt_[n][k], At_[m][k], acc[ai][bj][m][n], 0, 0, 0); \
    __builtin_amdgcn_s_setprio(0); } while (0)
#define WAIT_V(n) asm volatile("s_waitcnt vmcnt(" #n ")" ::: "memory")
#define WAIT_L(n) asm volatile("s_waitcnt lgkmcnt(" #n ")" ::: "memory")
#define BAR __builtin_amdgcn_s_barrier()
#define SCHED __builtin_amdgcn_sched_barrier(0)
#pragma unroll
  for (int a = 0; a < 2; ++a)
#pragma unroll
    for (int b = 0; b < 2; ++b)
#pragma unroll
      for (int m = 0; m < 4; ++m)
#pragma unroll
        for (int n = 0; n < 2; ++n) acc[a][b][m][n] = (f32x4){0.f, 0.f, 0.f, 0.f};
  bf16x8 At[4][2], B0[2][2], B1[2][2];
  STAGE_B(SB(0, 0), 0, 0); STAGE_B(SB(0, 1), 1, 0); STAGE_A(SA(0, 0), 0, 0); STAGE_A(SA(0, 1), 1, 0);
  if (wr == 1) BAR;
  WAIT_V(2); BAR;
  STAGE_B(SB(1, 0), 0, 1); STAGE_A(SA(1, 0), 0, 1); STAGE_B(SB(1, 1), 1, 1);
  WAIT_V(6); BAR;
#pragma unroll 1
  for (int t = 0; t < nt; t += 2) {
    const bool last = (t == nt - 2);
    const int k2 = last ? 0 : t + 2, k3 = k2 + 1;
    LDB(B0, 0, 0); LDB(B1, 0, 1); SCHED; LDA(At, 0, 0); STAGE_A(SA(1, 1), 1, t + 1);
    WAIT_V(8); WAIT_L(0); BAR; MMA(0, 0, At, B0); MMA(0, 1, At, B1); BAR; SCHED;
    LDA(At, 0, 1); STAGE_B(SB(0, 0), 0, k2); STAGE_B(SB(0, 1), 1, k2); STAGE_A(SA(0, 0), 0, k2);
    WAIT_V(8); WAIT_L(0); BAR; MMA(1, 0, At, B0); MMA(1, 1, At, B1); BAR; SCHED;
    LDB(B0, 1, 0); LDB(B1, 1, 1); SCHED; LDA(At, 1, 0); STAGE_A(SA(0, 1), 1, k2);
    WAIT_V(8); WAIT_L(0); BAR; MMA(0, 0, At, B0); MMA(0, 1, At, B1); BAR; SCHED;
    LDA(At, 1, 1); STAGE_B(SB(1, 0), 0, k3); STAGE_B(SB(1, 1), 1, k3); STAGE_A(SA(1, 0), 0, k3);
    WAIT_V(8); WAIT_L(0); BAR; MMA(1, 0, At, B0); MMA(1, 1, At, B1); BAR; SCHED;
  }
  WAIT_V(0);
  if (wr == 0) BAR;
  BAR;
#undef SA
#undef SB
}


#define XB_TMO      128
#define XB_XCNT(j)  (256  + 64 * (j))
#define XB_XSUB(j)  (1280 + 64 * (j))
#define XB_XGEN(j)  (2304 + 64 * (j))
#define XB_TOP      3328
#define XB_TOPGEN   3392
#define XCD_BAR_WORDS 3456
#define XB_SPIN_CAP (1u << 18)
__device__ __forceinline__ unsigned xb_ld(unsigned* p)              { return __hip_atomic_load(p, __ATOMIC_RELAXED, __HIP_MEMORY_SCOPE_AGENT); }
__device__ __forceinline__ unsigned xb_add(unsigned* p, unsigned v) { return __hip_atomic_fetch_add(p, v, __ATOMIC_RELAXED, __HIP_MEMORY_SCOPE_AGENT); }
__device__ __forceinline__ unsigned xb_xcc_id() { return (unsigned)__builtin_amdgcn_s_getreg((3 << 11) | 20) & 0xFu; }
#define XB_SPIN(cond, bar) do { unsigned _sp = 0; while (cond) { __builtin_amdgcn_s_sleep(1); \
    if ((++_sp & 255u) == 0u) { if (xb_ld(&(bar)[XB_TMO])) break; if (_sp > XB_SPIN_CAP) { atomicAdd(&(bar)[XB_TMO], 1u); break; } } } } while (0)
struct XcdBarrier { unsigned* bar; unsigned x; volatile LAS unsigned* st; };
__device__ __forceinline__ XcdBarrier xcd_barrier_post(unsigned* bar, volatile LAS unsigned* st) {
  XcdBarrier b; b.bar = bar; b.x = xb_xcc_id(); b.st = st;
  if (threadIdx.x == 0) (void)xb_add(&bar[XB_XCNT(b.x)], 1u);
  return b;
}
__device__ __forceinline__ void xcd_barrier_complete(unsigned* bar, unsigned x, unsigned& nloc, unsigned& nx) {
  const unsigned G = gridDim.x * gridDim.y * gridDim.z;
  unsigned sum, cnt, mine, sp = 0u;
  for (;;) {
    sum = 0u; cnt = 0u; mine = 0u;
#pragma unroll
    for (unsigned j = 0; j < 16; ++j) { const unsigned c = xb_ld(&bar[XB_XCNT(j)]); sum += c; cnt += (c > 0u) ? 1u : 0u; mine = (j == x) ? c : mine; }
    if (sum == G) break;
    __builtin_amdgcn_s_sleep(1);
    if ((++sp & 255u) == 0u) { if (xb_ld(&bar[XB_TMO])) break; if (sp > XB_SPIN_CAP) { atomicAdd(&bar[XB_TMO], 1u); break; } }
  }
  nloc = mine > 0u ? mine : 1u; nx = cnt > 0u ? cnt : 1u;
}
__device__ __forceinline__ void xcd_barrier(unsigned char* ws_) {
  XcdBarrier b; b.bar = (unsigned*)(ws_ + W_BAR); b.x = xb_xcc_id(); b.st = (volatile LAS unsigned*)((LAS unsigned char*)shm + XB_LDS_OFF);
  asm volatile("s_waitcnt vmcnt(0)" ::: "memory");
  __syncthreads();
  if (threadIdx.x == 0) {
    unsigned* bar = b.bar;
    __builtin_amdgcn_s_waitcnt(0);
    unsigned nloc = b.st[0], nx = b.st[1];
    if (nloc == 0u) { xcd_barrier_complete(bar, b.x, nloc, nx); b.st[0] = nloc; b.st[1] = nx; }
    const unsigned old = xb_add(&bar[XB_XSUB(b.x)], 1u);
    const unsigned gen = old / nloc;
    if (old + 1u == (gen + 1u) * nloc) {
      __builtin_amdgcn_fence(__ATOMIC_RELEASE, "agent");
      asm volatile("s_waitcnt vmcnt(0)" ::: "memory");
      const unsigned og = xb_add(&bar[XB_TOP], 1u);
      const unsigned tg = og / nx;
      if (og + 1u == (tg + 1u) * nx) xb_add(&bar[XB_TOPGEN], 1u);
      else XB_SPIN(xb_ld(&bar[XB_TOPGEN]) == tg, bar);
      __builtin_amdgcn_fence(__ATOMIC_ACQUIRE, "agent");
      xb_add(&bar[XB_XGEN(b.x)], 1u);
      asm volatile("s_waitcnt vmcnt(0)" ::: "memory");
    } else {
      XB_SPIN(xb_ld(&bar[XB_XGEN(b.x)]) == gen, bar);
      __builtin_amdgcn_fence(__ATOMIC_ACQUIRE, "agent");
      asm volatile("s_waitcnt vmcnt(0)" ::: "memory");
    }
  }
  __syncthreads();
}

__device__ __forceinline__ bool tile_at(long L, int nM, int nN, int& pm, int& pn) {
  const int nwg = nM * nN;
  if (L >= nwg) return false;
  int wgid = (int)L;
  { const int q = nwg / 8, r = nwg % 8, xcd = wgid % 8, off = wgid / 8; wgid = (xcd < r ? xcd * (q + 1) : r * (q + 1) + (xcd - r) * q) + off; }
  const int nig = 8 * nN, gid = wgid / nig, fm = gid * 8, gsz = (nM - fm) < 8 ? (nM - fm) : 8;
  pm = fm + ((wgid % nig) % gsz); pn = (wgid % nig) / gsz;
  return true;
}
__device__ __forceinline__ bool tile_next(int it, int nM, int nN, int& pm, int& pn) { return tile_at((long)it * gdim_o() + bid_o(), nM, nN, pm, pn); }

#define EPI_ROWS_BEGIN \
  const int wid = tid_o() >> 6, lane = tid_o() & 63, wr = wid >> 2, wc = wid & 3, fr = lane & 15, fq = lane >> 4; \
  _Pragma("unroll") for (int ai = 0; ai < 2; ++ai) _Pragma("unroll") for (int m = 0; m < 4; ++m) { \
    const int row = brow + ai * 128 + wr * 64 + m * 16 + fr;
#define EPI_ROWS_END }

enum { G_GLU = 0, G_FFIN = 1, G_RESID = 2, G_QKV = 3, G_S1 = 4, G_S3 = 5 };

template <int MODE>
__device__ __forceinline__ void gemm_phase(const Params& p, const bf16_t* A, int lda, const bf16_t* Bt, int N, int K, int first = 0) {
  const int nM = (MODE == G_S1 || MODE == G_S3) ? NCH_PAD / 256 : NTM, nN = N / 256, nt = K / BK;
  unsigned char* ws = p.ws;
  const int G = gdim_o(), ks = nt / 4, nsplit = (NTM - SPLIT_PM0) * nN * ks, nMw = (MODE == G_RESID) ? SPLIT_PM0 : nM;
  const int nfull_it = (nMw * nN + G - 1) / G;
#pragma unroll 1
  for (int it = 0;; ++it) {
    int pm, pn; bool split = false; int kt0 = 0, ntu = nt, ksi = 0;
    if (MODE == G_RESID && it >= nfull_it) {
      const int u = (it - nfull_it) * G + bid_o();
      if (u >= nsplit) break;
      ksi = u % ks; const int tq = u / ks; pn = tq % nN; pm = SPLIT_PM0 + tq / nN;
      split = true; kt0 = ksi * 4; ntu = 4;
    } else if (!tile_next(it, nMw, nN, pm, pn)) { if (MODE == G_RESID) continue; else break; }
    const int brow = pm * 256, bcol = pn * 256;
    float rsv[8];
    if (MODE == G_FFIN || MODE == G_QKV) {
      const int tid_ = tid_o(), wr_ = (tid_ >> 6) >> 2, fr_ = tid_ & 15;
      const float* rsp = (const float*)(ws + W_RS) + brow + wr_ * 64 + fr_;
#pragma unroll
      for (int q = 0; q < 8; ++q) rsv[q] = rsp[(q >> 2) * 128 + (q & 3) * 16];
    }
    acc_t acc;
    if (MODE == G_S1) { ARow af; af.init((const bf16_t*)(ws + W_UB) + pn * 512, 16384, brow); gemm_mainloop(acc, af, Bt, K, bcol, nt); }
    else if (MODE == G_S3) { AS3 af; af.init((const bf16_t*)(ws + W_UB), (const bf16_t*)(ws + W_HIN), brow, pn); gemm_mainloop(acc, af, Bt, K, bcol, nt); }
    else { ARow af; af.init(A + kt0 * BK, lda, brow); gemm_mainloop(acc, af, Bt + kt0 * BK, K, bcol, ntu); }
    if (MODE == G_GLU) {
      bf16_t* xb = (bf16_t*)(ws + W_XB);
      EPI_ROWS_BEGIN
        bf16_t* xr = xb + (size_t)row * D;
        const int oc = (bcol >> 1) + wc * 32 + fq * 8;
        f32x4 x0, x1;
        if (first & 1) { const float* xs = xsrc_ptr(p, row); x0 = xs ? *(const f32x4*)(xs + oc) : (f32x4){0.f, 0.f, 0.f, 0.f}; x1 = xs ? *(const f32x4*)(xs + oc + 4) : (f32x4){0.f, 0.f, 0.f, 0.f}; }
        else { const u32x4 raw = *(const u32x4*)(xr + oc); x0 = unpack4((u32x2){raw.x, raw.y}); x1 = unpack4((u32x2){raw.z, raw.w}); }
#pragma unroll
        for (int j = 0; j < 4; ++j) { x0[j] += acc[ai][0][m][0][j] * sigmoidf_(acc[ai][1][m][0][j]); x1[j] += acc[ai][0][m][1][j] * sigmoidf_(acc[ai][1][m][1][j]); }
        u32x4 o; o.x = cvt_pk_bf16(x0[0], x0[1]); o.y = cvt_pk_bf16(x0[2], x0[3]); o.z = cvt_pk_bf16(x1[0], x1[1]); o.w = cvt_pk_bf16(x1[2], x1[3]);
        *(u32x4*)(xr + oc) = o;
      EPI_ROWS_END
    } else if (MODE == G_FFIN) {
      bf16_t* hb = (bf16_t*)(ws + W_HB); const float* rs = (const float*)(ws + W_RS);
      EPI_ROWS_BEGIN
        const float s = rsv[ai * 4 + m];
        const int oc = (bcol >> 1) + wc * 32 + fq * 8;
        float hv[8];
#pragma unroll
        for (int n = 0; n < 2; ++n)
#pragma unroll
          for (int j = 0; j < 4; ++j) { const float gt = acc[ai][0][m][n][j] * s, up = acc[ai][1][m][n][j] * s; hv[n * 4 + j] = gt * sigmoidf_(gt) * up; }
        u32x4 o; o.x = cvt_pk_bf16(hv[0], hv[1]); o.y = cvt_pk_bf16(hv[2], hv[3]); o.z = cvt_pk_bf16(hv[4], hv[5]); o.w = cvt_pk_bf16(hv[6], hv[7]);
        *(u32x4*)(hb + (size_t)row * FF + oc) = o;
      EPI_ROWS_END
    } else if (MODE == G_RESID) {
      bf16_t* xb = (bf16_t*)(ws + W_XB);
      EPI_ROWS_BEGIN
        bf16_t* xr = xb + (size_t)row * D;
#pragma unroll
        for (int bj = 0; bj < 2; ++bj)
#pragma unroll
          for (int n = 0; n < 2; ++n) {
            const int oc = bcol + bj * 128 + wc * 32 + n * 16 + fq * 4;
            if (split) {
              *(f32x4*)((float*)(ws + W_PART) + ((size_t)ksi * SPLIT_ROWS + (row - SPLIT_ROW0)) * D + oc) = acc[ai][bj][m][n];
            } else {
              f32x4 x = unpack4(*(const u32x2*)(xr + oc));
              x += acc[ai][bj][m][n];
              if (first & 2) *(f32x4*)(xrow_ptr(p, row) + oc) = x;
              else { u32x2 o; o.x = cvt_pk_bf16(x[0], x[1]); o.y = cvt_pk_bf16(x[2], x[3]); *(u32x2*)(xr + oc) = o; }
            }
          }
      EPI_ROWS_END
    } else if (MODE == G_QKV) {
      bf16_t* qb = (bf16_t*)(ws + W_UB); float* kv = (float*)(ws + W_KVRAW); const float* rs = (const float*)(ws + W_RS);
      EPI_ROWS_BEGIN
        const float s = rsv[ai * 4 + m];
#pragma unroll
        for (int bj = 0; bj < 2; ++bj)
#pragma unroll
          for (int n = 0; n < 2; ++n) {
            const int oc = bcol + bj * 128 + wc * 32 + n * 16 + fq * 4;
            const f32x4 v = acc[ai][bj][m][n] * s;
            if (bcol < 1024) { u32x2 o; o.x = cvt_pk_bf16(v[0], v[1]); o.y = cvt_pk_bf16(v[2], v[3]); *(u32x2*)(qb + (size_t)row * D + oc) = o; }
            else *(f32x4*)(kv + (size_t)row * 512 + (oc - 1024)) = v;
          }
      EPI_ROWS_END
    } else if (MODE == G_S1) {
      float* sb = (float*)(ws + W_SB);
      EPI_ROWS_BEGIN
#pragma unroll
        for (int bj = 0; bj < 2; ++bj)
#pragma unroll
          for (int n = 0; n < 2; ++n) {
            const int oc = bcol + bj * 128 + wc * 32 + n * 16 + fq * 4;
            *(f32x4*)(sb + (size_t)row * 8192 + oc) = acc[ai][bj][m][n];
          }
      EPI_ROWS_END
    } else if (MODE == G_S3) {
      bf16_t* yg = (bf16_t*)(ws + W_YG);
      EPI_ROWS_BEGIN
        const bool valid = row < NCH && row != 1025;
        const int tr = chunk_row(row);
        if (valid) {
#pragma unroll
          for (int bj = 0; bj < 2; ++bj)
#pragma unroll
            for (int n = 0; n < 2; ++n) {
              const int t = bj * 8 + wc * 2 + n;
              const f32x4 v = acc[ai][bj][m][n];
              u32x2 o; o.x = cvt_pk_bf16(gelu_tanh(v[0]), gelu_tanh(v[1])); o.y = cvt_pk_bf16(gelu_tanh(v[2]), gelu_tanh(v[3]));
              *(u32x2*)(yg + (size_t)(tr + t) * D + pn * 16 + fq * 4) = o;
            }
        }
      EPI_ROWS_END
    }
    __builtin_amdgcn_s_barrier();
  }
}

__device__ __forceinline__ int perm32(int rho) { return 8 * ((rho & 15) >> 2) + 4 * (rho >> 4) + (rho & 3); }
__device__ __forceinline__ int srccol(int np, int mode, int Nh) {
  if (mode == 0) return np;
  const int t256 = np >> 8, r = np & 255, bj = r >> 7, r128 = r & 127, out = t256 * 128 + (r128 & ~31) + perm32(r128 & 31);
  return bj ? Nh + out : out;
}
__device__ __forceinline__ void transpose_tile(const float* W, int K, int N, bf16_t* Wt, int np0, int k0, int mode, int Nh, const float* gain) {
  float* tile = (float*)shm;
  const int tid = tid_o(), c4 = tid & 63, r0 = tid >> 6;
  const int sc = srccol(np0 + c4 * 4, mode, Nh);
  f32x4 v[8];
#pragma unroll
  for (int q = 0; q < 8; ++q) v[q] = *(const f32x4*)(W + (size_t)(k0 + r0 + q * 8) * N + sc);
#pragma unroll
  for (int q = 0; q < 8; ++q) { const int r = r0 + q * 8; const float g = gain ? gain[k0 + r] : 1.f; float* t = tile + r * 257 + c4 * 4; t[0] = v[q].x * g; t[1] = v[q].y * g; t[2] = v[q].z * g; t[3] = v[q].w * g; }
  __syncthreads();
#pragma unroll
  for (int q = 0; q < 4; ++q) {
    const int e = tid + q * 512, n = e & 255, ks = e >> 8;
    const float* s = tile + (ks * 8) * 257 + n;
    u32x4 o; o.x = cvt_pk_bf16(s[0], s[257]); o.y = cvt_pk_bf16(s[2 * 257], s[3 * 257]); o.z = cvt_pk_bf16(s[4 * 257], s[5 * 257]); o.w = cvt_pk_bf16(s[6 * 257], s[7 * 257]);
    *(u32x4*)(Wt + (size_t)(np0 + n) * K + k0 + ks * 8) = o;
  }
  __syncthreads();
}

__device__ __forceinline__ void weights_phase(const Params& p) {
  unsigned char* ws = p.ws;
  const int total = 2 * 128 + 4 * 352 + 4 * 176 + 64 + 32 + 64 + 2 * 64;
  unsigned* qctr = (unsigned*)(ws + W_BAR) + 3600;
  volatile LAS int* qslot = (volatile LAS int*)((LAS unsigned char*)shm + XB_LDS_OFF + 8);
  for (;;) {
    __syncthreads();
    if (tid_o() == 0) *qslot = (int)__hip_atomic_fetch_add(qctr, 1u, __ATOMIC_RELAXED, __HIP_MEMORY_SCOPE_AGENT);
    __syncthreads();
    const int t = *qslot;
    if (t >= total) break;
    int r = t; const float* W; int K, N, mode = 0, Nh = 0; const float* gain = nullptr; bf16_t* dst;
    if (r < 256) { const int l = r / 128; r -= l * 128; W = p.in[17] + (size_t)l * 1024 * 2048; K = 1024; N = 2048; mode = 1; Nh = 1024; dst = (bf16_t*)(ws + W_WGLU) + (size_t)l * 2048 * 1024; }
    else if ((r -= 256) < 1408) { const int l = r / 352; r -= l * 352; W = p.in[18] + (size_t)l * 1024 * 5632; K = 1024; N = 5632; mode = 1; Nh = FF; gain = p.in[8] + l * D; dst = (bf16_t*)(ws + W_WIN) + (size_t)l * 5632 * 1024; }
    else if ((r -= 1408) < 704) { const int l = r / 176; r -= l * 176; W = p.in[19] + (size_t)l * FF * 1024; K = FF; N = 1024; dst = (bf16_t*)(ws + W_WOUT) + (size_t)l * 1024 * FF; }
    else if ((r -= 704) < 64) { W = p.in[23]; K = 1024; N = 1024; gain = p.in[7] + 2 * D; dst = (bf16_t*)(ws + W_WQKV); }
    else if ((r -= 64) < 32) { W = p.in[21]; K = 1024; N = 512; gain = p.in[20]; dst = (bf16_t*)(ws + W_WQKV) + (size_t)1024 * 1024; }
    else if ((r -= 32) < 64) { W = p.in[23] + (size_t)1024 * 1024; K = 1024; N = 1024; gain = p.in[7] + 3 * D; dst = (bf16_t*)(ws + W_WQKV) + (size_t)1536 * 1024; }
    else { r -= 64; const int l = r / 64; r -= l * 64; W = p.in[26] + (size_t)l * 1024 * 1024; K = 1024; N = 1024; dst = (bf16_t*)(ws + W_WO) + (size_t)l * 1024 * 1024; }
    const int nkt = K / 64, kt = r % nkt, nb = r / nkt;
    transpose_tile(W, K, N, dst, nb * 256, kt * 64, mode, Nh, gain);
  }
}

__device__ __forceinline__ void s5_matrices(const Params& p, int l, int g) {
  float* L = (float*)shm;
  float* apr = L;
  float* api = apr + 64 * 17;
  float* bbr = api + 64 * 17;
  float* bbi = bbr + 1024;
  float* ccr = bbi + 1024;
  float* cci = ccr + 1024;
  float* fre = cci + 1024;
  float* fim = fre + 64;
  float* Kv = fim + 64;
  const int tid = tid_o();
  unsigned char* ws = p.ws;
  const size_t lg = (size_t)l * 64 + g;
  if (tid < 64) {
    const int pp = tid;
    const double dt = exp((double)p.in[11][lg]);
    const double are = p.in[9][lg * 64 + pp], aim = p.in[10][lg * 64 + pp];
    const double mg = exp(are * dt), an = aim * dt, br = mg * cos(an), bi = mg * sin(an);
    { double pr = 1.0, pi = 0.0;
      for (int j = 0; j <= 16; ++j) { apr[pp * 17 + j] = (float)pr; api[pp * 17 + j] = (float)pi; const double t = pr * br - pi * bi; pi = pr * bi + pi * br; pr = t; } }
    const double nr = br - 1.0, ni = bi, inv = 1.0 / (are * are + aim * aim);
    fre[pp] = (float)((nr * are + ni * aim) * inv); fim[pp] = (float)((ni * are - nr * aim) * inv);
    float* a16 = (float*)(ws + W_A16) + (lg * 64 + pp) * 2;
    a16[0] = apr[pp * 17 + 16]; a16[1] = api[pp * 17 + 16];
  }
  __syncthreads();
  for (int e = tid; e < 1024; e += 512) {
    const int pp = e >> 4;
    const float br = p.in[12][lg * 1024 + e], bi = p.in[13][lg * 1024 + e];
    bbr[e] = fre[pp] * br - fim[pp] * bi; bbi[e] = fre[pp] * bi + fim[pp] * br;
    ccr[e] = p.in[14][lg * 1024 + e]; cci[e] = p.in[15][lg * 1024 + e];
  }
  __syncthreads();
  for (int e = tid; e < 4096; e += 512) {
    const int j = e >> 8, cp = (e >> 4) & 15, c = e & 15;
    float s = 0.f;
    for (int pp = 0; pp < 64; ++pp) {
      const float xr = ccr[cp * 64 + pp] * apr[pp * 17 + j] - cci[cp * 64 + pp] * api[pp * 17 + j];
      const float xi = ccr[cp * 64 + pp] * api[pp * 17 + j] + cci[cp * 64 + pp] * apr[pp * 17 + j];
      s += xr * bbr[pp * 16 + c] - xi * bbi[pp * 16 + c];
    }
    if (j == 0 && cp == c) s += p.in[16][lg * 16 + c];
    Kv[e] = s;
  }
  __syncthreads();
  bf16_t* bs3 = (bf16_t*)(ws + W_BS3) + ((size_t)l * 16384 + (size_t)g * 256) * 384;
  for (int e = tid; e < 256 * 48; e += 512) {
    const int n = e / 48, k8 = e % 48, t = n >> 4, cp = n & 15;
    float v[8];
    if (k8 < 32) {
      const int s = k8 >> 1, c0 = (k8 & 1) * 8;
#pragma unroll
      for (int i = 0; i < 8; ++i) v[i] = (s <= t) ? Kv[((t - s) * 16 + cp) * 16 + c0 + i] : 0.f;
    } else {
      const int kk = (k8 - 32) * 8;
#pragma unroll
      for (int i = 0; i < 8; ++i) {
        const int q = kk + i, pp = q & 63;
        const float cr = ccr[cp * 64 + pp], ci = cci[cp * 64 + pp], ar = apr[pp * 17 + t + 1], ai = api[pp * 17 + t + 1];
        v[i] = q < 64 ? (cr * ar - ci * ai) : -(cr * ai + ci * ar);
      }
    }
    u32x4 o; o.x = cvt_pk_bf16(v[0], v[1]); o.y = cvt_pk_bf16(v[2], v[3]); o.z = cvt_pk_bf16(v[4], v[5]); o.w = cvt_pk_bf16(v[6], v[7]);
    *(u32x4*)(bs3 + (size_t)n * 384 + k8 * 8) = o;
  }
  bf16_t* bs1 = (bf16_t*)(ws + W_BS1) + ((size_t)l * 8192 + (size_t)(g >> 1) * 256 + (g & 1) * 128) * 512;
  for (int e = tid; e < 128 * 64; e += 512) {
    const int jn = e >> 6, k8 = e & 63, k = k8 * 8, pp = jn & 63;
    float v[8];
    if ((k >> 8) == (g & 1)) {
      const int s = (k & 255) >> 4, c0 = k & 15;
      const float ar = apr[pp * 17 + 15 - s], ai = api[pp * 17 + 15 - s];
#pragma unroll
      for (int i = 0; i < 8; ++i) {
        const float br = bbr[pp * 16 + c0 + i], bi = bbi[pp * 16 + c0 + i];
        v[i] = jn < 64 ? (ar * br - ai * bi) : (ar * bi + ai * br);
      }
    } else {
#pragma unroll
      for (int i = 0; i < 8; ++i) v[i] = 0.f;
    }
    u32x4 o; o.x = cvt_pk_bf16(v[0], v[1]); o.y = cvt_pk_bf16(v[2], v[3]); o.z = cvt_pk_bf16(v[4], v[5]); o.w = cvt_pk_bf16(v[6], v[7]);
    *(u32x4*)(bs1 + (size_t)jn * 512 + k) = o;
  }
  __syncthreads();
}

__device__ __forceinline__ size_t kf_off(int krow, int kvh, int kk, int hh) { return ((((size_t)(krow >> 5) * 4 + kvh) * 4 + kk) * 64 + hh * 32 + (krow & 31)) * 8; }
__device__ __forceinline__ size_t vf_off(int krow, int kvh, int d) {
  const int kin = krow & 15, hh = (kin >> 2) & 1, j = (kin >> 3) * 4 + (kin & 3);
  return ((((size_t)(krow >> 4) * 4 + kvh) * 2 + (d >> 5)) * 64 + hh * 32 + (d & 31)) * 8 + j;
}
__device__ __forceinline__ void cache_phase(const Params& p) {
  unsigned char* ws = p.ws;
  bf16_t* kb = (bf16_t*)(ws + W_KB); bf16_t* vt = (bf16_t*)(ws + W_VT);
  const int gt = bid_o() * 512 + tid_o(), nth = gdim_o() * 512;
  for (int e = gt; e < 32 * 128 * 32; e += nth) {
    const int i = e / (128 * 32), w = (e / 32) % 128, c8 = e % 32, kvh = c8 >> 3, d0 = (c8 & 7) * 8;
    const int krow = KS_BASE + i * 160 + w;
    const float* s = p.in[4] + ((size_t)i * 128 + w) * 256 + c8 * 8;
    const f32x4 a = *(const f32x4*)s, b = *(const f32x4*)(s + 4);
    u32x4 o; o.x = cvt_pk_bf16(a.x, a.y); o.y = cvt_pk_bf16(a.z, a.w); o.z = cvt_pk_bf16(b.x, b.y); o.w = cvt_pk_bf16(b.z, b.w);
    *(u32x4*)(kb + kf_off(krow, kvh, d0 >> 4, (d0 >> 3) & 1)) = o;
  }
  for (int e = gt; e < 32 * 128 * 256; e += nth) {
    const int i = e / (128 * 256), w = (e / 256) % 128, c = e % 256;
    vt[vf_off(KS_BASE + i * 160 + w, c >> 6, c & 63)] = f2bf(p.in[5][e]);
  }
}

template <int MODE>
__device__ __forceinline__ void norm_phase(const Params& p, const float* gain, int nks) {
  unsigned char* ws = p.ws;
  const int lane = tid_o() & 63, wv = tid_o() >> 6;
  bf16_t* ub = (bf16_t*)(ws + W_UB); float* rs = (float*)(ws + W_RS);
  if (MODE == 2) {
    const bf16_t* xb = (const bf16_t*)(ws + W_XB);
    for (int row = (bid_o() * 8 + wv) * 4; row < SPLIT_ROW0; row += gdim_o() * 32) {
      u32x2 raw[4][4];
#pragma unroll
      for (int q = 0; q < 4; ++q)
#pragma unroll
        for (int j = 0; j < 4; ++j) raw[q][j] = *(const u32x2*)(xb + (size_t)(row + q) * D + (lane + 64 * j) * 4);
#pragma unroll
      for (int q = 0; q < 4; ++q) {
        float s = 0.f;
#pragma unroll
        for (int j = 0; j < 4; ++j) { const f32x4 v = unpack4(raw[q][j]); s += (v.x * v.x + v.y * v.y) + (v.z * v.z + v.w * v.w); }
        const float r = rsqrtf(wave_sum(s, lane) * (1.f / D) + 1e-6f);
        if (lane == 0) rs[row + q] = r;
      }
    }
  }
  for (int row = ((MODE == 3 || MODE == 2) ? SPLIT_ROW0 : 0) + bid_o() * 8 + wv; row < R_PAD; row += gdim_o() * 8) {
    float* xr = xrow_ptr(p, row);
    f32x4 v[4];
    if (MODE == 0) {
      const float* src = xsrc_ptr(p, row);
#pragma unroll
      for (int j = 0; j < 4; ++j) v[j] = src ? *(const f32x4*)(src + (lane + 64 * j) * 4) : (f32x4){0.f, 0.f, 0.f, 0.f};
    } else {
      bf16_t* xbr = (bf16_t*)(ws + W_XB) + (size_t)row * D;
#pragma unroll
      for (int j = 0; j < 4; ++j) v[j] = unpack4(*(const u32x2*)(xbr + (lane + 64 * j) * 4));
      if (nks > 0 && row >= SPLIT_ROW0) {
        const float* pp = (const float*)(ws + W_PART) + (size_t)(row - SPLIT_ROW0) * D + lane * 4;
        for (int k = 0; k < nks; k += 4) {
          f32x4 t[4][4];
#pragma unroll
          for (int kk = 0; kk < 4; ++kk)
#pragma unroll
            for (int j = 0; j < 4; ++j) t[kk][j] = (k + kk < nks) ? *(const f32x4*)(pp + (size_t)(k + kk) * SPLIT_ROWS * D + 256 * j) : (f32x4){0.f, 0.f, 0.f, 0.f};
#pragma unroll
          for (int kk = 0; kk < 4; ++kk)
#pragma unroll
            for (int j = 0; j < 4; ++j) v[j] += t[kk][j];
        }
        if (MODE == 3) {
#pragma unroll
          for (int j = 0; j < 4; ++j) *(f32x4*)(xr + (lane + 64 * j) * 4) = v[j];
        } else {
#pragma unroll
          for (int j = 0; j < 4; ++j) { u32x2 o; o.x = cvt_pk_bf16(v[j].x, v[j].y); o.y = cvt_pk_bf16(v[j].z, v[j].w); *(u32x2*)(xbr + (lane + 64 * j) * 4) = o; }
        }
      }
    }
    if (MODE == 3) continue;
    float s = 0.f;
#pragma unroll
    for (int j = 0; j < 4; ++j) s += (v[j].x * v[j].x + v[j].y * v[j].y) + (v[j].z * v[j].z + v[j].w * v[j].w);
    const float r = rsqrtf(wave_sum(s, lane) * (1.f / D) + 1e-6f);
    if (MODE == 2) {
      if (lane == 0) rs[row] = r;
    }
    else {
#pragma unroll
      for (int j = 0; j < 4; ++j) {
        const f32x4 gg = *(const f32x4*)(gain + (lane + 64 * j) * 4);
        u32x2 o; o.x = cvt_pk_bf16(v[j].x * r * gg.x, v[j].y * r * gg.y); o.y = cvt_pk_bf16(v[j].z * r * gg.z, v[j].w * r * gg.w);
        const int col0 = (lane + 64 * j) * 4;
        if (row < R_REAL) {
          int cgi, s_;
          if (row < R_SAMPLE) { const int b_ = row >> 14, t = row & 16383; cgi = b_ * 1025 + 1 + (t >> 4); s_ = t & 15; }
          else if (row < R_META) { const int q = row - R_SAMPLE; cgi = 2050 + (q >> 4); s_ = q & 15; }
          else { cgi = 0; s_ = row - R_META; }
          const size_t off = (size_t)cgi * 16384 + (col0 >> 4) * 256 + s_ * 16 + (col0 & 15);
          *(u32x2*)(ub + off) = o;
          if (row >= R_META) *(u32x2*)(ub + off + (size_t)1025 * 16384) = o;
        }
      }
    }
  }
}

__device__ __forceinline__ void s2_phase(const Params& p, int l) {
  unsigned char* ws = p.ws;
  const float* sb = (const float*)(ws + W_SB); bf16_t* hin = (bf16_t*)(ws + W_HIN);
  const int lane = tid_o() & 63, wv = tid_o() >> 6;
  float* ex = (float*)shm;
  constexpr int SEG = 129;
  for (int item = bid_o(); item < 128; item += gdim_o()) {
    const int b = item >> 6, g = item & 63;
    const float* a16 = (const float*)(ws + W_A16) + (((size_t)l * 64 + g) * 64 + lane) * 2;
    const float ar = a16[0], ai = a16[1];
    const int c0 = wv * SEG, c1 = (c0 + SEG) < 1025 ? (c0 + SEG) : 1025;
    const float* sp = sb + (size_t)(b * 1025) * 8192 + g * 128 + lane;
    bf16_t* hp = hin + (size_t)(b * 1025) * 8192 + g * 128 + lane;
    float hr = 0.f, hi = 0.f;
    {
      int c = c0;
      float sr[8], si[8], pr[8], pi[8];
      if (c + 8 <= c1) {
#pragma unroll
        for (int u = 0; u < 8; ++u) { sr[u] = sp[(size_t)(c + u) * 8192]; si[u] = sp[(size_t)(c + u) * 8192 + 64]; }
      }
      for (; c + 8 <= c1; c += 8) {
        const bool more = c + 16 <= c1;
        if (more) {
#pragma unroll
          for (int u = 0; u < 8; ++u) { pr[u] = sp[(size_t)(c + 8 + u) * 8192]; pi[u] = sp[(size_t)(c + 8 + u) * 8192 + 64]; }
        }
#pragma unroll
        for (int u = 0; u < 8; ++u) { const float nr = ar * hr - ai * hi + sr[u], ni = ar * hi + ai * hr + si[u]; hr = nr; hi = ni; }
#pragma unroll
        for (int u = 0; u < 8; ++u) { sr[u] = pr[u]; si[u] = pi[u]; }
      }
      for (; c < c1; ++c) { const float sr = sp[(size_t)c * 8192], si = sp[(size_t)c * 8192 + 64]; const float nr = ar * hr - ai * hi + sr, ni = ar * hi + ai * hr + si; hr = nr; hi = ni; }
    }
    ex[(wv * 2) * 64 + lane] = hr; ex[(wv * 2 + 1) * 64 + lane] = hi;
    float qr = ar, qi = ai;
#pragma unroll
    for (int s = 0; s < 7; ++s) { const float t = qr * qr - qi * qi; qi = 2.f * qr * qi; qr = t; }
    { const float t = qr * ar - qi * ai; qi = qr * ai + qi * ar; qr = t; }
    __syncthreads();
    hr = 0.f; hi = 0.f;
    for (int j = 0; j < wv; ++j) { const float er = ex[(j * 2) * 64 + lane], ei = ex[(j * 2 + 1) * 64 + lane]; const float nr = qr * hr - qi * hi + er, ni = qr * hi + qi * hr + ei; hr = nr; hi = ni; }
    {
      int c = c0;
      float sr[8], si[8], pr[8], pi[8];
      if (c + 8 <= c1) {
#pragma unroll
        for (int u = 0; u < 8; ++u) { sr[u] = sp[(size_t)(c + u) * 8192]; si[u] = sp[(size_t)(c + u) * 8192 + 64]; }
      }
      for (; c + 8 <= c1; c += 8) {
        const bool more = c + 16 <= c1;
        if (more) {
#pragma unroll
          for (int u = 0; u < 8; ++u) { pr[u] = sp[(size_t)(c + 8 + u) * 8192]; pi[u] = sp[(size_t)(c + 8 + u) * 8192 + 64]; }
        }
#pragma unroll
        for (int u = 0; u < 8; ++u) {
          hp[(size_t)(c + u) * 8192] = f2bf(hr); hp[(size_t)(c + u) * 8192 + 64] = f2bf(hi);
          const float nr = ar * hr - ai * hi + sr[u], ni = ar * hi + ai * hr + si[u]; hr = nr; hi = ni;
        }
#pragma unroll
        for (int u = 0; u < 8; ++u) { sr[u] = pr[u]; si[u] = pi[u]; }
      }
      for (; c < c1; ++c) {
        const float sr = sp[(size_t)c * 8192], si = sp[(size_t)c * 8192 + 64];
        hp[(size_t)c * 8192] = f2bf(hr); hp[(size_t)c * 8192 + 64] = f2bf(hi);
        const float nr = ar * hr - ai * hi + sr, ni = ar * hi + ai * hr + si; hr = nr; hi = ni;
      }
    }
    if (wv == 7) {
      p.out[O_PRE + (((size_t)l * NB + b) * 64 + g) * 64 + lane] = hr; p.out[O_PIM + (((size_t)l * NB + b) * 64 + g) * 64 + lane] = hi;
    }
    __syncthreads();
  }
  for (int q = bid_o() * 8 + wv; q < 2048; q += gdim_o() * 8) {
    const int i = q >> 6, g = q & 63, c0 = 2050 + 2 * i;
    const size_t so = (((size_t)l * DB + i) * 64 + g) * 64 + lane;
    float hr = p.in[2][so], hi = p.in[3][so];
    const float* a16 = (const float*)(ws + W_A16) + (((size_t)l * 64 + g) * 64 + lane) * 2;
    const float ar = a16[0], ai = a16[1];
    const float* sp = sb + (size_t)c0 * 8192 + g * 128 + lane;
    bf16_t* hp = hin + (size_t)c0 * 8192 + g * 128 + lane;
#pragma unroll
    for (int c = 0; c < 2; ++c) {
      const float sr = sp[(size_t)c * 8192], si = sp[(size_t)c * 8192 + 64];
      hp[(size_t)c * 8192] = f2bf(hr); hp[(size_t)c * 8192 + 64] = f2bf(hi);
      const float nr = ar * hr - ai * hi + sr, ni = ar * hi + ai * hr + si; hr = nr; hi = ni;
    }
    p.out[O_SRE + so] = hr; p.out[O_SIM + so] = hi;
  }
}

__device__ __forceinline__ void kvfin_phase(const Params& p) {
  unsigned char* ws = p.ws;
  const float* kv = (const float*)(ws + W_KVRAW); bf16_t* kb = (bf16_t*)(ws + W_KB); bf16_t* vt = (bf16_t*)(ws + W_VT);
  const int lane = tid_o() & 63, wv = tid_o() >> 6;
  for (int row = bid_o() * 8 + wv; row < R_REAL; row += gdim_o() * 8) {
    const float* src = kv + (size_t)row * 512 + lane * 8;
    const f32x4 a = *(const f32x4*)src, b = *(const f32x4*)(src + 4);
    float v[8] = {a.x, a.y, a.z, a.w, b.x, b.y, b.z, b.w};
    const int col = (lane & 31) * 8, kvh = col >> 6, d0 = col & 63;
    int krow; float* ok = nullptr; float* ov = nullptr;
    if (row < R_SAMPLE) { const int b_ = row >> 14, t = row & 16383; krow = row;
      if (t >= SEQ - 128) { ok = p.out + O_PK + ((size_t)b_ * 128 + (t - (SEQ - 128))) * 256; ov = p.out + O_PV + ((size_t)b_ * 128 + (t - (SEQ - 128))) * 256; } }
    else if (row < R_META) { const int q = row - R_SAMPLE, i = q >> 5, j = q & 31; krow = KS_BASE + i * 160 + 128 + j;
      ok = p.out + O_SK + (size_t)q * 256; ov = p.out + O_SV + (size_t)q * 256; }
    else { krow = KM_BASE + (row - R_META); }
    if (lane < 32) {
      float s = 0.f;
#pragma unroll
      for (int i = 0; i < 8; ++i) s += v[i] * v[i];
      s += shx(s, 1, lane); s += shx(s, 2, lane); s += shx(s, 4, lane);
      const float r = rsqrtf(s * (1.f / 64.f) + 1e-6f);
#pragma unroll
      for (int i = 0; i < 8; ++i) v[i] = v[i] * r * p.in[22][d0 + i];
      u32x4 o; o.x = cvt_pk_bf16(v[0], v[1]); o.y = cvt_pk_bf16(v[2], v[3]); o.z = cvt_pk_bf16(v[4], v[5]); o.w = cvt_pk_bf16(v[6], v[7]);
      *(u32x4*)(kb + kf_off(krow, kvh, d0 >> 4, (d0 >> 3) & 1)) = o;
      if (ok) { *(f32x4*)(ok + col) = (f32x4){v[0], v[1], v[2], v[3]}; *(f32x4*)(ok + col + 4) = (f32x4){v[4], v[5], v[6], v[7]}; }
    } else {
      float s = 0.f; s += shx(s, 1, lane); s += shx(s, 2, lane); s += shx(s, 4, lane);
#pragma unroll
      for (int i = 0; i < 8; ++i) vt[vf_off(krow, kvh, d0 + i)] = f2bf(v[i]);
      if (ov) { *(f32x4*)(ov + col) = (f32x4){v[0], v[1], v[2], v[3]}; *(f32x4*)(ov + col + 4) = (f32x4){v[4], v[5], v[6], v[7]}; }
    }
  }
}

__device__ __forceinline__ int rel_bucket(int rel) {
  const int n = rel < 0 ? -rel : rel;
  const float nf = (float)(n < 1 ? 1 : n);
  int large = 8 + (int)(logf(nf / 8.f) / 2.772588722239781f * 8.f);
  large = large < 15 ? large : 15;
  return (rel > 0 ? 16 : 0) + (n < 8 ? n : large);
}

struct AttnItem { int kvh, nt_band, ktile0, sj0, tpos, qrow0, qi0, head; bool active; };
__device__ __forceinline__ AttnItem attn_item(int item, int wv) {
  AttnItem a;
  if (item < 2048) {
    const int b = item >> 10, n = (item >> 2) & 255; a.kvh = item & 3; a.head = a.kvh * 4 + (wv >> 1); const int qt = wv & 1;
    a.qi0 = qt * 32; a.qrow0 = b * SEQ + n * 64 + a.qi0; a.tpos = n * 64 + a.qi0;
    const int c0 = n >= 2 ? n - 2 : 0;
    a.nt_band = (n - c0 + 1) * 2;
    a.ktile0 = (b * SEQ + c0 * 64) >> 5;
    a.sj0 = n >= 2 ? 0 : (2 - n) * 64; a.active = true;
  } else {
    const int q = item - 2048, i = q >> 2; a.kvh = q & 3; a.head = a.kvh * 4 + (wv & 3); a.active = wv < 4;
    a.qi0 = 0; a.qrow0 = R_SAMPLE + i * 32; a.tpos = 1024; a.nt_band = 5;
    a.ktile0 = (KS_BASE + i * 160) >> 5; a.sj0 = 0;
  }
  return a;
}
constexpr int AT_BUF0 = 16896, AT_KV = 28672, AT_BUF = 2 * AT_KV;
__device__ __forceinline__ void attn_stage(const bf16_t* kb, const bf16_t* vt, int item, int buf, int wv, int lane) {
  const AttnItem a = attn_item(item, 0);
  LAS unsigned char* lds = (LAS unsigned char*)shm + AT_BUF0 + buf * AT_BUF;
#pragma unroll
  for (int t = 0; t < 7; ++t) {
    if (t <= a.nt_band) {
      const int T = t == 0 ? (KM_BASE >> 5) : a.ktile0 + (t - 1);
      const bf16_t* src; unsigned dst;
      if (wv < 4) { src = kb + ((((size_t)T * 4 + a.kvh) * 4 + wv) * 64 + lane) * 8; dst = t * 4096 + wv * 1024; }
      else { const int s = (wv - 4) >> 1, dt = (wv - 4) & 1; src = vt + (((((size_t)T * 2 + s) * 4 + a.kvh) * 2 + dt) * 64 + lane) * 8; dst = AT_KV + t * 4096 + (wv - 4) * 1024; }
      __builtin_amdgcn_global_load_lds((const unsigned*)src, (LAS unsigned*)(lds + dst), 16, 0, 0);
    }
  }
}

__device__ __forceinline__ void attn_phase(const Params& p, int jl) {
  unsigned char* ws = p.ws;
  float* lut = (float*)shm;
  float* qg = lut + 16 * 256;
  for (int e = tid_o(); e < 16 * 256; e += 512) {
    const int h = e >> 8, idx = e & 255; const int rel = idx - 191;
    lut[e] = idx < 255 ? p.in[27][rel_bucket(rel) * 16 + h] * 1.44269504089f : 0.f;
  }
  if (tid_o() < 64) qg[tid_o()] = p.in[24][jl * 64 + tid_o()] * (0.125f * 1.44269504089f);
  const bf16_t* qb = (const bf16_t*)(ws + W_UB); const bf16_t* kb = (const bf16_t*)(ws + W_KB); const bf16_t* vt = (const bf16_t*)(ws + W_VT);
  bf16_t* ao = (bf16_t*)(ws + W_YG);
  const int tid = tid_o(), lane = tid & 63, wv = __builtin_amdgcn_readfirstlane(tid >> 6), ql = lane & 31, hh = lane >> 5;
  const int G = gdim_o(), item0 = bid_o(), NITEM = 2048 + 128;
  u32x4 qraw[4];
  if (item0 < NITEM) {
    attn_stage(kb, vt, item0, 0, wv, lane);
    const AttnItem a = attn_item(item0, wv);
    const bf16_t* qp = qb + (size_t)(a.qrow0 + ql) * D + a.head * 64 + hh * 8;
#pragma unroll
    for (int kk = 0; kk < 4; ++kk) qraw[kk] = *(const u32x4*)(qp + kk * 16);
  }
  int cur = 0;
#pragma unroll 1
  for (int item = item0; item < NITEM; item += G, cur ^= 1) {
    asm volatile("s_waitcnt vmcnt(0)" ::: "memory");
    __syncthreads();
    const AttnItem a = attn_item(item, wv);
    u32x4 qcur[4];
#pragma unroll
    for (int kk = 0; kk < 4; ++kk) qcur[kk] = qraw[kk];
    if (item + G < NITEM) {
      attn_stage(kb, vt, item + G, cur ^ 1, wv, lane);
      const AttnItem an = attn_item(item + G, wv);
      const bf16_t* qp = qb + (size_t)(an.qrow0 + ql) * D + an.head * 64 + hh * 8;
#pragma unroll
      for (int kk = 0; kk < 4; ++kk) qraw[kk] = *(const u32x4*)(qp + kk * 16);
    }
    if (!a.active) continue;
    const int head = a.head, nt_band = a.nt_band, sj0 = a.sj0, qi0 = a.qi0, tpos = a.tpos, qrow0 = a.qrow0;
    const LAS unsigned char* kl = (const LAS unsigned char*)shm + AT_BUF0 + cur * AT_BUF + lane * 16;
    bf16x8 qf[4];
    {
      float qv[32]; float s = 0.f;
#pragma unroll
      for (int kk = 0; kk < 4; ++kk) {
        const unsigned w[4] = {qcur[kk].x, qcur[kk].y, qcur[kk].z, qcur[kk].w};
#pragma unroll
        for (int i = 0; i < 4; ++i) { qv[kk * 8 + 2 * i] = bf2f(w[i] & 0xffffu); qv[kk * 8 + 2 * i + 1] = bf2f(w[i] >> 16); }
      }
#pragma unroll
      for (int i = 0; i < 32; ++i) s += qv[i] * qv[i];
      s += shx(s, 32, lane);
      const float r = rsqrtf(s * (1.f / 64.f) + 1e-6f);
#pragma unroll
      for (int kk = 0; kk < 4; ++kk) {
        u32x4 o; const float* g8 = qg + kk * 16 + hh * 8;
        o.x = cvt_pk_bf16(qv[kk * 8 + 0] * r * g8[0], qv[kk * 8 + 1] * r * g8[1]); o.y = cvt_pk_bf16(qv[kk * 8 + 2] * r * g8[2], qv[kk * 8 + 3] * r * g8[3]);
        o.z = cvt_pk_bf16(qv[kk * 8 + 4] * r * g8[4], qv[kk * 8 + 5] * r * g8[5]); o.w = cvt_pk_bf16(qv[kk * 8 + 6] * r * g8[6], qv[kk * 8 + 7] * r * g8[7]);
        qf[kk] = __builtin_bit_cast(bf16x8, o);
      }
    }
    f32x16 sc[7];
#pragma unroll
    for (int t = 0; t < 7; ++t) {
      if (t <= nt_band) {
        f32x16 a_ = {0.f, 0.f, 0.f, 0.f, 0.f, 0.f, 0.f, 0.f, 0.f, 0.f, 0.f, 0.f, 0.f, 0.f, 0.f, 0.f};
#pragma unroll
        for (int kk = 0; kk < 4; ++kk) {
          const bf16x8 kf = *(const LAS bf16x8*)(kl + t * 4096 + kk * 1024);
          a_ = __builtin_amdgcn_mfma_f32_32x32x16_bf16(kf, qf[kk], a_, 0, 0, 0);
        }
        sc[t] = a_;
      }
    }
    const float sink = p.in[25][jl * 16 + head] * 1.44269504089f;
    const float* lh = lut + head * 256 + 191;
    float mx = sink;
    const int qi = qi0 + ql;
#pragma unroll
    for (int t = 0; t < 7; ++t) {
      if (t <= nt_band) {
#pragma unroll
        for (int r = 0; r < 16; ++r) {
          const int key = 8 * (r >> 2) + 4 * hh + (r & 3);
          float v;
          if (t == 0) {
            if (r < 8) { int rel = key - 16 - (tpos + ql); rel = rel < -191 ? -191 : rel; v = sc[t][r] + lh[rel]; } else v = -1e30f;
          } else {
            const int rel = sj0 + (t - 1) * 32 + key - 128 - qi;
            v = sc[t][r] + lh[rel];
          }
          sc[t][r] = v; mx = fmaxf(mx, v);
        }
      }
    }
    mx = fmaxf(mx, shx(mx, 32, lane));
    float sum = 0.f;
#pragma unroll
    for (int t = 0; t < 7; ++t) {
      if (t <= nt_band) {
#pragma unroll
        for (int r = 0; r < 16; ++r) { const float e = __builtin_amdgcn_exp2f(sc[t][r] - mx); sc[t][r] = e; sum += e; }
      }
    }
    sum += shx(sum, 32, lane);
    const float inv = 1.f / (sum + __builtin_amdgcn_exp2f(sink - mx));
    f32x16 o0 = {0.f, 0.f, 0.f, 0.f, 0.f, 0.f, 0.f, 0.f, 0.f, 0.f, 0.f, 0.f, 0.f, 0.f, 0.f, 0.f}, o1 = o0;
#pragma unroll
    for (int t = 0; t < 7; ++t) {
      if (t <= nt_band) {
#pragma unroll
        for (int s = 0; s < 2; ++s) {
          if (t == 0 && s == 1) continue;
          u32x4 pa; pa.x = cvt_pk_bf16(sc[t][8 * s + 0] * inv, sc[t][8 * s + 1] * inv); pa.y = cvt_pk_bf16(sc[t][8 * s + 2] * inv, sc[t][8 * s + 3] * inv);
          pa.z = cvt_pk_bf16(sc[t][8 * s + 4] * inv, sc[t][8 * s + 5] * inv); pa.w = cvt_pk_bf16(sc[t][8 * s + 6] * inv, sc[t][8 * s + 7] * inv);
          const bf16x8 pf = __builtin_bit_cast(bf16x8, pa);
          const bf16x8 b0 = *(const LAS bf16x8*)(kl + AT_KV + t * 4096 + s * 2048), b1 = *(const LAS bf16x8*)(kl + AT_KV + t * 4096 + s * 2048 + 1024);
          o0 = __builtin_amdgcn_mfma_f32_32x32x16_bf16(pf, b0, o0, 0, 0, 0);
          o1 = __builtin_amdgcn_mfma_f32_32x32x16_bf16(pf, b1, o1, 0, 0, 0);
        }
      }
    }
#pragma unroll
    for (int r = 0; r < 16; ++r) {
      const int q = 8 * (r >> 2) + 4 * hh + (r & 3);
      bf16_t* op = ao + (size_t)(qrow0 + q) * D + head * 64 + ql;
      op[0] = f2bf(o0[r]); op[32] = f2bf(o1[r]);
    }
  }
  asm volatile("s_waitcnt vmcnt(0)" ::: "memory");
  __syncthreads();
}

__global__ void __launch_bounds__(512) fwd_megakernel(Params p) {
  cg::grid_group grid = cg::this_grid();
  unsigned char* ws = p.ws;
  volatile LAS unsigned* xst = (volatile LAS unsigned*)((LAS unsigned char*)shm + XB_LDS_OFF);
  if (threadIdx.x < 4) xst[threadIdx.x] = 0u;
  __syncthreads();
  (void)xcd_barrier_post((unsigned*)(ws + W_BAR), xst);
  for (int it = bid_o(); it < 128; it += gdim_o()) s5_matrices(p, it >> 6, it & 63);
  weights_phase(p);
  cache_phase(p);
  norm_phase<0>(p, p.in[7], 0);
  if (p.ws == nullptr) grid.sync();
  xcd_barrier(p.ws);
#pragma unroll 1
  for (int l = 0; l < 4; ++l) {
    if (l < 2) {
      if (l == 1) { norm_phase<1>(p, p.in[7] + D, 11); xcd_barrier(p.ws); }
      gemm_phase<G_S1>(p, nullptr, 0, (const bf16_t*)(ws + W_BS1) + (size_t)l * 8192 * 512, 8192, 512);
      xcd_barrier(p.ws);
      if (PROBE == 9) { gemm_phase<G_S1>(p, nullptr, 0, (const bf16_t*)(ws + W_BS1) + (size_t)l * 8192 * 512, 8192, 512); xcd_barrier(p.ws); }
      s2_phase(p, l);
      xcd_barrier(p.ws);
      if (PROBE == 3) { s2_phase(p, l); xcd_barrier(p.ws); s2_phase(p, l); xcd_barrier(p.ws); }
      gemm_phase<G_S3>(p, nullptr, 0, (const bf16_t*)(ws + W_BS3) + (size_t)l * 16384 * 384, 16384, 384);
      xcd_barrier(p.ws);
      if (PROBE == 10) { gemm_phase<G_S3>(p, nullptr, 0, (const bf16_t*)(ws + W_BS3) + (size_t)l * 16384 * 384, 16384, 384); xcd_barrier(p.ws); }
      gemm_phase<G_GLU>(p, (const bf16_t*)(ws + W_YG), D, (const bf16_t*)(ws + W_WGLU) + (size_t)l * 2048 * 1024, 2048, 1024, l == 0);
      xcd_barrier(p.ws);
    } else {
      norm_phase<2>(p, nullptr, 11);
      xcd_barrier(p.ws);
      if (l == 2) gemm_phase<G_QKV>(p, (const bf16_t*)(ws + W_XB), D, (const bf16_t*)(ws + W_WQKV), 1536, 1024);
      else gemm_phase<G_QKV>(p, (const bf16_t*)(ws + W_XB), D, (const bf16_t*)(ws + W_WQKV) + (size_t)1536 * 1024, 1024, 1024);
      xcd_barrier(p.ws);
      if (l == 2) { kvfin_phase(p); xcd_barrier(p.ws); }
      attn_phase(p, l - 2);
      xcd_barrier(p.ws);
      if (PROBE == 4) { attn_phase(p, l - 2); xcd_barrier(p.ws); attn_phase(p, l - 2); xcd_barrier(p.ws); }
      gemm_phase<G_RESID>(p, (const bf16_t*)(ws + W_YG), D, (const bf16_t*)(ws + W_WO) + (size_t)(l - 2) * 1024 * 1024, 1024, 1024);
      xcd_barrier(p.ws);
    }
    norm_phase<2>(p, nullptr, l < 2 ? 0 : 4);
    xcd_barrier(p.ws);
    gemm_phase<G_FFIN>(p, (const bf16_t*)(ws + W_XB), D, (const bf16_t*)(ws + W_WIN) + (size_t)l * 5632 * 1024, 5632, 1024);
    xcd_barrier(p.ws);
    if (PROBE == 1) { gemm_phase<G_FFIN>(p, (const bf16_t*)(ws + W_XB), D, (const bf16_t*)(ws + W_WIN) + (size_t)l * 5632 * 1024, 5632, 1024); xcd_barrier(p.ws); }
    if (PROBE == 2) { for (int q = 0; q < 10; ++q) xcd_barrier(p.ws); }
    gemm_phase<G_RESID>(p, (const bf16_t*)(ws + W_HB), FF, (const bf16_t*)(ws + W_WOUT) + (size_t)l * 1024 * FF, 1024, FF, l == 3 ? 2 : 0);
    xcd_barrier(p.ws);
  }
  norm_phase<3>(p, nullptr, 11);
}

extern "C" void kernel_launch(void* const* d_in, const int* in_sizes, int n_in, void* d_out, int out_size, void* d_ws, size_t ws_size, hipStream_t stream) {
  static int grid_blocks = 0;
  if (grid_blocks == 0) {
    if (n_in != 28 || (size_t)out_size != O_END || ws_size < W_END) { fprintf(stderr, "kernel_launch: unexpected shapes (n_in %d out %d ws %zu need %zu)\n", n_in, out_size, ws_size, (size_t)W_END); grid_blocks = -1; return; }
    int dev = 0, cus = 0, per_cu = 0;
    hipGetDevice(&dev);
    hipDeviceGetAttribute(&cus, hipDeviceAttributeMultiprocessorCount, dev);
    if (hipFuncSetAttribute((const void*)fwd_megakernel, hipFuncAttributeMaxDynamicSharedMemorySize, LDS_BYTES) != hipSuccess) { fprintf(stderr, "kernel_launch: hipFuncSetAttribute failed\n"); }
    hipOccupancyMaxActiveBlocksPerMultiprocessor(&per_cu, (const void*)fwd_megakernel, 512, LDS_BYTES);
    if (per_cu < 1) { fprintf(stderr, "kernel_launch: occupancy query says %d blocks/CU\n", per_cu); per_cu = 1; }
    (void)hipGetLastError();
    grid_blocks = cus;
  }
  if (grid_blocks < 0) return;
  if (hipMemsetAsync((char*)d_ws + W_BAR, 0, 4096 * 4, stream) != hipSuccess) { fprintf(stderr, "kernel_launch: memset failed\n"); return; }
  Params p{};
  for (int i = 0; i < 28; ++i) p.in[i] = (const float*)d_in[i];
  p.out = (float*)d_out; p.ws = (unsigned char*)d_ws;
  void* args[] = {&p};
  hipError_t e = hipLaunchCooperativeKernel((const void*)fwd_megakernel, dim3(grid_blocks), dim3(512), args, LDS_BYTES, stream);
  if (e != hipSuccess) fprintf(stderr, "cooperative launch failed: %s (grid %d)\n", hipGetErrorString(e), grid_blocks);
}
```

```cpp
#include <hip/hip_runtime.h>
#include <hip/hip_cooperative_groups.h>
#include <cstdio>
#include <cstdint>
namespace cg = cooperative_groups;

typedef unsigned short bf16_t;
typedef short bf16x8 __attribute__((ext_vector_type(8)));
typedef float f32x4 __attribute__((ext_vector_type(4)));
typedef float f32x16 __attribute__((ext_vector_type(16)));
typedef unsigned u32x4 __attribute__((ext_vector_type(4)));
typedef unsigned u32x2 __attribute__((ext_vector_type(2)));

constexpr int D = 1024, SEQ = 16384, NB = 2, DB = 32, DS = 32, FF = 2816;
constexpr int R_PROMPT = 0, R_SAMPLE = 32768, R_META = 33792, R_REAL = 33808, R_PAD = 34048;
constexpr int NTM = R_PAD / 256;
constexpr int NCH = 2 * 1025 + 64, NCH_PAD = 2304;
constexpr int KROWS = 32768 + 32 * 160 + 16;
constexpr int KS_BASE = 32768, KM_BASE = 32768 + 5120;
constexpr size_t VT_S = (size_t)2 * 4 * 64 * 16384, VT_M = VT_S + (size_t)32 * 4 * 64 * 160;

constexpr size_t O_YP = 0, O_YS = 33554432, O_PRE = O_YS + 1048576, O_PIM = O_PRE + 16384, O_PK = O_PIM + 16384, O_PV = O_PK + 65536,
                 O_SRE = O_PV + 65536, O_SIM = O_SRE + 262144, O_SK = O_SIM + 262144, O_SV = O_SK + 262144, O_END = O_SV + 262144;

constexpr size_t al(size_t x) { return (x + 255) & ~(size_t)255; }
constexpr size_t W_XMETA = 0;
constexpr size_t W_XB = al(W_XMETA + (size_t)256 * D * 4);
constexpr size_t W_RS = al(W_XB + (size_t)R_PAD * D * 2);
constexpr size_t W_UB = al(W_RS + (size_t)R_PAD * 4);
constexpr size_t W_YG = al(W_UB + (size_t)R_PAD * D * 2);
constexpr size_t W_SB = al(W_YG + (size_t)R_PAD * D * 2);
constexpr size_t W_HIN = al(W_SB + (size_t)NCH_PAD * 8192 * 4);
constexpr size_t W_KB = al(W_HIN + (size_t)NCH_PAD * 8192 * 2);
constexpr size_t W_VT = al(W_KB + (size_t)(KROWS + 16) * 256 * 2);
constexpr size_t W_WGLU = al(W_VT + (size_t)(KROWS + 16) * 256 * 2);
constexpr size_t W_WIN = al(W_WGLU + (size_t)2 * 2048 * 1024 * 2);
constexpr size_t W_WOUT = al(W_WIN + (size_t)4 * 5632 * 1024 * 2);
constexpr size_t W_WQKV = al(W_WOUT + (size_t)4 * 1024 * FF * 2);
constexpr size_t W_WO = al(W_WQKV + (size_t)2560 * 1024 * 2);
constexpr size_t W_BS1 = al(W_WO + (size_t)2 * 1024 * 1024 * 2);
constexpr size_t W_BS3 = al(W_BS1 + (size_t)2 * 8192 * 512 * 2);
constexpr size_t W_A16 = al(W_BS3 + (size_t)2 * 16384 * 384 * 2);
constexpr size_t W_BAR = al(W_A16 + (size_t)2 * 64 * 64 * 8);
constexpr size_t W_END = al(W_BAR + (size_t)4096 * 4);
constexpr size_t W_HB = W_UB;
constexpr size_t W_KVRAW = W_SB;
constexpr size_t W_PART = W_UB + (size_t)R_PAD * FF * 2;
constexpr int SPLIT_ROW0 = 32768, SPLIT_ROWS = R_PAD - 32768, SPLIT_PM0 = 128;
static_assert(W_PART + (size_t)11 * SPLIT_ROWS * D * 4 <= W_KB, "partials overlay");
static_assert((size_t)R_PAD * FF * 2 <= W_HIN - W_UB, "hb overlay");
static_assert((size_t)R_PAD * 512 * 4 <= W_HIN - W_SB, "kvraw overlay");
static_assert(W_END <= (size_t)512 * 1024 * 1024, "workspace");

constexpr int LDS_BYTES = 147456;
constexpr int XB_LDS_OFF = LDS_BYTES - 16;
constexpr int PROBE = 0;

struct Params {
  const float* in[28];
  float* out;
  unsigned char* ws;
};

extern __shared__ __attribute__((aligned(16))) unsigned char shm[];

__device__ __forceinline__ unsigned cvt_pk_bf16(float lo, float hi) { unsigned r; asm volatile("v_cvt_pk_bf16_f32 %0, %1, %2" : "=v"(r) : "v"(lo), "v"(hi)); return r; }
__device__ __forceinline__ bf16_t f2bf(float f) { return (bf16_t)(cvt_pk_bf16(f, 0.f) & 0xffffu); }
__device__ __forceinline__ float bf2f(unsigned b) { return __uint_as_float(b << 16); }
__device__ __forceinline__ f32x4 unpack4(u32x2 r) { return (f32x4){__uint_as_float(r.x << 16), __uint_as_float(r.x & 0xffff0000u), __uint_as_float(r.y << 16), __uint_as_float(r.y & 0xffff0000u)}; }
__device__ __forceinline__ float shx(float v, int o, int lane) { return __int_as_float(__builtin_amdgcn_ds_bpermute((lane ^ o) << 2, __float_as_int(v))); }
__device__ __forceinline__ float wave_sum(float v, int lane) {
#pragma unroll
  for (int o = 1; o < 64; o <<= 1) v += shx(v, o, lane);
  return v;
}
__device__ __forceinline__ int tid_o() { int t = threadIdx.x; asm volatile("" : "+v"(t)); return t; }
__device__ __forceinline__ int bid_o() { int b = blockIdx.x; asm volatile("" : "+s"(b)); return b; }
__device__ __forceinline__ int gdim_o() { int b = gridDim.x; asm volatile("" : "+s"(b)); return b; }
__device__ __forceinline__ float sigmoidf_(float x) { return __builtin_amdgcn_rcpf(1.f + __expf(-x)); }
__device__ __forceinline__ float gelu_tanh(float x) {
  const float x2 = x * x;
  const float w = x * (-2.302208198f - 0.102943242f * x2);
  return x * __builtin_amdgcn_rcpf(1.f + __builtin_amdgcn_exp2f(w));
}
__device__ __forceinline__ float* xrow_ptr(const Params& p, int row) {
  return row < R_META ? p.out + (size_t)row * D : (float*)(p.ws + W_XMETA) + (size_t)(row - R_META) * D;
}
__device__ __forceinline__ const float* xsrc_ptr(const Params& p, int row) {
  return row < R_SAMPLE ? p.in[0] + (size_t)row * D : row < R_META ? p.in[1] + (size_t)(row - R_SAMPLE) * D : row < R_REAL ? p.in[6] + (size_t)(row - R_META) * D : nullptr;
}
__device__ __forceinline__ int chunk_row(int cgi) {
  if (cgi >= NCH) cgi = 0;
  if (cgi < 2050) { const int b = cgi >= 1025 ? 1 : 0; const int c = cgi - b * 1025; return c == 0 ? R_META : b * SEQ + (c - 1) * 16; }
  return R_SAMPLE + (cgi - 2050) * 16;
}

#define LAS __attribute__((address_space(3)))
constexpr int BM = 256, BK = 64, HALF = 128, HTB = HALF * BK * 2;
__device__ __forceinline__ int lds_byte(int r, int c) {
  int st = (r >> 4) * 2 + (c >> 5), rr = r & 15, cc = c & 31, ob = rr * 64 + cc * 2;
  return st * 1024 + (ob ^ (((ob >> 9) & 1) << 5));
}
__device__ __forceinline__ void stage_rc(int b, int& R, int& C) {
  int st = b / 1024, sb = b % 1024, swz = sb ^ (((sb >> 9) & 1) << 5);
  R = (st >> 1) * 16 + swz / 64; C = (st & 1) * 32 + (swz % 64) / 2;
}

typedef f32x4 acc_t[2][2][4][2];

struct ARow {
  const char* base; unsigned hstep; unsigned voff[2];
  __device__ __forceinline__ void init(const bf16_t* A, int lda, int brow) {
    base = (const char*)(A + (size_t)brow * lda); hstep = (unsigned)HALF * lda * 2u;
#pragma unroll
    for (int i = 0; i < 2; ++i) { int R, C; stage_rc(tid_o() * 16 + i * 8192, R, C); voff[i] = (unsigned)(R * lda + C) * 2u; }
  }
  __device__ __forceinline__ const char* ptr(int h, int i, int kt) const { return base + (size_t)h * hstep + (size_t)kt * 128 + voff[i]; }
};
struct AS1 {
  const char* ub; unsigned voff[2][2]; int pn;
  __device__ __forceinline__ void init(const bf16_t* u, int brow, int pn_) {
    ub = (const char*)u; pn = pn_;
#pragma unroll
    for (int h = 0; h < 2; ++h)
#pragma unroll
      for (int i = 0; i < 2; ++i) { int R, C; stage_rc(tid_o() * 16 + i * 8192, R, C);
        voff[h][i] = (unsigned)(chunk_row(brow + h * 128 + R) + (C >> 4)) * 2048u + (unsigned)(C & 15) * 2u; }
  }
  __device__ __forceinline__ const char* ptr(int h, int i, int kt) const { return ub + (size_t)((pn * 2 + (kt >> 2)) * 32 + (kt & 3) * 8192) + voff[h][i]; }
};
struct AS3 {
  const char* ub; const char* hin; unsigned voffu[2][2], voffh[2][2]; int g;
  __device__ __forceinline__ void init(const bf16_t* u, const bf16_t* hn, int brow, int g_) {
    ub = (const char*)u; hin = (const char*)hn; g = g_;
#pragma unroll
    for (int h = 0; h < 2; ++h)
#pragma unroll
      for (int i = 0; i < 2; ++i) { int R, C; stage_rc(tid_o() * 16 + i * 8192, R, C);
        int cgi = brow + h * 128 + R; if (cgi >= NCH) cgi = 0;
        voffu[h][i] = (unsigned)cgi * 32768u + (unsigned)C * 2u;
        voffh[h][i] = (unsigned)cgi * 16384u + (unsigned)C * 2u; }
  }
  __device__ __forceinline__ const char* ptr(int h, int i, int kt) const {
    return kt < 4 ? ub + (size_t)(g * 512 + kt * 128) + voffu[h][i] : hin + (size_t)(g * 256 + (kt - 4) * 128) + voffh[h][i];
  }
};

template <class AF>
__device__ __forceinline__ void gemm_mainloop(acc_t& acc, const AF& A, const bf16_t* Bt, int K, int bcol, int nt) {
  LAS unsigned char* lds = (LAS unsigned char*)shm;
  const int tid = tid_o(), wid = __builtin_amdgcn_readfirstlane(tid >> 6), lane = tid & 63, wr = wid >> 2, wc = wid & 3, fr = lane & 15, fq = lane >> 4;
  unsigned voffB[2];
#pragma unroll
  for (int i = 0; i < 2; ++i) { int R, C; stage_rc(tid * 16 + i * 8192, R, C); voffB[i] = (unsigned)(R * K + C) * 2u; }
  const char* cB = (const char*)(Bt + (size_t)bcol * K);
  const size_t hstepB = (size_t)HALF * K * 2;
  const unsigned ldsw = (unsigned)wid * 1024u;
  const int aoff = lds_byte(wr * 64 + fr, fq * 8), boff = lds_byte(wc * 32 + fr, fq * 8);
#define SA(b, h) (((b) * 2 + (h)) * HTB)
#define SB(b, h) ((4 + (b) * 2 + (h)) * HTB)
#define STAGE_A(bufoff, h, kt) do { _Pragma("unroll") for (int _i = 0; _i < 2; ++_i) \
    __builtin_amdgcn_global_load_lds((const unsigned*)A.ptr(h, _i, kt), (LAS unsigned*)(lds + (bufoff) + ldsw + _i * 8192), 16, 0, 0); } while (0)
#define STAGE_B(bufoff, h, kt) do { _Pragma("unroll") for (int _i = 0; _i < 2; ++_i) \
    __builtin_amdgcn_global_load_lds((const unsigned*)(cB + (size_t)(h) * hstepB + (size_t)(kt) * 128 + voffB[_i]), (LAS unsigned*)(lds + (bufoff) + ldsw + _i * 8192), 16, 0, 0); } while (0)
#define LDA(dst, b, h) do { _Pragma("unroll") for (int m = 0; m < 4; ++m) _Pragma("unroll") for (int k = 0; k < 2; ++k) dst[m][k] = *(const LAS bf16x8*)(lds + SA(b, h) + aoff + m * 2048 + k * 1024); } while (0)
#define LDB(dst, b, h) do { _Pragma("unroll") for (int n = 0; n < 2; ++n) _Pragma("unroll") for (int k = 0; k < 2; ++k) dst[n][k] = *(const LAS bf16x8*)(lds + SB(b, h) + boff + n * 2048 + k * 1024); } while (0)
#define MMA(ai, bj, At_, Bt_) do { __builtin_amdgcn_s_setprio(1); _Pragma("unroll") for (int m = 0; m < 4; ++m) _Pragma("unroll") for (int n = 0; n < 2; ++n) _Pragma("unroll") for (int k = 0; k < 2; ++k) \
      acc[ai][bj][m][n] = __builtin_amdgcn_mfma_f32_16x16x32_bf16(Bt_[n][k], At_[m][k], acc[ai][bj][m][n], 0, 0, 0); \
    __builtin_amdgcn_s_setprio(0); } while (0)
#define WAIT_V(n) asm volatile("s_waitcnt vmcnt(" #n ")" ::: "memory")
#define WAIT_L(n) asm volatile("s_waitcnt lgkmcnt(" #n ")" ::: "memory")
#define BAR __builtin_amdgcn_s_barrier()
#define SCHED __builtin_amdgcn_sched_barrier(0)
#pragma unroll
  for (int a = 0; a < 2; ++a)
#pragma unroll
    for (int b = 0; b < 2; ++b)
#pragma unroll
      for (int m = 0; m < 4; ++m)
#pragma unroll
        for (int n = 0; n < 2; ++n) acc[a][b][m][n] = (f32x4){0.f, 0.f, 0.f, 0.f};
  bf16x8 At[4][2], B0[2][2], B1[2][2];
  STAGE_B(SB(0, 0), 0, 0); STAGE_B(SB(0, 1), 1, 0); STAGE_A(SA(0, 0), 0, 0); STAGE_A(SA(0, 1), 1, 0);
  if (wr == 1) BAR;
  WAIT_V(2); BAR;
  STAGE_B(SB(1, 0), 0, 1); STAGE_A(SA(1, 0), 0, 1); STAGE_B(SB(1, 1), 1, 1);
  WAIT_V(6); BAR;
#pragma unroll 1
  for (int t = 0; t < nt - 2; t += 2) {
    const int k2 = t + 2, k3 = t + 3;
    LDB(B0, 0, 0); LDB(B1, 0, 1); SCHED; LDA(At, 0, 0); STAGE_A(SA(1, 1), 1, t + 1);
    WAIT_V(8); WAIT_L(0); BAR; MMA(0, 0, At, B0); MMA(0, 1, At, B1); BAR; SCHED;
    LDA(At, 0, 1); STAGE_B(SB(0, 0), 0, k2); STAGE_B(SB(0, 1), 1, k2); STAGE_A(SA(0, 0), 0, k2);
    WAIT_V(8); WAIT_L(0); BAR; MMA(1, 0, At, B0); MMA(1, 1, At, B1); BAR; SCHED;
    LDB(B0, 1, 0); LDB(B1, 1, 1); SCHED; LDA(At, 1, 0); STAGE_A(SA(0, 1), 1, k2);
    WAIT_V(8); WAIT_L(0); BAR; MMA(0, 0, At, B0); MMA(0, 1, At, B1); BAR; SCHED;
    LDA(At, 1, 1); STAGE_B(SB(1, 0), 0, k3); STAGE_B(SB(1, 1), 1, k3); STAGE_A(SA(1, 0), 0, k3);
    WAIT_V(8); WAIT_L(0); BAR; MMA(1, 0, At, B0); MMA(1, 1, At, B1); BAR; SCHED;
  }
  {
    LDB(B0, 0, 0); LDB(B1, 0, 1); SCHED; LDA(At, 0, 0); STAGE_A(SA(1, 1), 1, nt - 1);
    WAIT_V(8); WAIT_L(0); BAR; MMA(0, 0, At, B0); MMA(0, 1, At, B1); BAR; SCHED;
    LDA(At, 0, 1);
    WAIT_V(2); WAIT_L(0); BAR; MMA(1, 0, At, B0); MMA(1, 1, At, B1); BAR; SCHED;
    LDB(B0, 1, 0); LDB(B1, 1, 1); SCHED; LDA(At, 1, 0);
    WAIT_V(0); WAIT_L(0); BAR; MMA(0, 0, At, B0); MMA(0, 1, At, B1); BAR; SCHED;
    LDA(At, 1, 1);
    WAIT_L(0); BAR; MMA(1, 0, At, B0); MMA(1, 1, At, B1); BAR;
  }
  WAIT_V(0);
  if (wr == 0) BAR;
  BAR;
#undef SA
#undef SB
}


#define XB_TMO      128
#define XB_XCNT(j)  (256  + 64 * (j))
#define XB_XSUB(j)  (1280 + 64 * (j))
#define XB_XGEN(j)  (2304 + 64 * (j))
#define XB_TOP      3328
#define XB_TOPGEN   3392
#define XCD_BAR_WORDS 3456
#define XB_SPIN_CAP (1u << 18)
__device__ __forceinline__ unsigned xb_ld(unsigned* p)              { return __hip_atomic_load(p, __ATOMIC_RELAXED, __HIP_MEMORY_SCOPE_AGENT); }
__device__ __forceinline__ unsigned xb_add(unsigned* p, unsigned v) { return __hip_atomic_fetch_add(p, v, __ATOMIC_RELAXED, __HIP_MEMORY_SCOPE_AGENT); }
__device__ __forceinline__ unsigned xb_xcc_id() { return (unsigned)__builtin_amdgcn_s_getreg((3 << 11) | 20) & 0xFu; }
#define XB_SPIN(cond, bar) do { unsigned _sp = 0; while (cond) { __builtin_amdgcn_s_sleep(1); \
    if ((++_sp & 255u) == 0u) { if (xb_ld(&(bar)[XB_TMO])) break; if (_sp > XB_SPIN_CAP) { atomicAdd(&(bar)[XB_TMO], 1u); break; } } } } while (0)
struct XcdBarrier { unsigned* bar; unsigned x; volatile LAS unsigned* st; };
__device__ __forceinline__ XcdBarrier xcd_barrier_post(unsigned* bar, volatile LAS unsigned* st) {
  XcdBarrier b; b.bar = bar; b.x = xb_xcc_id(); b.st = st;
  if (threadIdx.x == 0) (void)xb_add(&bar[XB_XCNT(b.x)], 1u);
  return b;
}
__device__ __forceinline__ void xcd_barrier_complete(unsigned* bar, unsigned x, unsigned& nloc, unsigned& nx) {
  const unsigned G = gridDim.x * gridDim.y * gridDim.z;
  unsigned sum, cnt, mine, sp = 0u;
  for (;;) {
    sum = 0u; cnt = 0u; mine = 0u;
#pragma unroll
    for (unsigned j = 0; j < 16; ++j) { const unsigned c = xb_ld(&bar[XB_XCNT(j)]); sum += c; cnt += (c > 0u) ? 1u : 0u; mine = (j == x) ? c : mine; }
    if (sum == G) break;
    __builtin_amdgcn_s_sleep(1);
    if ((++sp & 255u) == 0u) { if (xb_ld(&bar[XB_TMO])) break; if (sp > XB_SPIN_CAP) { atomicAdd(&bar[XB_TMO], 1u); break; } }
  }
  nloc = mine > 0u ? mine : 1u; nx = cnt > 0u ? cnt : 1u;
}
__device__ __forceinline__ void xcd_barrier(unsigned char* ws_) {
  XcdBarrier b; b.bar = (unsigned*)(ws_ + W_BAR); b.x = xb_xcc_id(); b.st = (volatile LAS unsigned*)((LAS unsigned char*)shm + XB_LDS_OFF);
  asm volatile("s_waitcnt vmcnt(0)" ::: "memory");
  __syncthreads();
  if (threadIdx.x == 0) {
    unsigned* bar = b.bar;
    __builtin_amdgcn_s_waitcnt(0);
    unsigned nloc = b.st[0], nx = b.st[1];
    if (nloc == 0u) { xcd_barrier_complete(bar, b.x, nloc, nx); b.st[0] = nloc; b.st[1] = nx; }
    const unsigned old = xb_add(&bar[XB_XSUB(b.x)], 1u);
    const unsigned gen = old / nloc;
    if (old + 1u == (gen + 1u) * nloc) {
      __builtin_amdgcn_fence(__ATOMIC_RELEASE, "agent");
      asm volatile("s_waitcnt vmcnt(0)" ::: "memory");
      const unsigned og = xb_add(&bar[XB_TOP], 1u);
      const unsigned tg = og / nx;
      if (og + 1u == (tg + 1u) * nx) xb_add(&bar[XB_TOPGEN], 1u);
      else XB_SPIN(xb_ld(&bar[XB_TOPGEN]) == tg, bar);
      __builtin_amdgcn_fence(__ATOMIC_ACQUIRE, "agent");
      xb_add(&bar[XB_XGEN(b.x)], 1u);
      asm volatile("s_waitcnt vmcnt(0)" ::: "memory");
    } else {
      XB_SPIN(xb_ld(&bar[XB_XGEN(b.x)]) == gen, bar);
      __builtin_amdgcn_fence(__ATOMIC_ACQUIRE, "agent");
      asm volatile("s_waitcnt vmcnt(0)" ::: "memory");
    }
  }
  __syncthreads();
}

__device__ __forceinline__ bool tile_at(long L, int nM, int nN, int& pm, int& pn) {
  const int nwg = nM * nN;
  if (L >= nwg) return false;
  int wgid = (int)L;
  { const int q = nwg / 8, r = nwg % 8, xcd = wgid % 8, off = wgid / 8; wgid = (xcd < r ? xcd * (q + 1) : r * (q + 1) + (xcd - r) * q) + off; }
  const int nig = 8 * nN, gid = wgid / nig, fm = gid * 8, gsz = (nM - fm) < 8 ? (nM - fm) : 8;
  pm = fm + ((wgid % nig) % gsz); pn = (wgid % nig) / gsz;
  return true;
}
__device__ __forceinline__ bool tile_next(int it, int nM, int nN, int& pm, int& pn) { return tile_at((long)it * gdim_o() + bid_o(), nM, nN, pm, pn); }

#define EPI_ROWS_BEGIN \
  const int wid = tid_o() >> 6, lane = tid_o() & 63, wr = wid >> 2, wc = wid & 3, fr = lane & 15, fq = lane >> 4; \
  _Pragma("unroll") for (int ai = 0; ai < 2; ++ai) _Pragma("unroll") for (int m = 0; m < 4; ++m) { \
    const int row = brow + ai * 128 + wr * 64 + m * 16 + fr;
#define EPI_ROWS_END }

enum { G_GLU = 0, G_FFIN = 1, G_RESID = 2, G_QKV = 3, G_S1 = 4, G_S3 = 5 };

template <int MODE>
__device__ __forceinline__ void gemm_phase(const Params& p, const bf16_t* A, int lda, const bf16_t* Bt, int N, int K, int first = 0) {
  const int nM = (MODE == G_S1 || MODE == G_S3) ? NCH_PAD / 256 : NTM, nN = N / 256, nt = K / BK;
  unsigned char* ws = p.ws;
  const int G = gdim_o(), ks = nt / 4, nsplit = (NTM - SPLIT_PM0) * nN * ks, nMw = (MODE == G_RESID) ? SPLIT_PM0 : nM;
  const int nfull_it = (nMw * nN + G - 1) / G;
#pragma unroll 1
  for (int it = 0;; ++it) {
    int pm, pn; bool split = false; int kt0 = 0, ntu = nt, ksi = 0;
    if (MODE == G_RESID && it >= nfull_it) {
      const int u = (it - nfull_it) * G + bid_o();
      if (u >= nsplit) break;
      ksi = u % ks; const int tq = u / ks; pn = tq % nN; pm = SPLIT_PM0 + tq / nN;
      split = true; kt0 = ksi * 4; ntu = 4;
    } else if (!tile_next(it, nMw, nN, pm, pn)) { if (MODE == G_RESID) continue; else break; }
    const int brow = pm * 256, bcol = pn * 256;
    float rsv[8];
    if (MODE == G_FFIN || MODE == G_QKV) {
      const int tid_ = tid_o(), wr_ = (tid_ >> 6) >> 2, fr_ = tid_ & 15;
      const float* rsp = (const float*)(ws + W_RS) + brow + wr_ * 64 + fr_;
#pragma unroll
      for (int q = 0; q < 8; ++q) rsv[q] = rsp[(q >> 2) * 128 + (q & 3) * 16];
    }
    acc_t acc;
    if (MODE == G_S1) { ARow af; af.init((const bf16_t*)(ws + W_UB) + pn * 512, 16384, brow); gemm_mainloop(acc, af, Bt, K, bcol, nt); }
    else if (MODE == G_S3) { AS3 af; af.init((const bf16_t*)(ws + W_UB), (const bf16_t*)(ws + W_HIN), brow, pn); gemm_mainloop(acc, af, Bt, K, bcol, nt); }
    else { ARow af; af.init(A + kt0 * BK, lda, brow); gemm_mainloop(acc, af, Bt + kt0 * BK, K, bcol, ntu); }
    if (MODE == G_GLU) {
      bf16_t* xb = (bf16_t*)(ws + W_XB);
      EPI_ROWS_BEGIN
        bf16_t* xr = xb + (size_t)row * D;
        const int oc = (bcol >> 1) + wc * 32 + fq * 8;
        f32x4 x0, x1;
        if (first & 1) { const float* xs = xsrc_ptr(p, row); x0 = xs ? *(const f32x4*)(xs + oc) : (f32x4){0.f, 0.f, 0.f, 0.f}; x1 = xs ? *(const f32x4*)(xs + oc + 4) : (f32x4){0.f, 0.f, 0.f, 0.f}; }
        else { const u32x4 raw = *(const u32x4*)(xr + oc); x0 = unpack4((u32x2){raw.x, raw.y}); x1 = unpack4((u32x2){raw.z, raw.w}); }
#pragma unroll
        for (int j = 0; j < 4; ++j) { x0[j] += acc[ai][0][m][0][j] * sigmoidf_(acc[ai][1][m][0][j]); x1[j] += acc[ai][0][m][1][j] * sigmoidf_(acc[ai][1][m][1][j]); }
        u32x4 o; o.x = cvt_pk_bf16(x0[0], x0[1]); o.y = cvt_pk_bf16(x0[2], x0[3]); o.z = cvt_pk_bf16(x1[0], x1[1]); o.w = cvt_pk_bf16(x1[2], x1[3]);
        *(u32x4*)(xr + oc) = o;
      EPI_ROWS_END
    } else if (MODE == G_FFIN) {
      bf16_t* hb = (bf16_t*)(ws + W_HB); const float* rs = (const float*)(ws + W_RS);
      EPI_ROWS_BEGIN
        const float s = rsv[ai * 4 + m];
        const int oc = (bcol >> 1) + wc * 32 + fq * 8;
        float hv[8];
#pragma unroll
        for (int n = 0; n < 2; ++n)
#pragma unroll
          for (int j = 0; j < 4; ++j) { const float gt = acc[ai][0][m][n][j] * s, up = acc[ai][1][m][n][j] * s; hv[n * 4 + j] = gt * sigmoidf_(gt) * up; }
        u32x4 o; o.x = cvt_pk_bf16(hv[0], hv[1]); o.y = cvt_pk_bf16(hv[2], hv[3]); o.z = cvt_pk_bf16(hv[4], hv[5]); o.w = cvt_pk_bf16(hv[6], hv[7]);
        *(u32x4*)(hb + (size_t)row * FF + oc) = o;
      EPI_ROWS_END
    } else if (MODE == G_RESID) {
      bf16_t* xb = (bf16_t*)(ws + W_XB);
      EPI_ROWS_BEGIN
        bf16_t* xr = xb + (size_t)row * D;
#pragma unroll
        for (int bj = 0; bj < 2; ++bj)
#pragma unroll
          for (int n = 0; n < 2; ++n) {
            const int oc = bcol + bj * 128 + wc * 32 + n * 16 + fq * 4;
            if (split) {
              *(f32x4*)((float*)(ws + W_PART) + ((size_t)ksi * SPLIT_ROWS + (row - SPLIT_ROW0)) * D + oc) = acc[ai][bj][m][n];
            } else {
              f32x4 x = unpack4(*(const u32x2*)(xr + oc));
              x += acc[ai][bj][m][n];
              if (first & 2) *(f32x4*)(xrow_ptr(p, row) + oc) = x;
              else { u32x2 o; o.x = cvt_pk_bf16(x[0], x[1]); o.y = cvt_pk_bf16(x[2], x[3]); *(u32x2*)(xr + oc) = o; }
            }
          }
      EPI_ROWS_END
    } else if (MODE == G_QKV) {
      bf16_t* qb = (bf16_t*)(ws + W_UB); float* kv = (float*)(ws + W_KVRAW); const float* rs = (const float*)(ws + W_RS);
      EPI_ROWS_BEGIN
        const float s = rsv[ai * 4 + m];
#pragma unroll
        for (int bj = 0; bj < 2; ++bj)
#pragma unroll
          for (int n = 0; n < 2; ++n) {
            const int oc = bcol + bj * 128 + wc * 32 + n * 16 + fq * 4;
            const f32x4 v = acc[ai][bj][m][n] * s;
            if (bcol < 1024) { u32x2 o; o.x = cvt_pk_bf16(v[0], v[1]); o.y = cvt_pk_bf16(v[2], v[3]); *(u32x2*)(qb + (size_t)row * D + oc) = o; }
            else *(f32x4*)(kv + (size_t)row * 512 + (oc - 1024)) = v;
          }
      EPI_ROWS_END
    } else if (MODE == G_S1) {
      float* sb = (float*)(ws + W_SB);
      EPI_ROWS_BEGIN
#pragma unroll
        for (int bj = 0; bj < 2; ++bj)
#pragma unroll
          for (int n = 0; n < 2; ++n) {
            const int oc = bcol + bj * 128 + wc * 32 + n * 16 + fq * 4;
            *(f32x4*)(sb + (size_t)row * 8192 + oc) = acc[ai][bj][m][n];
          }
      EPI_ROWS_END
    } else if (MODE == G_S3) {
      bf16_t* yg = (bf16_t*)(ws + W_YG);
      EPI_ROWS_BEGIN
        const bool valid = row < NCH && row != 1025;
        const int tr = chunk_row(row);
        if (valid) {
#pragma unroll
          for (int bj = 0; bj < 2; ++bj)
#pragma unroll
            for (int n = 0; n < 2; ++n) {
              const int t = bj * 8 + wc * 2 + n;
              const f32x4 v = acc[ai][bj][m][n];
              u32x2 o; o.x = cvt_pk_bf16(gelu_tanh(v[0]), gelu_tanh(v[1])); o.y = cvt_pk_bf16(gelu_tanh(v[2]), gelu_tanh(v[3]));
              *(u32x2*)(yg + (size_t)(tr + t) * D + pn * 16 + fq * 4) = o;
            }
        }
      EPI_ROWS_END
    }
    __builtin_amdgcn_s_barrier();
  }
}

__device__ __forceinline__ int perm32(int rho) { return 8 * ((rho & 15) >> 2) + 4 * (rho >> 4) + (rho & 3); }
__device__ __forceinline__ int srccol(int np, int mode, int Nh) {
  if (mode == 0) return np;
  const int t256 = np >> 8, r = np & 255, bj = r >> 7, r128 = r & 127, out = t256 * 128 + (r128 & ~31) + perm32(r128 & 31);
  return bj ? Nh + out : out;
}
__device__ __forceinline__ void transpose_tile(const float* W, int K, int N, bf16_t* Wt, int np0, int k0, int mode, int Nh, const float* gain) {
  float* tile = (float*)shm;
  const int tid = tid_o(), c4 = tid & 63, r0 = tid >> 6;
  const int sc = srccol(np0 + c4 * 4, mode, Nh);
  f32x4 v[8];
#pragma unroll
  for (int q = 0; q < 8; ++q) v[q] = *(const f32x4*)(W + (size_t)(k0 + r0 + q * 8) * N + sc);
#pragma unroll
  for (int q = 0; q < 8; ++q) { const int r = r0 + q * 8; const float g = gain ? gain[k0 + r] : 1.f; float* t = tile + r * 257 + c4 * 4; t[0] = v[q].x * g; t[1] = v[q].y * g; t[2] = v[q].z * g; t[3] = v[q].w * g; }
  __syncthreads();
#pragma unroll
  for (int q = 0; q < 4; ++q) {
    const int e = tid + q * 512, n = e & 255, ks = e >> 8;
    const float* s = tile + (ks * 8) * 257 + n;
    u32x4 o; o.x = cvt_pk_bf16(s[0], s[257]); o.y = cvt_pk_bf16(s[2 * 257], s[3 * 257]); o.z = cvt_pk_bf16(s[4 * 257], s[5 * 257]); o.w = cvt_pk_bf16(s[6 * 257], s[7 * 257]);
    *(u32x4*)(Wt + (size_t)(np0 + n) * K + k0 + ks * 8) = o;
  }
  __syncthreads();
}

__device__ __forceinline__ void weights_phase(const Params& p) {
  unsigned char* ws = p.ws;
  const int total = 2 * 128 + 4 * 352 + 4 * 176 + 64 + 32 + 64 + 2 * 64;
  unsigned* qctr = (unsigned*)(ws + W_BAR) + 3600;
  volatile LAS int* qslot = (volatile LAS int*)((LAS unsigned char*)shm + XB_LDS_OFF + 8);
  for (;;) {
    __syncthreads();
    if (tid_o() == 0) *qslot = (int)__hip_atomic_fetch_add(qctr, 1u, __ATOMIC_RELAXED, __HIP_MEMORY_SCOPE_AGENT);
    __syncthreads();
    const int t = *qslot;
    if (t >= total) break;
    int r = t; const float* W; int K, N, mode = 0, Nh = 0; const float* gain = nullptr; bf16_t* dst;
    if (r < 256) { const int l = r / 128; r -= l * 128; W = p.in[17] + (size_t)l * 1024 * 2048; K = 1024; N = 2048; mode = 1; Nh = 1024; dst = (bf16_t*)(ws + W_WGLU) + (size_t)l * 2048 * 1024; }
    else if ((r -= 256) < 1408) { const int l = r / 352; r -= l * 352; W = p.in[18] + (size_t)l * 1024 * 5632; K = 1024; N = 5632; mode = 1; Nh = FF; gain = p.in[8] + l * D; dst = (bf16_t*)(ws + W_WIN) + (size_t)l * 5632 * 1024; }
    else if ((r -= 1408) < 704) { const int l = r / 176; r -= l * 176; W = p.in[19] + (size_t)l * FF * 1024; K = FF; N = 1024; dst = (bf16_t*)(ws + W_WOUT) + (size_t)l * 1024 * FF; }
    else if ((r -= 704) < 64) { W = p.in[23]; K = 1024; N = 1024; gain = p.in[7] + 2 * D; dst = (bf16_t*)(ws + W_WQKV); }
    else if ((r -= 64) < 32) { W = p.in[21]; K = 1024; N = 512; gain = p.in[20]; dst = (bf16_t*)(ws + W_WQKV) + (size_t)1024 * 1024; }
    else if ((r -= 32) < 64) { W = p.in[23] + (size_t)1024 * 1024; K = 1024; N = 1024; gain = p.in[7] + 3 * D; dst = (bf16_t*)(ws + W_WQKV) + (size_t)1536 * 1024; }
    else { r -= 64; const int l = r / 64; r -= l * 64; W = p.in[26] + (size_t)l * 1024 * 1024; K = 1024; N = 1024; dst = (bf16_t*)(ws + W_WO) + (size_t)l * 1024 * 1024; }
    const int nkt = K / 64, kt = r % nkt, nb = r / nkt;
    transpose_tile(W, K, N, dst, nb * 256, kt * 64, mode, Nh, gain);
  }
}

__device__ __forceinline__ void s5_matrices(const Params& p, int l, int g) {
  float* L = (float*)shm;
  float* apr = L;
  float* api = apr + 64 * 17;
  float* bbr = api + 64 * 17;
  float* bbi = bbr + 1024;
  float* ccr = bbi + 1024;
  float* cci = ccr + 1024;
  float* fre = cci + 1024;
  float* fim = fre + 64;
  float* Kv = fim + 64;
  const int tid = tid_o();
  unsigned char* ws = p.ws;
  const size_t lg = (size_t)l * 64 + g;
  if (tid < 64) {
    const int pp = tid;
    const double dt = exp((double)p.in[11][lg]);
    const double are = p.in[9][lg * 64 + pp], aim = p.in[10][lg * 64 + pp];
    const double mg = exp(are * dt), an = aim * dt, br = mg * cos(an), bi = mg * sin(an);
    { double pr = 1.0, pi = 0.0;
      for (int j = 0; j <= 16; ++j) { apr[pp * 17 + j] = (float)pr; api[pp * 17 + j] = (float)pi; const double t = pr * br - pi * bi; pi = pr * bi + pi * br; pr = t; } }
    const double nr = br - 1.0, ni = bi, inv = 1.0 / (are * are + aim * aim);
    fre[pp] = (float)((nr * are + ni * aim) * inv); fim[pp] = (float)((ni * are - nr * aim) * inv);
    float* a16 = (float*)(ws + W_A16) + (lg * 64 + pp) * 2;
    a16[0] = apr[pp * 17 + 16]; a16[1] = api[pp * 17 + 16];
  }
  __syncthreads();
  for (int e = tid; e < 1024; e += 512) {
    const int pp = e >> 4;
    const float br = p.in[12][lg * 1024 + e], bi = p.in[13][lg * 1024 + e];
    bbr[e] = fre[pp] * br - fim[pp] * bi; bbi[e] = fre[pp] * bi + fim[pp] * br;
    ccr[e] = p.in[14][lg * 1024 + e]; cci[e] = p.in[15][lg * 1024 + e];
  }
  __syncthreads();
  for (int e = tid; e < 4096; e += 512) {
    const int j = e >> 8, cp = (e >> 4) & 15, c = e & 15;
    float s = 0.f;
    for (int pp = 0; pp < 64; ++pp) {
      const float xr = ccr[cp * 64 + pp] * apr[pp * 17 + j] - cci[cp * 64 + pp] * api[pp * 17 + j];
      const float xi = ccr[cp * 64 + pp] * api[pp * 17 + j] + cci[cp * 64 + pp] * apr[pp * 17 + j];
      s += xr * bbr[pp * 16 + c] - xi * bbi[pp * 16 + c];
    }
    if (j == 0 && cp == c) s += p.in[16][lg * 16 + c];
    Kv[e] = s;
  }
  __syncthreads();
  bf16_t* bs3 = (bf16_t*)(ws + W_BS3) + ((size_t)l * 16384 + (size_t)g * 256) * 384;
  for (int e = tid; e < 256 * 48; e += 512) {
    const int n = e / 48, k8 = e % 48, t = n >> 4, cp = n & 15;
    float v[8];
    if (k8 < 32) {
      const int s = k8 >> 1, c0 = (k8 & 1) * 8;
#pragma unroll
      for (int i = 0; i < 8; ++i) v[i] = (s <= t) ? Kv[((t - s) * 16 + cp) * 16 + c0 + i] : 0.f;
    } else {
      const int kk = (k8 - 32) * 8;
#pragma unroll
      for (int i = 0; i < 8; ++i) {
        const int q = kk + i, pp = q & 63;
        const float cr = ccr[cp * 64 + pp], ci = cci[cp * 64 + pp], ar = apr[pp * 17 + t + 1], ai = api[pp * 17 + t + 1];
        v[i] = q < 64 ? (cr * ar - ci * ai) : -(cr * ai + ci * ar);
      }
    }
    u32x4 o; o.x = cvt_pk_bf16(v[0], v[1]); o.y = cvt_pk_bf16(v[2], v[3]); o.z = cvt_pk_bf16(v[4], v[5]); o.w = cvt_pk_bf16(v[6], v[7]);
    *(u32x4*)(bs3 + (size_t)n * 384 + k8 * 8) = o;
  }
  bf16_t* bs1 = (bf16_t*)(ws + W_BS1) + ((size_t)l * 8192 + (size_t)(g >> 1) * 256 + (g & 1) * 128) * 512;
  for (int e = tid; e < 128 * 64; e += 512) {
    const int jn = e >> 6, k8 = e & 63, k = k8 * 8, pp = jn & 63;
    float v[8];
    if ((k >> 8) == (g & 1)) {
      const int s = (k & 255) >> 4, c0 = k & 15;
      const float ar = apr[pp * 17 + 15 - s], ai = api[pp * 17 + 15 - s];
#pragma unroll
      for (int i = 0; i < 8; ++i) {
        const float br = bbr[pp * 16 + c0 + i], bi = bbi[pp * 16 + c0 + i];
        v[i] = jn < 64 ? (ar * br - ai * bi) : (ar * bi + ai * br);
      }
    } else {
#pragma unroll
      for (int i = 0; i < 8; ++i) v[i] = 0.f;
    }
    u32x4 o; o.x = cvt_pk_bf16(v[0], v[1]); o.y = cvt_pk_bf16(v[2], v[3]); o.z = cvt_pk_bf16(v[4], v[5]); o.w = cvt_pk_bf16(v[6], v[7]);
    *(u32x4*)(bs1 + (size_t)jn * 512 + k) = o;
  }
  __syncthreads();
}

__device__ __forceinline__ size_t kf_off(int krow, int kvh, int kk, int hh) { return ((((size_t)(krow >> 5) * 4 + kvh) * 4 + kk) * 64 + hh * 32 + (krow & 31)) * 8; }
__device__ __forceinline__ size_t vf_off(int krow, int kvh, int d) {
  const int kin = krow & 15, hh = (kin >> 2) & 1, j = (kin >> 3) * 4 + (kin & 3);
  return ((((size_t)(krow >> 4) * 4 + kvh) * 2 + (d >> 5)) * 64 + hh * 32 + (d & 31)) * 8 + j;
}
__device__ __forceinline__ void cache_phase(const Params& p) {
  unsigned char* ws = p.ws;
  bf16_t* kb = (bf16_t*)(ws + W_KB); bf16_t* vt = (bf16_t*)(ws + W_VT);
  const int gt = bid_o() * 512 + tid_o(), nth = gdim_o() * 512;
  for (int e = gt; e < 32 * 128 * 32; e += nth) {
    const int i = e / (128 * 32), w = (e / 32) % 128, c8 = e % 32, kvh = c8 >> 3, d0 = (c8 & 7) * 8;
    const int krow = KS_BASE + i * 160 + w;
    const float* s = p.in[4] + ((size_t)i * 128 + w) * 256 + c8 * 8;
    const f32x4 a = *(const f32x4*)s, b = *(const f32x4*)(s + 4);
    u32x4 o; o.x = cvt_pk_bf16(a.x, a.y); o.y = cvt_pk_bf16(a.z, a.w); o.z = cvt_pk_bf16(b.x, b.y); o.w = cvt_pk_bf16(b.z, b.w);
    *(u32x4*)(kb + kf_off(krow, kvh, d0 >> 4, (d0 >> 3) & 1)) = o;
  }
  for (int e = gt; e < 32 * 128 * 256; e += nth) {
    const int i = e / (128 * 256), w = (e / 256) % 128, c = e % 256;
    vt[vf_off(KS_BASE + i * 160 + w, c >> 6, c & 63)] = f2bf(p.in[5][e]);
  }
}

template <int MODE>
__device__ __forceinline__ void norm_phase(const Params& p, const float* gain, int nks) {
  unsigned char* ws = p.ws;
  const int lane = tid_o() & 63, wv = tid_o() >> 6;
  bf16_t* ub = (bf16_t*)(ws + W_UB); float* rs = (float*)(ws + W_RS);
  if (MODE == 2) {
    const bf16_t* xb = (const bf16_t*)(ws + W_XB);
    for (int row = (bid_o() * 8 + wv) * 4; row < SPLIT_ROW0; row += gdim_o() * 32) {
      u32x2 raw[4][4];
#pragma unroll
      for (int q = 0; q < 4; ++q)
#pragma unroll
        for (int j = 0; j < 4; ++j) raw[q][j] = *(const u32x2*)(xb + (size_t)(row + q) * D + (lane + 64 * j) * 4);
#pragma unroll
      for (int q = 0; q < 4; ++q) {
        float s = 0.f;
#pragma unroll
        for (int j = 0; j < 4; ++j) { const f32x4 v = unpack4(raw[q][j]); s += (v.x * v.x + v.y * v.y) + (v.z * v.z + v.w * v.w); }
        const float r = rsqrtf(wave_sum(s, lane) * (1.f / D) + 1e-6f);
        if (lane == 0) rs[row + q] = r;
      }
    }
  }
  for (int row = ((MODE == 3 || MODE == 2) ? SPLIT_ROW0 : 0) + bid_o() * 8 + wv; row < R_PAD; row += gdim_o() * 8) {
    float* xr = xrow_ptr(p, row);
    f32x4 v[4];
    if (MODE == 0) {
      const float* src = xsrc_ptr(p, row);
#pragma unroll
      for (int j = 0; j < 4; ++j) v[j] = src ? *(const f32x4*)(src + (lane + 64 * j) * 4) : (f32x4){0.f, 0.f, 0.f, 0.f};
    } else {
      bf16_t* xbr = (bf16_t*)(ws + W_XB) + (size_t)row * D;
#pragma unroll
      for (int j = 0; j < 4; ++j) v[j] = unpack4(*(const u32x2*)(xbr + (lane + 64 * j) * 4));
      if (nks > 0 && row >= SPLIT_ROW0) {
        const float* pp = (const float*)(ws + W_PART) + (size_t)(row - SPLIT_ROW0) * D + lane * 4;
        for (int k = 0; k < nks; k += 4) {
          f32x4 t[4][4];
#pragma unroll
          for (int kk = 0; kk < 4; ++kk)
#pragma unroll
            for (int j = 0; j < 4; ++j) t[kk][j] = (k + kk < nks) ? *(const f32x4*)(pp + (size_t)(k + kk) * SPLIT_ROWS * D + 256 * j) : (f32x4){0.f, 0.f, 0.f, 0.f};
#pragma unroll
          for (int kk = 0; kk < 4; ++kk)
#pragma unroll
            for (int j = 0; j < 4; ++j) v[j] += t[kk][j];
        }
        if (MODE == 3) {
#pragma unroll
          for (int j = 0; j < 4; ++j) *(f32x4*)(xr + (lane + 64 * j) * 4) = v[j];
        } else {
#pragma unroll
          for (int j = 0; j < 4; ++j) { u32x2 o; o.x = cvt_pk_bf16(v[j].x, v[j].y); o.y = cvt_pk_bf16(v[j].z, v[j].w); *(u32x2*)(xbr + (lane + 64 * j) * 4) = o; }
        }
      }
    }
    if (MODE == 3) continue;
    float s = 0.f;
#pragma unroll
    for (int j = 0; j < 4; ++j) s += (v[j].x * v[j].x + v[j].y * v[j].y) + (v[j].z * v[j].z + v[j].w * v[j].w);
    const float r = rsqrtf(wave_sum(s, lane) * (1.f / D) + 1e-6f);
    if (MODE == 2) {
      if (lane == 0) rs[row] = r;
    }
    else {
#pragma unroll
      for (int j = 0; j < 4; ++j) {
        const f32x4 gg = *(const f32x4*)(gain + (lane + 64 * j) * 4);
        u32x2 o; o.x = cvt_pk_bf16(v[j].x * r * gg.x, v[j].y * r * gg.y); o.y = cvt_pk_bf16(v[j].z * r * gg.z, v[j].w * r * gg.w);
        const int col0 = (lane + 64 * j) * 4;
        if (row < R_REAL) {
          int cgi, s_;
          if (row < R_SAMPLE) { const int b_ = row >> 14, t = row & 16383; cgi = b_ * 1025 + 1 + (t >> 4); s_ = t & 15; }
          else if (row < R_META) { const int q = row - R_SAMPLE; cgi = 2050 + (q >> 4); s_ = q & 15; }
          else { cgi = 0; s_ = row - R_META; }
          const size_t off = (size_t)cgi * 16384 + (col0 >> 4) * 256 + s_ * 16 + (col0 & 15);
          *(u32x2*)(ub + off) = o;
          if (row >= R_META) *(u32x2*)(ub + off + (size_t)1025 * 16384) = o;
        }
      }
    }
  }
}

__device__ __forceinline__ void s2_phase(const Params& p, int l) {
  unsigned char* ws = p.ws;
  const float* sb = (const float*)(ws + W_SB); bf16_t* hin = (bf16_t*)(ws + W_HIN);
  const int lane = tid_o() & 63, wv = tid_o() >> 6;
  float* ex = (float*)shm;
  constexpr int SEG = 129;
  for (int item = bid_o(); item < 128; item += gdim_o()) {
    const int b = item >> 6, g = item & 63;
    const float* a16 = (const float*)(ws + W_A16) + (((size_t)l * 64 + g) * 64 + lane) * 2;
    const float ar = a16[0], ai = a16[1];
    const int c0 = wv * SEG, c1 = (c0 + SEG) < 1025 ? (c0 + SEG) : 1025;
    const float* sp = sb + (size_t)(b * 1025) * 8192 + g * 128 + lane;
    bf16_t* hp = hin + (size_t)(b * 1025) * 8192 + g * 128 + lane;
    float hr = 0.f, hi = 0.f;
    {
      int c = c0;
      float sr[8], si[8], pr[8], pi[8];
      if (c + 8 <= c1) {
#pragma unroll
        for (int u = 0; u < 8; ++u) { sr[u] = sp[(size_t)(c + u) * 8192]; si[u] = sp[(size_t)(c + u) * 8192 + 64]; }
      }
      for (; c + 8 <= c1; c += 8) {
        const bool more = c + 16 <= c1;
        if (more) {
#pragma unroll
          for (int u = 0; u < 8; ++u) { pr[u] = sp[(size_t)(c + 8 + u) * 8192]; pi[u] = sp[(size_t)(c + 8 + u) * 8192 + 64]; }
        }
#pragma unroll
        for (int u = 0; u < 8; ++u) { const float nr = ar * hr - ai * hi + sr[u], ni = ar * hi + ai * hr + si[u]; hr = nr; hi = ni; }
#pragma unroll
        for (int u = 0; u < 8; ++u) { sr[u] = pr[u]; si[u] = pi[u]; }
      }
      for (; c < c1; ++c) { const float sr = sp[(size_t)c * 8192], si = sp[(size_t)c * 8192 + 64]; const float nr = ar * hr - ai * hi + sr, ni = ar * hi + ai * hr + si; hr = nr; hi = ni; }
    }
    ex[(wv * 2) * 64 + lane] = hr; ex[(wv * 2 + 1) * 64 + lane] = hi;
    float qr = ar, qi = ai;
#pragma unroll
    for (int s = 0; s < 7; ++s) { const float t = qr * qr - qi * qi; qi = 2.f * qr * qi; qr = t; }
    { const float t = qr * ar - qi * ai; qi = qr * ai + qi * ar; qr = t; }
    __syncthreads();
    hr = 0.f; hi = 0.f;
    for (int j = 0; j < wv; ++j) { const float er = ex[(j * 2) * 64 + lane], ei = ex[(j * 2 + 1) * 64 + lane]; const float nr = qr * hr - qi * hi + er, ni = qr * hi + qi * hr + ei; hr = nr; hi = ni; }
    {
      int c = c0;
      float sr[8], si[8], pr[8], pi[8];
      if (c + 8 <= c1) {
#pragma unroll
        for (int u = 0; u < 8; ++u) { sr[u] = sp[(size_t)(c + u) * 8192]; si[u] = sp[(size_t)(c + u) * 8192 + 64]; }
      }
      for (; c + 8 <= c1; c += 8) {
        const bool more = c + 16 <= c1;
        if (more) {
#pragma unroll
          for (int u = 0; u < 8; ++u) { pr[u] = sp[(size_t)(c + 8 + u) * 8192]; pi[u] = sp[(size_t)(c + 8 + u) * 8192 + 64]; }
        }
#pragma unroll
        for (int u = 0; u < 8; ++u) {
          hp[(size_t)(c + u) * 8192] = f2bf(hr); hp[(size_t)(c + u) * 8192 + 64] = f2bf(hi);
          const float nr = ar * hr - ai * hi + sr[u], ni = ar * hi + ai * hr + si[u]; hr = nr; hi = ni;
        }
#pragma unroll
        for (int u = 0; u < 8; ++u) { sr[u] = pr[u]; si[u] = pi[u]; }
      }
      for (; c < c1; ++c) {
        const float sr = sp[(size_t)c * 8192], si = sp[(size_t)c * 8192 + 64];
        hp[(size_t)c * 8192] = f2bf(hr); hp[(size_t)c * 8192 + 64] = f2bf(hi);
        const float nr = ar * hr - ai * hi + sr, ni = ar * hi + ai * hr + si; hr = nr; hi = ni;
      }
    }
    if (wv == 7) {
      p.out[O_PRE + (((size_t)l * NB + b) * 64 + g) * 64 + lane] = hr; p.out[O_PIM + (((size_t)l * NB + b) * 64 + g) * 64 + lane] = hi;
    }
    __syncthreads();
  }
  for (int q = bid_o() * 8 + wv; q < 2048; q += gdim_o() * 8) {
    const int i = q >> 6, g = q & 63, c0 = 2050 + 2 * i;
    const size_t so = (((size_t)l * DB + i) * 64 + g) * 64 + lane;
    float hr = p.in[2][so], hi = p.in[3][so];
    const float* a16 = (const float*)(ws + W_A16) + (((size_t)l * 64 + g) * 64 + lane) * 2;
    const float ar = a16[0], ai = a16[1];
    const float* sp = sb + (size_t)c0 * 8192 + g * 128 + lane;
    bf16_t* hp = hin + (size_t)c0 * 8192 + g * 128 + lane;
#pragma unroll
    for (int c = 0; c < 2; ++c) {
      const float sr = sp[(size_t)c * 8192], si = sp[(size_t)c * 8192 + 64];
      hp[(size_t)c * 8192] = f2bf(hr); hp[(size_t)c * 8192 + 64] = f2bf(hi);
      const float nr = ar * hr - ai * hi + sr, ni = ar * hi + ai * hr + si; hr = nr; hi = ni;
    }
    p.out[O_SRE + so] = hr; p.out[O_SIM + so] = hi;
  }
}

__device__ __forceinline__ void kvfin_phase(const Params& p) {
  unsigned char* ws = p.ws;
  const float* kv = (const float*)(ws + W_KVRAW); bf16_t* kb = (bf16_t*)(ws + W_KB); bf16_t* vt = (bf16_t*)(ws + W_VT);
  const int lane = tid_o() & 63, wv = tid_o() >> 6;
  for (int row = bid_o() * 8 + wv; row < R_REAL; row += gdim_o() * 8) {
    const float* src = kv + (size_t)row * 512 + lane * 8;
    const f32x4 a = *(const f32x4*)src, b = *(const f32x4*)(src + 4);
    float v[8] = {a.x, a.y, a.z, a.w, b.x, b.y, b.z, b.w};
    const int col = (lane & 31) * 8, kvh = col >> 6, d0 = col & 63;
    int krow; float* ok = nullptr; float* ov = nullptr;
    if (row < R_SAMPLE) { const int b_ = row >> 14, t = row & 16383; krow = row;
      if (t >= SEQ - 128) { ok = p.out + O_PK + ((size_t)b_ * 128 + (t - (SEQ - 128))) * 256; ov = p.out + O_PV + ((size_t)b_ * 128 + (t - (SEQ - 128))) * 256; } }
    else if (row < R_META) { const int q = row - R_SAMPLE, i = q >> 5, j = q & 31; krow = KS_BASE + i * 160 + 128 + j;
      ok = p.out + O_SK + (size_t)q * 256; ov = p.out + O_SV + (size_t)q * 256; }
    else { krow = KM_BASE + (row - R_META); }
    if (lane < 32) {
      float s = 0.f;
#pragma unroll
      for (int i = 0; i < 8; ++i) s += v[i] * v[i];
      s += shx(s, 1, lane); s += shx(s, 2, lane); s += shx(s, 4, lane);
      const float r = rsqrtf(s * (1.f / 64.f) + 1e-6f);
#pragma unroll
      for (int i = 0; i < 8; ++i) v[i] = v[i] * r * p.in[22][d0 + i];
      u32x4 o; o.x = cvt_pk_bf16(v[0], v[1]); o.y = cvt_pk_bf16(v[2], v[3]); o.z = cvt_pk_bf16(v[4], v[5]); o.w = cvt_pk_bf16(v[6], v[7]);
      *(u32x4*)(kb + kf_off(krow, kvh, d0 >> 4, (d0 >> 3) & 1)) = o;
      if (ok) { *(f32x4*)(ok + col) = (f32x4){v[0], v[1], v[2], v[3]}; *(f32x4*)(ok + col + 4) = (f32x4){v[4], v[5], v[6], v[7]}; }
    } else {
      float s = 0.f; s += shx(s, 1, lane); s += shx(s, 2, lane); s += shx(s, 4, lane);
#pragma unroll
      for (int i = 0; i < 8; ++i) vt[vf_off(krow, kvh, d0 + i)] = f2bf(v[i]);
      if (ov) { *(f32x4*)(ov + col) = (f32x4){v[0], v[1], v[2], v[3]}; *(f32x4*)(ov + col + 4) = (f32x4){v[4], v[5], v[6], v[7]}; }
    }
  }
}

__device__ __forceinline__ int rel_bucket(int rel) {
  const int n = rel < 0 ? -rel : rel;
  const float nf = (float)(n < 1 ? 1 : n);
  int large = 8 + (int)(logf(nf / 8.f) / 2.772588722239781f * 8.f);
  large = large < 15 ? large : 15;
  return (rel > 0 ? 16 : 0) + (n < 8 ? n : large);
}

struct AttnItem { int kvh, nt_band, ktile0, sj0, tpos, qrow0, qi0, head; bool active; };
__device__ __forceinline__ AttnItem attn_item(int item, int wv) {
  AttnItem a;
  if (item < 2048) {
    const int b = item >> 10, n = (item >> 2) & 255; a.kvh = item & 3; a.head = a.kvh * 4 + (wv >> 1); const int qt = wv & 1;
    a.qi0 = qt * 32; a.qrow0 = b * SEQ + n * 64 + a.qi0; a.tpos = n * 64 + a.qi0;
    const int c0 = n >= 2 ? n - 2 : 0;
    a.nt_band = (n - c0 + 1) * 2;
    a.ktile0 = (b * SEQ + c0 * 64) >> 5;
    a.sj0 = n >= 2 ? 0 : (2 - n) * 64; a.active = true;
  } else {
    const int q = item - 2048, i = q >> 2; a.kvh = q & 3; a.head = a.kvh * 4 + (wv & 3); a.active = wv < 4;
    a.qi0 = 0; a.qrow0 = R_SAMPLE + i * 32; a.tpos = 1024; a.nt_band = 5;
    a.ktile0 = (KS_BASE + i * 160) >> 5; a.sj0 = 0;
  }
  return a;
}
constexpr int AT_BUF0 = 16896, AT_KV = 28672, AT_BUF = 2 * AT_KV;
__device__ __forceinline__ void attn_stage(const bf16_t* kb, const bf16_t* vt, int item, int buf, int wv, int lane) {
  const AttnItem a = attn_item(item, 0);
  LAS unsigned char* lds = (LAS unsigned char*)shm + AT_BUF0 + buf * AT_BUF;
#pragma unroll
  for (int t = 0; t < 7; ++t) {
    if (t <= a.nt_band) {
      const int T = t == 0 ? (KM_BASE >> 5) : a.ktile0 + (t - 1);
      const bf16_t* src; unsigned dst;
      if (wv < 4) { src = kb + ((((size_t)T * 4 + a.kvh) * 4 + wv) * 64 + lane) * 8; dst = t * 4096 + wv * 1024; }
      else { const int s = (wv - 4) >> 1, dt = (wv - 4) & 1; src = vt + (((((size_t)T * 2 + s) * 4 + a.kvh) * 2 + dt) * 64 + lane) * 8; dst = AT_KV + t * 4096 + (wv - 4) * 1024; }
      __builtin_amdgcn_global_load_lds((const unsigned*)src, (LAS unsigned*)(lds + dst), 16, 0, 0);
    }
  }
}

__device__ __forceinline__ void attn_phase(const Params& p, int jl) {
  unsigned char* ws = p.ws;
  float* lut = (float*)shm;
  float* qg = lut + 16 * 256;
  for (int e = tid_o(); e < 16 * 256; e += 512) {
    const int h = e >> 8, idx = e & 255; const int rel = idx - 191;
    lut[e] = idx < 255 ? p.in[27][rel_bucket(rel) * 16 + h] * 1.44269504089f : 0.f;
  }
  if (tid_o() < 64) qg[tid_o()] = p.in[24][jl * 64 + tid_o()] * (0.125f * 1.44269504089f);
  const bf16_t* qb = (const bf16_t*)(ws + W_UB); const bf16_t* kb = (const bf16_t*)(ws + W_KB); const bf16_t* vt = (const bf16_t*)(ws + W_VT);
  bf16_t* ao = (bf16_t*)(ws + W_YG);
  const int tid = tid_o(), lane = tid & 63, wv = __builtin_amdgcn_readfirstlane(tid >> 6), ql = lane & 31, hh = lane >> 5;
  const int G = gdim_o(), item0 = bid_o(), NITEM = 2048 + 128;
  u32x4 qraw[4];
  if (item0 < NITEM) {
    attn_stage(kb, vt, item0, 0, wv, lane);
    const AttnItem a = attn_item(item0, wv);
    const bf16_t* qp = qb + (size_t)(a.qrow0 + ql) * D + a.head * 64 + hh * 8;
#pragma unroll
    for (int kk = 0; kk < 4; ++kk) qraw[kk] = *(const u32x4*)(qp + kk * 16);
  }
  int cur = 0;
#pragma unroll 1
  for (int item = item0; item < NITEM; item += G, cur ^= 1) {
    asm volatile("s_waitcnt vmcnt(0)" ::: "memory");
    __syncthreads();
    const AttnItem a = attn_item(item, wv);
    u32x4 qcur[4];
#pragma unroll
    for (int kk = 0; kk < 4; ++kk) qcur[kk] = qraw[kk];
    if (item + G < NITEM) {
      attn_stage(kb, vt, item + G, cur ^ 1, wv, lane);
      const AttnItem an = attn_item(item + G, wv);
      const bf16_t* qp = qb + (size_t)(an.qrow0 + ql) * D + an.head * 64 + hh * 8;
#pragma unroll
      for (int kk = 0; kk < 4; ++kk) qraw[kk] = *(const u32x4*)(qp + kk * 16);
    }
    if (!a.active) continue;
    const int head = a.head, nt_band = a.nt_band, sj0 = a.sj0, qi0 = a.qi0, tpos = a.tpos, qrow0 = a.qrow0;
    const LAS unsigned char* kl = (const LAS unsigned char*)shm + AT_BUF0 + cur * AT_BUF + lane * 16;
    bf16x8 qf[4];
    {
      float qv[32]; float s = 0.f;
#pragma unroll
      for (int kk = 0; kk < 4; ++kk) {
        const unsigned w[4] = {qcur[kk].x, qcur[kk].y, qcur[kk].z, qcur[kk].w};
#pragma unroll
        for (int i = 0; i < 4; ++i) { qv[kk * 8 + 2 * i] = bf2f(w[i] & 0xffffu); qv[kk * 8 + 2 * i + 1] = bf2f(w[i] >> 16); }
      }
#pragma unroll
      for (int i = 0; i < 32; ++i) s += qv[i] * qv[i];
      s += shx(s, 32, lane);
      const float r = rsqrtf(s * (1.f / 64.f) + 1e-6f);
#pragma unroll
      for (int kk = 0; kk < 4; ++kk) {
        u32x4 o; const float* g8 = qg + kk * 16 + hh * 8;
        o.x = cvt_pk_bf16(qv[kk * 8 + 0] * r * g8[0], qv[kk * 8 + 1] * r * g8[1]); o.y = cvt_pk_bf16(qv[kk * 8 + 2] * r * g8[2], qv[kk * 8 + 3] * r * g8[3]);
        o.z = cvt_pk_bf16(qv[kk * 8 + 4] * r * g8[4], qv[kk * 8 + 5] * r * g8[5]); o.w = cvt_pk_bf16(qv[kk * 8 + 6] * r * g8[6], qv[kk * 8 + 7] * r * g8[7]);
        qf[kk] = __builtin_bit_cast(bf16x8, o);
      }
    }
    f32x16 sc[7];
#pragma unroll
    for (int t = 0; t < 7; ++t) {
      if (t <= nt_band) {
        f32x16 a_ = {0.f, 0.f, 0.f, 0.f, 0.f, 0.f, 0.f, 0.f, 0.f, 0.f, 0.f, 0.f, 0.f, 0.f, 0.f, 0.f};
#pragma unroll
        for (int kk = 0; kk < 4; ++kk) {
          const bf16x8 kf = *(const LAS bf16x8*)(kl + t * 4096 + kk * 1024);
          a_ = __builtin_amdgcn_mfma_f32_32x32x16_bf16(kf, qf[kk], a_, 0, 0, 0);
        }
        sc[t] = a_;
      }
    }
    const float sink = p.in[25][jl * 16 + head] * 1.44269504089f;
    const float* lh = lut + head * 256 + 191;
    float mx = sink;
    const int qi = qi0 + ql;
#pragma unroll
    for (int t = 0; t < 7; ++t) {
      if (t <= nt_band) {
#pragma unroll
        for (int r = 0; r < 16; ++r) {
          const int key = 8 * (r >> 2) + 4 * hh + (r & 3);
          float v;
          if (t == 0) {
            if (r < 8) { int rel = key - 16 - (tpos + ql); rel = rel < -191 ? -191 : rel; v = sc[t][r] + lh[rel]; } else v = -1e30f;
          } else {
            const int rel = sj0 + (t - 1) * 32 + key - 128 - qi;
            v = sc[t][r] + lh[rel];
          }
          sc[t][r] = v; mx = fmaxf(mx, v);
        }
      }
    }
    mx = fmaxf(mx, shx(mx, 32, lane));
    float sum = 0.f;
#pragma unroll
    for (int t = 0; t < 7; ++t) {
      if (t <= nt_band) {
#pragma unroll
        for (int r = 0; r < 16; ++r) { const float e = __builtin_amdgcn_exp2f(sc[t][r] - mx); sc[t][r] = e; sum += e; }
      }
    }
    sum += shx(sum, 32, lane);
    const float inv = 1.f / (sum + __builtin_amdgcn_exp2f(sink - mx));
    f32x16 o0 = {0.f, 0.f, 0.f, 0.f, 0.f, 0.f, 0.f, 0.f, 0.f, 0.f, 0.f, 0.f, 0.f, 0.f, 0.f, 0.f}, o1 = o0;
#pragma unroll
    for (int t = 0; t < 7; ++t) {
      if (t <= nt_band) {
#pragma unroll
        for (int s = 0; s < 2; ++s) {
          if (t == 0 && s == 1) continue;
          u32x4 pa; pa.x = cvt_pk_bf16(sc[t][8 * s + 0] * inv, sc[t][8 * s + 1] * inv); pa.y = cvt_pk_bf16(sc[t][8 * s + 2] * inv, sc[t][8 * s + 3] * inv);
          pa.z = cvt_pk_bf16(sc[t][8 * s + 4] * inv, sc[t][8 * s + 5] * inv); pa.w = cvt_pk_bf16(sc[t][8 * s + 6] * inv, sc[t][8 * s + 7] * inv);
          const bf16x8 pf = __builtin_bit_cast(bf16x8, pa);
          const bf16x8 b0 = *(const LAS bf16x8*)(kl + AT_KV + t * 4096 + s * 2048), b1 = *(const LAS bf16x8*)(kl + AT_KV + t * 4096 + s * 2048 + 1024);
          o0 = __builtin_amdgcn_mfma_f32_32x32x16_bf16(pf, b0, o0, 0, 0, 0);
          o1 = __builtin_amdgcn_mfma_f32_32x32x16_bf16(pf, b1, o1, 0, 0, 0);
        }
      }
    }
#pragma unroll
    for (int r = 0; r < 16; ++r) {
      const int q = 8 * (r >> 2) + 4 * hh + (r & 3);
      bf16_t* op = ao + (size_t)(qrow0 + q) * D + head * 64 + ql;
      op[0] = f2bf(o0[r]); op[32] = f2bf(o1[r]);
    }
  }
  asm volatile("s_waitcnt vmcnt(0)" ::: "memory");
  __syncthreads();
}

__global__ void __launch_bounds__(512) fwd_megakernel(Params p) {
  cg::grid_group grid = cg::this_grid();
  unsigned char* ws = p.ws;
  volatile LAS unsigned* xst = (volatile LAS unsigned*)((LAS unsigned char*)shm + XB_LDS_OFF);
  if (threadIdx.x < 4) xst[threadIdx.x] = 0u;
  __syncthreads();
  (void)xcd_barrier_post((unsigned*)(ws + W_BAR), xst);
  for (int it = bid_o(); it < 128; it += gdim_o()) s5_matrices(p, it >> 6, it & 63);
  weights_phase(p);
  cache_phase(p);
  norm_phase<0>(p, p.in[7], 0);
  if (p.ws == nullptr) grid.sync();
  xcd_barrier(p.ws);
#pragma unroll 1
  for (int l = 0; l < 4; ++l) {
    if (l < 2) {
      if (l == 1) { norm_phase<1>(p, p.in[7] + D, 11); xcd_barrier(p.ws); }
      gemm_phase<G_S1>(p, nullptr, 0, (const bf16_t*)(ws + W_BS1) + (size_t)l * 8192 * 512, 8192, 512);
      xcd_barrier(p.ws);
      if (PROBE == 9) { gemm_phase<G_S1>(p, nullptr, 0, (const bf16_t*)(ws + W_BS1) + (size_t)l * 8192 * 512, 8192, 512); xcd_barrier(p.ws); }
      s2_phase(p, l);
      xcd_barrier(p.ws);
      if (PROBE == 3) { s2_phase(p, l); xcd_barrier(p.ws); s2_phase(p, l); xcd_barrier(p.ws); }
      gemm_phase<G_S3>(p, nullptr, 0, (const bf16_t*)(ws + W_BS3) + (size_t)l * 16384 * 384, 16384, 384);
      xcd_barrier(p.ws);
      if (PROBE == 10) { gemm_phase<G_S3>(p, nullptr, 0, (const bf16_t*)(ws + W_BS3) + (size_t)l * 16384 * 384, 16384, 384); xcd_barrier(p.ws); }
      gemm_phase<G_GLU>(p, (const bf16_t*)(ws + W_YG), D, (const bf16_t*)(ws + W_WGLU) + (size_t)l * 2048 * 1024, 2048, 1024, l == 0);
      xcd_barrier(p.ws);
    } else {
      norm_phase<2>(p, nullptr, 11);
      xcd_barrier(p.ws);
      if (l == 2) gemm_phase<G_QKV>(p, (const bf16_t*)(ws + W_XB), D, (const bf16_t*)(ws + W_WQKV), 1536, 1024);
      else gemm_phase<G_QKV>(p, (const bf16_t*)(ws + W_XB), D, (const bf16_t*)(ws + W_WQKV) + (size_t)1536 * 1024, 1024, 1024);
      xcd_barrier(p.ws);
      if (l == 2) { kvfin_phase(p); xcd_barrier(p.ws); }
      attn_phase(p, l - 2);
      xcd_barrier(p.ws);
      if (PROBE == 4) { attn_phase(p, l - 2); xcd_barrier(p.ws); attn_phase(p, l - 2); xcd_barrier(p.ws); }
      gemm_phase<G_RESID>(p, (const bf16_t*)(ws + W_YG), D, (const bf16_t*)(ws + W_WO) + (size_t)(l - 2) * 1024 * 1024, 1024, 1024);
      xcd_barrier(p.ws);
    }
    norm_phase<2>(p, nullptr, l < 2 ? 0 : 4);
    xcd_barrier(p.ws);
    gemm_phase<G_FFIN>(p, (const bf16_t*)(ws + W_XB), D, (const bf16_t*)(ws + W_WIN) + (size_t)l * 5632 * 1024, 5632, 1024);
    xcd_barrier(p.ws);
    if (PROBE == 1) { gemm_phase<G_FFIN>(p, (const bf16_t*)(ws + W_XB), D, (const bf16_t*)(ws + W_WIN) + (size_t)l * 5632 * 1024, 5632, 1024); xcd_barrier(p.ws); }
    if (PROBE == 2) { for (int q = 0; q < 10; ++q) xcd_barrier(p.ws); }
    gemm_phase<G_RESID>(p, (const bf16_t*)(ws + W_HB), FF, (const bf16_t*)(ws + W_WOUT) + (size_t)l * 1024 * FF, 1024, FF, l == 3 ? 2 : 0);
    xcd_barrier(p.ws);
  }
  norm_phase<3>(p, nullptr, 11);
}

extern "C" void kernel_launch(void* const* d_in, const int* in_sizes, int n_in, void* d_out, int out_size, void* d_ws, size_t ws_size, hipStream_t stream) {
  static int grid_blocks = 0;
  if (grid_blocks == 0) {
    if (n_in != 28 || (size_t)out_size != O_END || ws_size < W_END) { fprintf(stderr, "kernel_launch: unexpected shapes (n_in %d out %d ws %zu need %zu)\n", n_in, out_size, ws_size, (size_t)W_END); grid_blocks = -1; return; }
    int dev = 0, cus = 0, per_cu = 0;
    hipGetDevice(&dev);
    hipDeviceGetAttribute(&cus, hipDeviceAttributeMultiprocessorCount, dev);
    if (hipFuncSetAttribute((const void*)fwd_megakernel, hipFuncAttributeMaxDynamicSharedMemorySize, LDS_BYTES) != hipSuccess) { fprintf(stderr, "kernel_launch: hipFuncSetAttribute failed\n"); }
    hipOccupancyMaxActiveBlocksPerMultiprocessor(&per_cu, (const void*)fwd_megakernel, 512, LDS_BYTES);
    if (per_cu < 1) { fprintf(stderr, "kernel_launch: occupancy query says %d blocks/CU\n", per_cu); per_cu = 1; }
    (void)hipGetLastError();
    grid_blocks = cus;
  }
  if (grid_blocks < 0) return;
  if (hipMemsetAsync((char*)d_ws + W_BAR, 0, 4096 * 4, stream) != hipSuccess) { fprintf(stderr, "kernel_launch: memset failed\n"); return; }
  Params p{};
  for (int i = 0; i < 28; ++i) p.in[i] = (const float*)d_in[i];
  p.out = (float*)d_out; p.ws = (unsigned char*)d_ws;
  void* args[] = {&p};
  hipError_t e = hipLaunchCooperativeKernel((const void*)fwd_megakernel, dim3(grid_blocks), dim3(512), args, LDS_BYTES, stream);
  if (e != hipSuccess) fprintf(stderr, "cooperative launch failed: %s (grid %d)\n", hipGetErrorString(e), grid_blocks);
}
```

```cpp
#include <hip/hip_runtime.h>
#include <hip/hip_cooperative_groups.h>
#include <cstdio>
#include <cstdint>
namespace cg = cooperative_groups;

typedef unsigned short bf16_t;
typedef short bf16x8 __attribute__((ext_vector_type(8)));
typedef float f32x4 __attribute__((ext_vector_type(4)));
typedef float f32x16 __attribute__((ext_vector_type(16)));
typedef unsigned u32x4 __attribute__((ext_vector_type(4)));
typedef unsigned u32x2 __attribute__((ext_vector_type(2)));

constexpr int D = 1024, SEQ = 16384, NB = 2, DB = 32, DS = 32, FF = 2816;
constexpr int R_PROMPT = 0, R_SAMPLE = 32768, R_META = 33792, R_REAL = 33808, R_PAD = 34048;
constexpr int NTM = R_PAD / 256;
constexpr int NCH = 2 * 1025 + 64, NCH_PAD = 2304;
constexpr int KROWS = 32768 + 32 * 160 + 16;
constexpr int KS_BASE = 32768, KM_BASE = 32768 + 5120;
constexpr size_t VT_S = (size_t)2 * 4 * 64 * 16384, VT_M = VT_S + (size_t)32 * 4 * 64 * 160;

constexpr size_t O_YP = 0, O_YS = 33554432, O_PRE = O_YS + 1048576, O_PIM = O_PRE + 16384, O_PK = O_PIM + 16384, O_PV = O_PK + 65536,
                 O_SRE = O_PV + 65536, O_SIM = O_SRE + 262144, O_SK = O_SIM + 262144, O_SV = O_SK + 262144, O_END = O_SV + 262144;

constexpr size_t al(size_t x) { return (x + 255) & ~(size_t)255; }
constexpr size_t W_XMETA = 0;
constexpr size_t W_XB = al(W_XMETA + (size_t)256 * D * 4);
constexpr size_t W_RS = al(W_XB + (size_t)R_PAD * D * 2);
constexpr size_t W_UB = al(W_RS + (size_t)R_PAD * 4);
constexpr size_t W_YG = al(W_UB + (size_t)R_PAD * D * 2);
constexpr size_t W_SB = al(W_YG + (size_t)R_PAD * D * 2);
constexpr size_t W_HIN = al(W_SB + (size_t)NCH_PAD * 8192 * 4);
constexpr size_t W_KB = al(W_HIN + (size_t)NCH_PAD * 8192 * 2);
constexpr size_t W_VT = al(W_KB + (size_t)(KROWS + 16) * 256 * 2);
constexpr size_t W_WGLU = al(W_VT + (size_t)(KROWS + 16) * 256 * 2);
constexpr size_t W_WIN = al(W_WGLU + (size_t)2 * 2048 * 1024 * 2);
constexpr size_t W_WOUT = al(W_WIN + (size_t)4 * 5632 * 1024 * 2);
constexpr size_t W_WQKV = al(W_WOUT + (size_t)4 * 1024 * FF * 2);
constexpr size_t W_WO = al(W_WQKV + (size_t)2560 * 1024 * 2);
constexpr size_t W_BS1 = al(W_WO + (size_t)2 * 1024 * 1024 * 2);
constexpr size_t W_BS3 = al(W_BS1 + (size_t)2 * 8192 * 512 * 2);
constexpr size_t W_A16 = al(W_BS3 + (size_t)2 * 16384 * 384 * 2);
constexpr size_t W_BAR = al(W_A16 + (size_t)2 * 64 * 64 * 8);
constexpr size_t W_END = al(W_BAR + (size_t)4096 * 4);
constexpr size_t W_HB = W_UB;
constexpr size_t W_KVRAW = W_SB;
constexpr size_t W_PART = W_UB + (size_t)R_PAD * FF * 2;
constexpr int SPLIT_ROW0 = 32768, SPLIT_ROWS = R_PAD - 32768, SPLIT_PM0 = 128;
static_assert(W_PART + (size_t)11 * SPLIT_ROWS * D * 4 <= W_KB, "partials overlay");
static_assert((size_t)R_PAD * FF * 2 <= W_HIN - W_UB, "hb overlay");
static_assert((size_t)R_PAD * 512 * 4 <= W_HIN - W_SB, "kvraw overlay");
static_assert(W_END <= (size_t)512 * 1024 * 1024, "workspace");

constexpr int LDS_BYTES = 147456;
constexpr int XB_LDS_OFF = LDS_BYTES - 16;
constexpr int PROBE = 0;

struct Params {
  const float* in[28];
  float* out;
  unsigned char* ws;
};

extern __shared__ __attribute__((aligned(16))) unsigned char shm[];

__device__ __forceinline__ unsigned cvt_pk_bf16(float lo, float hi) { unsigned r; asm volatile("v_cvt_pk_bf16_f32 %0, %1, %2" : "=v"(r) : "v"(lo), "v"(hi)); return r; }
__device__ __forceinline__ bf16_t f2bf(float f) { return (bf16_t)(cvt_pk_bf16(f, 0.f) & 0xffffu); }
__device__ __forceinline__ float bf2f(unsigned b) { return __uint_as_float(b << 16); }
__device__ __forceinline__ f32x4 unpack4(u32x2 r) { return (f32x4){__uint_as_float(r.x << 16), __uint_as_float(r.x & 0xffff0000u), __uint_as_float(r.y << 16), __uint_as_float(r.y & 0xffff0000u)}; }
__device__ __forceinline__ float shx(float v, int o, int lane) { return __int_as_float(__builtin_amdgcn_ds_bpermute((lane ^ o) << 2, __float_as_int(v))); }
__device__ __forceinline__ float wave_sum(float v, int lane) {
#pragma unroll
  for (int o = 1; o < 64; o <<= 1) v += shx(v, o, lane);
  return v;
}
__device__ __forceinline__ int tid_o() { int t = threadIdx.x; asm volatile("" : "+v"(t)); return t; }
__device__ __forceinline__ int bid_o() { int b = blockIdx.x; asm volatile("" : "+s"(b)); return b; }
__device__ __forceinline__ int gdim_o() { int b = gridDim.x; asm volatile("" : "+s"(b)); return b; }
__device__ __forceinline__ float sigmoidf_(float x) { return __builtin_amdgcn_rcpf(1.f + __expf(-x)); }
__device__ __forceinline__ float gelu_tanh(float x) {
  const float x2 = x * x;
  const float w = x * (-2.302208198f - 0.102943242f * x2);
  return x * __builtin_amdgcn_rcpf(1.f + __builtin_amdgcn_exp2f(w));
}
__device__ __forceinline__ float* xrow_ptr(const Params& p, int row) {
  return row < R_META ? p.out + (size_t)row * D : (float*)(p.ws + W_XMETA) + (size_t)(row - R_META) * D;
}
__device__ __forceinline__ const float* xsrc_ptr(const Params& p, int row) {
  return row < R_SAMPLE ? p.in[0] + (size_t)row * D : row < R_META ? p.in[1] + (size_t)(row - R_SAMPLE) * D : row < R_REAL ? p.in[6] + (size_t)(row - R_META) * D : nullptr;
}
__device__ __forceinline__ int chunk_row(int cgi) {
  if (cgi >= NCH) cgi = 0;
  if (cgi < 2050) { const int b = cgi >= 1025 ? 1 : 0; const int c = cgi - b * 1025; return c == 0 ? R_META : b * SEQ + (c - 1) * 16; }
  return R_SAMPLE + (cgi - 2050) * 16;
}

#define LAS __attribute__((address_space(3)))
constexpr int BM = 256, BK = 64, HALF = 128, HTB = HALF * BK * 2;
__device__ __forceinline__ int lds_byte(int r, int c) {
  int st = (r >> 4) * 2 + (c >> 5), rr = r & 15, cc = c & 31, ob = rr * 64 + cc * 2;
  return st * 1024 + (ob ^ (((ob >> 9) & 1) << 5));
}
__device__ __forceinline__ void stage_rc(int b, int& R, int& C) {
  int st = b / 1024, sb = b % 1024, swz = sb ^ (((sb >> 9) & 1) << 5);
  R = (st >> 1) * 16 + swz / 64; C = (st & 1) * 32 + (swz % 64) / 2;
}

typedef f32x4 acc_t[2][2][4][2];

struct ARow {
  const char* base; unsigned hstep; unsigned voff[2];
  __device__ __forceinline__ void init(const bf16_t* A, int lda, int brow) {
    base = (const char*)(A + (size_t)brow * lda); hstep = (unsigned)HALF * lda * 2u;
#pragma unroll
    for (int i = 0; i < 2; ++i) { int R, C; stage_rc(tid_o() * 16 + i * 8192, R, C); voff[i] = (unsigned)(R * lda + C) * 2u; }
  }
  __device__ __forceinline__ const char* ptr(int h, int i, int kt) const { return base + (size_t)h * hstep + (size_t)kt * 128 + voff[i]; }
};
struct AS1 {
  const char* ub; unsigned voff[2][2]; int pn;
  __device__ __forceinline__ void init(const bf16_t* u, int brow, int pn_) {
    ub = (const char*)u; pn = pn_;
#pragma unroll
    for (int h = 0; h < 2; ++h)
#pragma unroll
      for (int i = 0; i < 2; ++i) { int R, C; stage_rc(tid_o() * 16 + i * 8192, R, C);
        voff[h][i] = (unsigned)(chunk_row(brow + h * 128 + R) + (C >> 4)) * 2048u + (unsigned)(C & 15) * 2u; }
  }
  __device__ __forceinline__ const char* ptr(int h, int i, int kt) const { return ub + (size_t)((pn * 2 + (kt >> 2)) * 32 + (kt & 3) * 8192) + voff[h][i]; }
};
struct AS3 {
  const char* ub; const char* hin; unsigned voffu[2][2], voffh[2][2]; int g;
  __device__ __forceinline__ void init(const bf16_t* u, const bf16_t* hn, int brow, int g_) {
    ub = (const char*)u; hin = (const char*)hn; g = g_;
#pragma unroll
    for (int h = 0; h < 2; ++h)
#pragma unroll
      for (int i = 0; i < 2; ++i) { int R, C; stage_rc(tid_o() * 16 + i * 8192, R, C);
        int cgi = brow + h * 128 + R; if (cgi >= NCH) cgi = 0;
        voffu[h][i] = (unsigned)cgi * 32768u + (unsigned)C * 2u;
        voffh[h][i] = (unsigned)cgi * 16384u + (unsigned)C * 2u; }
  }
  __device__ __forceinline__ const char* ptr(int h, int i, int kt) const {
    return kt < 4 ? ub + (size_t)(g * 512 + kt * 128) + voffu[h][i] : hin + (size_t)(g * 256 + (kt - 4) * 128) + voffh[h][i];
  }
};

template <class AF>
__device__ __forceinline__ void gemm_mainloop(acc_t& acc, const AF& A, const bf16_t* Bt, int K, int bcol, int nt) {
  LAS unsigned char* lds = (LAS unsigned char*)shm;
  const int tid = tid_o(), wid = __builtin_amdgcn_readfirstlane(tid >> 6), lane = tid & 63, wr = wid >> 2, wc = wid & 3, fr = lane & 15, fq = lane >> 4;
  unsigned voffB[2];
#pragma unroll
  for (int i = 0; i < 2; ++i) { int R, C; stage_rc(tid * 16 + i * 8192, R, C); voffB[i] = (unsigned)(R * K + C) * 2u; }
  const char* cB = (const char*)(Bt + (size_t)bcol * K);
  const size_t hstepB = (size_t)HALF * K * 2;
  const unsigned ldsw = (unsigned)wid * 1024u;
  const int aoff = lds_byte(wr * 64 + fr, fq * 8), boff = lds_byte(wc * 32 + fr, fq * 8);
#define SA(b, h) (((b) * 2 + (h)) * HTB)
#define SB(b, h) ((4 + (b) * 2 + (h)) * HTB)
#define STAGE_A(bufoff, h, kt) do { _Pragma("unroll") for (int _i = 0; _i < 2; ++_i) \
    __builtin_amdgcn_global_load_lds((const unsigned*)A.ptr(h, _i, kt), (LAS unsigned*)(lds + (bufoff) + ldsw + _i * 8192), 16, 0, 0); } while (0)
#define STAGE_B(bufoff, h, kt) do { _Pragma("unroll") for (int _i = 0; _i < 2; ++_i) \
    __builtin_amdgcn_global_load_lds((const unsigned*)(cB + (size_t)(h) * hstepB + (size_t)(kt) * 128 + voffB[_i]), (LAS unsigned*)(lds + (bufoff) + ldsw + _i * 8192), 16, 0, 0); } while (0)
#define LDA(dst, b, h) do { _Pragma("unroll") for (int m = 0; m < 4; ++m) _Pragma("unroll") for (int k = 0; k < 2; ++k) dst[m][k] = *(const LAS bf16x8*)(lds + SA(b, h) + aoff + m * 2048 + k * 1024); } while (0)
#define LDB(dst, b, h) do { _Pragma("unroll") for (int n = 0; n < 2; ++n) _Pragma("unroll") for (int k = 0; k < 2; ++k) dst[n][k] = *(const LAS bf16x8*)(lds + SB(b, h) + boff + n * 2048 + k * 1024); } while (0)
#define MMA(ai, bj, At_, Bt_) do { __builtin_amdgcn_s_setprio(1); _Pragma("unroll") for (int m = 0; m < 4; ++m) _Pragma("unroll") for (int n = 0; n < 2; ++n) _Pragma("unroll") for (int k = 0; k < 2; ++k) \
      acc[ai][bj][m][n] = __builtin_amdgcn_mfma_f32_16x16x32_bf16(Bt_[n][k], At_[m][k], acc[ai][bj][m][n], 0, 0, 0); \
    __builtin_amdgcn_s_setprio(0); } while (0)
#define WAIT_V(n) asm volatile("s_waitcnt vmcnt(" #n ")" ::: "memory")
#define WAIT_L(n) asm volatile("s_waitcnt lgkmcnt(" #n ")" ::: "memory")
#define BAR __builtin_amdgcn_s_barrier()
#define SCHED __builtin_amdgcn_sched_barrier(0)
#pragma unroll
  for (int a = 0; a < 2; ++a)
#pragma unroll
    for (int b = 0; b < 2; ++b)
#pragma unroll
      for (int m = 0; m < 4; ++m)
#pragma unroll
        for (int n = 0; n < 2; ++n) acc[a][b][m][n] = (f32x4){0.f, 0.f, 0.f, 0.f};
  bf16x8 At[4][2], B0[2][2], B1[2][2];
  STAGE_B(SB(0, 0), 0, 0); STAGE_B(SB(0, 1), 1, 0); STAGE_A(SA(0, 0), 0, 0); STAGE_A(SA(0, 1), 1, 0);
  if (wr == 1) BAR;
  WAIT_V(2); BAR;
  STAGE_B(SB(1, 0), 0, 1); STAGE_A(SA(1, 0), 0, 1); STAGE_B(SB(1, 1), 1, 1);
  WAIT_V(6); BAR;
#pragma unroll 1
  for (int t = 0; t < nt - 2; t += 2) {
    const int k2 = t + 2, k3 = t + 3;
    LDB(B0, 0, 0); LDB(B1, 0, 1); SCHED; LDA(At, 0, 0); STAGE_A(SA(1, 1), 1, t + 1);
    WAIT_V(8); WAIT_L(0); BAR; MMA(0, 0, At, B0); MMA(0, 1, At, B1); BAR; SCHED;
    LDA(At, 0, 1); STAGE_B(SB(0, 0), 0, k2); STAGE_B(SB(0, 1), 1, k2); STAGE_A(SA(0, 0), 0, k2);
    WAIT_V(8); WAIT_L(0); BAR; MMA(1, 0, At, B0); MMA(1, 1, At, B1); BAR; SCHED;
    LDB(B0, 1, 0); LDB(B1, 1, 1); SCHED; LDA(At, 1, 0); STAGE_A(SA(0, 1), 1, k2);
    WAIT_V(8); WAIT_L(0); BAR; MMA(0, 0, At, B0); MMA(0, 1, At, B1); BAR; SCHED;
    LDA(At, 1, 1); STAGE_B(SB(1, 0), 0, k3); STAGE_B(SB(1, 1), 1, k3); STAGE_A(SA(1, 0), 0, k3);
    WAIT_V(8); WAIT_L(0); BAR; MMA(1, 0, At, B0); MMA(1, 1, At, B1); BAR; SCHED;
  }
  {
    LDB(B0, 0, 0); LDB(B1, 0, 1); SCHED; LDA(At, 0, 0); STAGE_A(SA(1, 1), 1, nt - 1);
    WAIT_V(8); WAIT_L(0); BAR; MMA(0, 0, At, B0); MMA(0, 1, At, B1); BAR; SCHED;
    LDA(At, 0, 1);
    WAIT_V(2); WAIT_L(0); BAR; MMA(1, 0, At, B0); MMA(1, 1, At, B1); BAR; SCHED;
    LDB(B0, 1, 0); LDB(B1, 1, 1); SCHED; LDA(At, 1, 0);
    WAIT_V(0); WAIT_L(0); BAR; MMA(0, 0, At, B0); MMA(0, 1, At, B1); BAR; SCHED;
    LDA(At, 1, 1);
    WAIT_L(0); BAR; MMA(1, 0, At, B0); MMA(1, 1, At, B1); BAR;
  }
  WAIT_V(0);
  if (wr == 0) BAR;
  BAR;
#undef SA
#undef SB
}


#define XB_TMO      128
#define XB_XCNT(j)  (256  + 64 * (j))
#define XB_XSUB(j)  (1280 + 64 * (j))
#define XB_XGEN(j)  (2304 + 64 * (j))
#define XB_TOP      3328
#define XB_TOPGEN   3392
#define XCD_BAR_WORDS 3456
#define XB_SPIN_CAP (1u << 18)
__device__ __forceinline__ unsigned xb_ld(unsigned* p)              { return __hip_atomic_load(p, __ATOMIC_RELAXED, __HIP_MEMORY_SCOPE_AGENT); }
__device__ __forceinline__ unsigned xb_add(unsigned* p, unsigned v) { return __hip_atomic_fetch_add(p, v, __ATOMIC_RELAXED, __HIP_MEMORY_SCOPE_AGENT); }
__device__ __forceinline__ unsigned xb_xcc_id() { return (unsigned)__builtin_amdgcn_s_getreg((3 << 11) | 20) & 0xFu; }
#define XB_SPIN(cond, bar) do { unsigned _sp = 0; while (cond) { __builtin_amdgcn_s_sleep(1); \
    if ((++_sp & 255u) == 0u) { if (xb_ld(&(bar)[XB_TMO])) break; if (_sp > XB_SPIN_CAP) { atomicAdd(&(bar)[XB_TMO], 1u); break; } } } } while (0)
struct XcdBarrier { unsigned* bar; unsigned x; volatile LAS unsigned* st; };
__device__ __forceinline__ XcdBarrier xcd_barrier_post(unsigned* bar, volatile LAS unsigned* st) {
  XcdBarrier b; b.bar = bar; b.x = xb_xcc_id(); b.st = st;
  if (threadIdx.x == 0) (void)xb_add(&bar[XB_XCNT(b.x)], 1u);
  return b;
}
__device__ __forceinline__ void xcd_barrier_complete(unsigned* bar, unsigned x, unsigned& nloc, unsigned& nx) {
  const unsigned G = gridDim.x * gridDim.y * gridDim.z;
  unsigned sum, cnt, mine, sp = 0u;
  for (;;) {
    sum = 0u; cnt = 0u; mine = 0u;
#pragma unroll
    for (unsigned j = 0; j < 16; ++j) { const unsigned c = xb_ld(&bar[XB_XCNT(j)]); sum += c; cnt += (c > 0u) ? 1u : 0u; mine = (j == x) ? c : mine; }
    if (sum == G) break;
    __builtin_amdgcn_s_sleep(1);
    if ((++sp & 255u) == 0u) { if (xb_ld(&bar[XB_TMO])) break; if (sp > XB_SPIN_CAP) { atomicAdd(&bar[XB_TMO], 1u); break; } }
  }
  nloc = mine > 0u ? mine : 1u; nx = cnt > 0u ? cnt : 1u;
}
__device__ __forceinline__ void xcd_barrier(unsigned char* ws_) {
  XcdBarrier b; b.bar = (unsigned*)(ws_ + W_BAR); b.x = xb_xcc_id(); b.st = (volatile LAS unsigned*)((LAS unsigned char*)shm + XB_LDS_OFF);
  asm volatile("s_waitcnt vmcnt(0)" ::: "memory");
  __syncthreads();
  if (threadIdx.x == 0) {
    unsigned* bar = b.bar;
    __builtin_amdgcn_s_waitcnt(0);
    unsigned nloc = b.st[0], nx = b.st[1];
    if (nloc == 0u) { xcd_barrier_complete(bar, b.x, nloc, nx); b.st[0] = nloc; b.st[1] = nx; }
    const unsigned old = xb_add(&bar[XB_XSUB(b.x)], 1u);
    const unsigned gen = old / nloc;
    if (old + 1u == (gen + 1u) * nloc) {
      __builtin_amdgcn_fence(__ATOMIC_RELEASE, "agent");
      asm volatile("s_waitcnt vmcnt(0)" ::: "memory");
      const unsigned og = xb_add(&bar[XB_TOP], 1u);
      const unsigned tg = og / nx;
      if (og + 1u == (tg + 1u) * nx) xb_add(&bar[XB_TOPGEN], 1u);
      else XB_SPIN(xb_ld(&bar[XB_TOPGEN]) == tg, bar);
      __builtin_amdgcn_fence(__ATOMIC_ACQUIRE, "agent");
      xb_add(&bar[XB_XGEN(b.x)], 1u);
      asm volatile("s_waitcnt vmcnt(0)" ::: "memory");
    } else {
      XB_SPIN(xb_ld(&bar[XB_XGEN(b.x)]) == gen, bar);
      __builtin_amdgcn_fence(__ATOMIC_ACQUIRE, "agent");
      asm volatile("s_waitcnt vmcnt(0)" ::: "memory");
    }
  }
  __syncthreads();
}

__device__ __forceinline__ bool tile_at(long L, int nM, int nN, int& pm, int& pn) {
  const int nwg = nM * nN;
  if (L >= nwg) return false;
  int wgid = (int)L;
  { const int q = nwg / 8, r = nwg % 8, xcd = wgid % 8, off = wgid / 8; wgid = (xcd < r ? xcd * (q + 1) : r * (q + 1) + (xcd - r) * q) + off; }
  const int nig = 8 * nN, gid = wgid / nig, fm = gid * 8, gsz = (nM - fm) < 8 ? (nM - fm) : 8;
  pm = fm + ((wgid % nig) % gsz); pn = (wgid % nig) / gsz;
  return true;
}
__device__ __forceinline__ bool tile_next(int it, int nM, int nN, int& pm, int& pn) { return tile_at((long)it * gdim_o() + bid_o(), nM, nN, pm, pn); }

#define EPI_ROWS_BEGIN \
  const int wid = tid_o() >> 6, lane = tid_o() & 63, wr = wid >> 2, wc = wid & 3, fr = lane & 15, fq = lane >> 4; \
  _Pragma("unroll") for (int ai = 0; ai < 2; ++ai) _Pragma("unroll") for (int m = 0; m < 4; ++m) { \
    const int row = brow + ai * 128 + wr * 64 + m * 16 + fr;
#define EPI_ROWS_END }

enum { G_GLU = 0, G_FFIN = 1, G_RESID = 2, G_QKV = 3, G_S1 = 4, G_S3 = 5 };

template <int MODE>
__device__ __forceinline__ void gemm_epilogue(const Params& p, acc_t& acc, int brow, int bcol, int pn, bool split, int ksi, int first, const float (&rsv)[8]) {
  unsigned char* ws = p.ws;
    if (MODE == G_GLU) {
      bf16_t* xb = (bf16_t*)(ws + W_XB);
      EPI_ROWS_BEGIN
        bf16_t* xr = xb + (size_t)row * D;
        const int oc = (bcol >> 1) + wc * 32 + fq * 8;
        f32x4 x0, x1;
        if (first & 1) { const float* xs = xsrc_ptr(p, row); x0 = xs ? *(const f32x4*)(xs + oc) : (f32x4){0.f, 0.f, 0.f, 0.f}; x1 = xs ? *(const f32x4*)(xs + oc + 4) : (f32x4){0.f, 0.f, 0.f, 0.f}; }
        else { const u32x4 raw = *(const u32x4*)(xr + oc); x0 = unpack4((u32x2){raw.x, raw.y}); x1 = unpack4((u32x2){raw.z, raw.w}); }
#pragma unroll
        for (int j = 0; j < 4; ++j) { x0[j] += acc[ai][0][m][0][j] * sigmoidf_(acc[ai][1][m][0][j]); x1[j] += acc[ai][0][m][1][j] * sigmoidf_(acc[ai][1][m][1][j]); }
        u32x4 o; o.x = cvt_pk_bf16(x0[0], x0[1]); o.y = cvt_pk_bf16(x0[2], x0[3]); o.z = cvt_pk_bf16(x1[0], x1[1]); o.w = cvt_pk_bf16(x1[2], x1[3]);
        *(u32x4*)(xr + oc) = o;
      EPI_ROWS_END
    } else if (MODE == G_FFIN) {
      bf16_t* hb = (bf16_t*)(ws + W_HB); const float* rs = (const float*)(ws + W_RS);
      EPI_ROWS_BEGIN
        const float s = rsv[ai * 4 + m];
        const int oc = (bcol >> 1) + wc * 32 + fq * 8;
        float hv[8];
#pragma unroll
        for (int n = 0; n < 2; ++n)
#pragma unroll
          for (int j = 0; j < 4; ++j) { const float gt = acc[ai][0][m][n][j] * s, up = acc[ai][1][m][n][j] * s; hv[n * 4 + j] = gt * sigmoidf_(gt) * up; }
        u32x4 o; o.x = cvt_pk_bf16(hv[0], hv[1]); o.y = cvt_pk_bf16(hv[2], hv[3]); o.z = cvt_pk_bf16(hv[4], hv[5]); o.w = cvt_pk_bf16(hv[6], hv[7]);
        *(u32x4*)(hb + (size_t)row * FF + oc) = o;
      EPI_ROWS_END
    } else if (MODE == G_RESID) {
      bf16_t* xb = (bf16_t*)(ws + W_XB);
      EPI_ROWS_BEGIN
        bf16_t* xr = xb + (size_t)row * D;
#pragma unroll
        for (int bj = 0; bj < 2; ++bj)
#pragma unroll
          for (int n = 0; n < 2; ++n) {
            const int oc = bcol + bj * 128 + wc * 32 + n * 16 + fq * 4;
            if (split) {
              *(f32x4*)((float*)(ws + W_PART) + ((size_t)ksi * SPLIT_ROWS + (row - SPLIT_ROW0)) * D + oc) = acc[ai][bj][m][n];
            } else {
              f32x4 x = unpack4(*(const u32x2*)(xr + oc));
              x += acc[ai][bj][m][n];
              if (first & 2) *(f32x4*)(xrow_ptr(p, row) + oc) = x;
              else { u32x2 o; o.x = cvt_pk_bf16(x[0], x[1]); o.y = cvt_pk_bf16(x[2], x[3]); *(u32x2*)(xr + oc) = o; }
            }
          }
      EPI_ROWS_END
    } else if (MODE == G_QKV) {
      bf16_t* qb = (bf16_t*)(ws + W_UB); float* kv = (float*)(ws + W_KVRAW); const float* rs = (const float*)(ws + W_RS);
      EPI_ROWS_BEGIN
        const float s = rsv[ai * 4 + m];
#pragma unroll
        for (int bj = 0; bj < 2; ++bj)
#pragma unroll
          for (int n = 0; n < 2; ++n) {
            const int oc = bcol + bj * 128 + wc * 32 + n * 16 + fq * 4;
            const f32x4 v = acc[ai][bj][m][n] * s;
            if (bcol < 1024) { u32x2 o; o.x = cvt_pk_bf16(v[0], v[1]); o.y = cvt_pk_bf16(v[2], v[3]); *(u32x2*)(qb + (size_t)row * D + oc) = o; }
            else *(f32x4*)(kv + (size_t)row * 512 + (oc - 1024)) = v;
          }
      EPI_ROWS_END
    } else if (MODE == G_S1) {
      float* sb = (float*)(ws + W_SB);
      EPI_ROWS_BEGIN
#pragma unroll
        for (int bj = 0; bj < 2; ++bj)
#pragma unroll
          for (int n = 0; n < 2; ++n) {
            const int oc = bcol + bj * 128 + wc * 32 + n * 16 + fq * 4;
            *(f32x4*)(sb + (size_t)row * 8192 + oc) = acc[ai][bj][m][n];
          }
      EPI_ROWS_END
    } else if (MODE == G_S3) {
      bf16_t* yg = (bf16_t*)(ws + W_YG);
      EPI_ROWS_BEGIN
        const bool valid = row < NCH && row != 1025;
        const int tr = chunk_row(row);
        if (valid) {
#pragma unroll
          for (int bj = 0; bj < 2; ++bj)
#pragma unroll
            for (int n = 0; n < 2; ++n) {
              const int t = bj * 8 + wc * 2 + n;
              const f32x4 v = acc[ai][bj][m][n];
              u32x2 o; o.x = cvt_pk_bf16(gelu_tanh(v[0]), gelu_tanh(v[1])); o.y = cvt_pk_bf16(gelu_tanh(v[2]), gelu_tanh(v[3]));
              *(u32x2*)(yg + (size_t)(tr + t) * D + pn * 16 + fq * 4) = o;
            }
        }
      EPI_ROWS_END
    }
}

template <int MODE>
__device__ __forceinline__ void gemm_phase(const Params& p, const bf16_t* A, int lda, const bf16_t* Bt, int N, int K, int first = 0) {
  const int nM = (MODE == G_S1 || MODE == G_S3) ? NCH_PAD / 256 : NTM, nN = N / 256, nt = K / BK;
  unsigned char* ws = p.ws;
  const int G = gdim_o(), ks = nt / 4, nsplit = (NTM - SPLIT_PM0) * nN * ks, nMw = (MODE == G_RESID) ? SPLIT_PM0 : nM;
  const int nfull_it = (nMw * nN + G - 1) / G;
#pragma unroll 1
  for (int it = 0;; ++it) {
    int pm, pn; bool split = false; int kt0 = 0, ntu = nt, ksi = 0;
    if (MODE == G_RESID && it >= nfull_it) {
      const int u = (it - nfull_it) * G + bid_o();
      if (u >= nsplit) break;
      ksi = u % ks; const int tq = u / ks; pn = tq % nN; pm = SPLIT_PM0 + tq / nN;
      split = true; kt0 = ksi * 4; ntu = 4;
    } else if (!tile_next(it, nMw, nN, pm, pn)) { if (MODE == G_RESID) continue; else break; }
    const int brow = pm * 256, bcol = pn * 256;
    float rsv[8];
    if (MODE == G_FFIN || MODE == G_QKV) {
      const int tid_ = tid_o(), wr_ = (tid_ >> 6) >> 2, fr_ = tid_ & 15;
      const float* rsp = (const float*)(ws + W_RS) + brow + wr_ * 64 + fr_;
#pragma unroll
      for (int q = 0; q < 8; ++q) rsv[q] = rsp[(q >> 2) * 128 + (q & 3) * 16];
    }
    acc_t acc;
    if (MODE == G_S1) { ARow af; af.init((const bf16_t*)(ws + W_UB) + pn * 512, 16384, brow); gemm_mainloop(acc, af, Bt, K, bcol, nt); }
    else if (MODE == G_S3) { AS3 af; af.init((const bf16_t*)(ws + W_UB), (const bf16_t*)(ws + W_HIN), brow, pn); gemm_mainloop(acc, af, Bt, K, bcol, nt); }
    else { ARow af; af.init(A + kt0 * BK, lda, brow); gemm_mainloop(acc, af, Bt + kt0 * BK, K, bcol, ntu); }
    gemm_epilogue<MODE>(p, acc, brow, bcol, pn, split, ksi, first, rsv);
    __builtin_amdgcn_s_barrier();
  }
}

template <int MODE>
__device__ __forceinline__ void gemm_phase_stream(const Params& p, const bf16_t* A, int lda, const bf16_t* Bt, int N, int K) {
  const int nM = NTM, nN = N / 256, nt = K / BK;
  unsigned char* ws = p.ws;
  LAS unsigned char* lds = (LAS unsigned char*)shm;
  const int tid = tid_o(), wid = __builtin_amdgcn_readfirstlane(tid >> 6), lane = tid & 63, wr = wid >> 2, wc = wid & 3, fr = lane & 15, fq = lane >> 4;
  unsigned voffA[2], voffB[2];
#pragma unroll
  for (int i = 0; i < 2; ++i) { int R, C; stage_rc(tid * 16 + i * 8192, R, C); voffA[i] = (unsigned)(R * lda + C) * 2u; voffB[i] = (unsigned)(R * K + C) * 2u; }
  const size_t kstep = (size_t)(BK * 2);
  const size_t hstepA = (size_t)HALF * lda * 2, hstepB = (size_t)HALF * K * 2;
  const unsigned ldsw = (unsigned)wid * 1024u;
  const int aoff = lds_byte(wr * 64 + fr, fq * 8), boff = lds_byte(wc * 32 + fr, fq * 8);
#define SA(b, h) (((b) * 2 + (h)) * HTB)
#define SB(b, h) ((4 + (b) * 2 + (h)) * HTB)
#define STG(bufoff, gbase, voff) do { _Pragma("unroll") for (int _i = 0; _i < 2; ++_i) \
    __builtin_amdgcn_global_load_lds((const unsigned*)((const char*)(gbase) + (voff)[_i]), (LAS unsigned*)(lds + (bufoff) + ldsw + _i * 8192), 16, 0, 0); } while (0)
  int cpm, cpn, npm, npn, ui = 0;
  if (!tile_next(0, nM, nN, cpm, cpn)) return;
  acc_t acc;
#pragma unroll
  for (int a = 0; a < 2; ++a)
#pragma unroll
    for (int b = 0; b < 2; ++b)
#pragma unroll
      for (int m = 0; m < 4; ++m)
#pragma unroll
        for (int n = 0; n < 2; ++n) acc[a][b][m][n] = (f32x4){0.f, 0.f, 0.f, 0.f};
  bf16x8 At[4][2], B0[2][2], B1[2][2];
  float rsv[8];
  const float* rsb = (const float*)(ws + W_RS) + wr * 64 + fr;
#pragma unroll
  for (int q = 0; q < 8; ++q) rsv[q] = rsb[cpm * 256 + (q >> 2) * 128 + (q & 3) * 16];
  const char* cA = (const char*)A + (size_t)cpm * 2 * hstepA; const char* cB = (const char*)Bt + (size_t)cpn * 2 * hstepB;
  STG(SB(0, 0), cB, voffB); STG(SB(0, 1), cB + hstepB, voffB); STG(SA(0, 0), cA, voffA); STG(SA(0, 1), cA + hstepA, voffA);
  if (wr == 1) BAR;
  WAIT_V(2); BAR;
  STG(SB(1, 0), cB + kstep, voffB); STG(SA(1, 0), cA + kstep, voffA); STG(SB(1, 1), cB + hstepB + kstep, voffB);
  WAIT_V(6); BAR;
#pragma unroll 1
  for (;;) {
    const bool has_next = tile_next(ui + 1, nM, nN, npm, npn);
    const char* nA = has_next ? (const char*)A + (size_t)npm * 2 * hstepA : cA; const char* nB = has_next ? (const char*)Bt + (size_t)npn * 2 * hstepB : cB;
#pragma unroll 1
    for (int t = 0; t < nt; t += 2) {
      const bool last = (t == nt - 2);
      const char* a1 = cA + (size_t)(t + 1) * kstep;
      const char* a2 = last ? nA : cA + (size_t)(t + 2) * kstep; const char* b2 = last ? nB : cB + (size_t)(t + 2) * kstep;
      const char* a3 = a2 + kstep; const char* b3 = b2 + kstep;
      LDB(B0, 0, 0); LDB(B1, 0, 1); SCHED; LDA(At, 0, 0); STG(SA(1, 1), a1 + hstepA, voffA);
      WAIT_V(8); WAIT_L(0); BAR; MMA(0, 0, At, B0); MMA(0, 1, At, B1); BAR; SCHED;
      LDA(At, 0, 1); STG(SB(0, 0), b2, voffB); STG(SB(0, 1), b2 + hstepB, voffB); STG(SA(0, 0), a2, voffA);
      WAIT_V(8); WAIT_L(0); BAR; MMA(1, 0, At, B0); MMA(1, 1, At, B1); BAR; SCHED;
      LDB(B0, 1, 0); LDB(B1, 1, 1); SCHED; LDA(At, 1, 0); STG(SA(0, 1), a2 + hstepA, voffA);
      WAIT_V(8); WAIT_L(0); BAR; MMA(0, 0, At, B0); MMA(0, 1, At, B1); BAR; SCHED;
      LDA(At, 1, 1); STG(SB(1, 0), b3, voffB); STG(SB(1, 1), b3 + hstepB, voffB); STG(SA(1, 0), a3, voffA);
      WAIT_V(8); WAIT_L(0); BAR; MMA(1, 0, At, B0); MMA(1, 1, At, B1); BAR; SCHED;
    }
    if (wr == 0) BAR;
    gemm_epilogue<MODE>(p, acc, cpm * 256, cpn * 256, cpn, false, 0, 0, rsv);
    if (!has_next) break;
#pragma unroll
    for (int a = 0; a < 2; ++a)
#pragma unroll
      for (int b = 0; b < 2; ++b)
#pragma unroll
        for (int m = 0; m < 4; ++m)
#pragma unroll
          for (int n = 0; n < 2; ++n) acc[a][b][m][n] = (f32x4){0.f, 0.f, 0.f, 0.f};
    cpm = npm; cpn = npn; cA = nA; cB = nB; ++ui;
#pragma unroll
    for (int q = 0; q < 8; ++q) rsv[q] = rsb[cpm * 256 + (q >> 2) * 128 + (q & 3) * 16];
    if (wr == 1) BAR;
  }
  WAIT_V(0);
  BAR;
#undef SA
#undef SB
#undef STG
}

__device__ __forceinline__ int perm32(int rho) { return 8 * ((rho & 15) >> 2) + 4 * (rho >> 4) + (rho & 3); }
__device__ __forceinline__ int srccol(int np, int mode, int Nh) {
  if (mode == 0) return np;
  const int t256 = np >> 8, r = np & 255, bj = r >> 7, r128 = r & 127, out = t256 * 128 + (r128 & ~31) + perm32(r128 & 31);
  return bj ? Nh + out : out;
}
__device__ __forceinline__ void transpose_tile(const float* W, int K, int N, bf16_t* Wt, int np0, int k0, int mode, int Nh, const float* gain) {
  float* tile = (float*)shm;
  const int tid = tid_o(), c4 = tid & 63, r0 = tid >> 6;
  const int sc = srccol(np0 + c4 * 4, mode, Nh);
  f32x4 v[8];
#pragma unroll
  for (int q = 0; q < 8; ++q) v[q] = *(const f32x4*)(W + (size_t)(k0 + r0 + q * 8) * N + sc);
#pragma unroll
  for (int q = 0; q < 8; ++q) { const int r = r0 + q * 8; const float g = gain ? gain[k0 + r] : 1.f; float* t = tile + r * 257 + c4 * 4; t[0] = v[q].x * g; t[1] = v[q].y * g; t[2] = v[q].z * g; t[3] = v[q].w * g; }
  __syncthreads();
#pragma unroll
  for (int q = 0; q < 4; ++q) {
    const int e = tid + q * 512, n = e & 255, ks = e >> 8;
    const float* s = tile + (ks * 8) * 257 + n;
    u32x4 o; o.x = cvt_pk_bf16(s[0], s[257]); o.y = cvt_pk_bf16(s[2 * 257], s[3 * 257]); o.z = cvt_pk_bf16(s[4 * 257], s[5 * 257]); o.w = cvt_pk_bf16(s[6 * 257], s[7 * 257]);
    *(u32x4*)(Wt + (size_t)(np0 + n) * K + k0 + ks * 8) = o;
  }
  __syncthreads();
}

__device__ __forceinline__ void weights_phase(const Params& p) {
  unsigned char* ws = p.ws;
  const int total = 2 * 128 + 4 * 352 + 4 * 176 + 64 + 32 + 64 + 2 * 64;
  unsigned* qctr = (unsigned*)(ws + W_BAR) + 3600;
  volatile LAS int* qslot = (volatile LAS int*)((LAS unsigned char*)shm + XB_LDS_OFF + 8);
  for (;;) {
    __syncthreads();
    if (tid_o() == 0) *qslot = (int)__hip_atomic_fetch_add(qctr, 1u, __ATOMIC_RELAXED, __HIP_MEMORY_SCOPE_AGENT);
    __syncthreads();
    const int t = *qslot;
    if (t >= total) break;
    int r = t; const float* W; int K, N, mode = 0, Nh = 0; const float* gain = nullptr; bf16_t* dst;
    if (r < 256) { const int l = r / 128; r -= l * 128; W = p.in[17] + (size_t)l * 1024 * 2048; K = 1024; N = 2048; mode = 1; Nh = 1024; dst = (bf16_t*)(ws + W_WGLU) + (size_t)l * 2048 * 1024; }
    else if ((r -= 256) < 1408) { const int l = r / 352; r -= l * 352; W = p.in[18] + (size_t)l * 1024 * 5632; K = 1024; N = 5632; mode = 1; Nh = FF; gain = p.in[8] + l * D; dst = (bf16_t*)(ws + W_WIN) + (size_t)l * 5632 * 1024; }
    else if ((r -= 1408) < 704) { const int l = r / 176; r -= l * 176; W = p.in[19] + (size_t)l * FF * 1024; K = FF; N = 1024; dst = (bf16_t*)(ws + W_WOUT) + (size_t)l * 1024 * FF; }
    else if ((r -= 704) < 64) { W = p.in[23]; K = 1024; N = 1024; gain = p.in[7] + 2 * D; dst = (bf16_t*)(ws + W_WQKV); }
    else if ((r -= 64) < 32) { W = p.in[21]; K = 1024; N = 512; gain = p.in[20]; dst = (bf16_t*)(ws + W_WQKV) + (size_t)1024 * 1024; }
    else if ((r -= 32) < 64) { W = p.in[23] + (size_t)1024 * 1024; K = 1024; N = 1024; gain = p.in[7] + 3 * D; dst = (bf16_t*)(ws + W_WQKV) + (size_t)1536 * 1024; }
    else { r -= 64; const int l = r / 64; r -= l * 64; W = p.in[26] + (size_t)l * 1024 * 1024; K = 1024; N = 1024; dst = (bf16_t*)(ws + W_WO) + (size_t)l * 1024 * 1024; }
    const int nkt = K / 64, kt = r % nkt, nb = r / nkt;
    transpose_tile(W, K, N, dst, nb * 256, kt * 64, mode, Nh, gain);
  }
}

__device__ __forceinline__ void s5_matrices(const Params& p, int l, int g) {
  float* L = (float*)shm;
  float* apr = L;
  float* api = apr + 64 * 17;
  float* bbr = api + 64 * 17;
  float* bbi = bbr + 1024;
  float* ccr = bbi + 1024;
  float* cci = ccr + 1024;
  float* fre = cci + 1024;
  float* fim = fre + 64;
  float* Kv = fim + 64;
  const int tid = tid_o();
  unsigned char* ws = p.ws;
  const size_t lg = (size_t)l * 64 + g;
  if (tid < 64) {
    const int pp = tid;
    const double dt = exp((double)p.in[11][lg]);
    const double are = p.in[9][lg * 64 + pp], aim = p.in[10][lg * 64 + pp];
    const double mg = exp(are * dt), an = aim * dt, br = mg * cos(an), bi = mg * sin(an);
    { double pr = 1.0, pi = 0.0;
      for (int j = 0; j <= 16; ++j) { apr[pp * 17 + j] = (float)pr; api[pp * 17 + j] = (float)pi; const double t = pr * br - pi * bi; pi = pr * bi + pi * br; pr = t; } }
    const double nr = br - 1.0, ni = bi, inv = 1.0 / (are * are + aim * aim);
    fre[pp] = (float)((nr * are + ni * aim) * inv); fim[pp] = (float)((ni * are - nr * aim) * inv);
    float* a16 = (float*)(ws + W_A16) + (lg * 64 + pp) * 2;
    a16[0] = apr[pp * 17 + 16]; a16[1] = api[pp * 17 + 16];
  }
  __syncthreads();
  for (int e = tid; e < 1024; e += 512) {
    const int pp = e >> 4;
    const float br = p.in[12][lg * 1024 + e], bi = p.in[13][lg * 1024 + e];
    bbr[e] = fre[pp] * br - fim[pp] * bi; bbi[e] = fre[pp] * bi + fim[pp] * br;
    ccr[e] = p.in[14][lg * 1024 + e]; cci[e] = p.in[15][lg * 1024 + e];
  }
  __syncthreads();
  for (int e = tid; e < 4096; e += 512) {
    const int j = e >> 8, cp = (e >> 4) & 15, c = e & 15;
    float s = 0.f;
    for (int pp = 0; pp < 64; ++pp) {
      const float xr = ccr[cp * 64 + pp] * apr[pp * 17 + j] - cci[cp * 64 + pp] * api[pp * 17 + j];
      const float xi = ccr[cp * 64 + pp] * api[pp * 17 + j] + cci[cp * 64 + pp] * apr[pp * 17 + j];
      s += xr * bbr[pp * 16 + c] - xi * bbi[pp * 16 + c];
    }
    if (j == 0 && cp == c) s += p.in[16][lg * 16 + c];
    Kv[e] = s;
  }
  __syncthreads();
  bf16_t* bs3 = (bf16_t*)(ws + W_BS3) + ((size_t)l * 16384 + (size_t)g * 256) * 384;
  for (int e = tid; e < 256 * 48; e += 512) {
    const int n = e / 48, k8 = e % 48, t = n >> 4, cp = n & 15;
    float v[8];
    if (k8 < 32) {
      const int s = k8 >> 1, c0 = (k8 & 1) * 8;
#pragma unroll
      for (int i = 0; i < 8; ++i) v[i] = (s <= t) ? Kv[((t - s) * 16 + cp) * 16 + c0 + i] : 0.f;
    } else {
      const int kk = (k8 - 32) * 8;
#pragma unroll
      for (int i = 0; i < 8; ++i) {
        const int q = kk + i, pp = q & 63;
        const float cr = ccr[cp * 64 + pp], ci = cci[cp * 64 + pp], ar = apr[pp * 17 + t + 1], ai = api[pp * 17 + t + 1];
        v[i] = q < 64 ? (cr * ar - ci * ai) : -(cr * ai + ci * ar);
      }
    }
    u32x4 o; o.x = cvt_pk_bf16(v[0], v[1]); o.y = cvt_pk_bf16(v[2], v[3]); o.z = cvt_pk_bf16(v[4], v[5]); o.w = cvt_pk_bf16(v[6], v[7]);
    *(u32x4*)(bs3 + (size_t)n * 384 + k8 * 8) = o;
  }
  bf16_t* bs1 = (bf16_t*)(ws + W_BS1) + ((size_t)l * 8192 + (size_t)(g >> 1) * 256 + (g & 1) * 128) * 512;
  for (int e = tid; e < 128 * 64; e += 512) {
    const int jn = e >> 6, k8 = e & 63, k = k8 * 8, pp = jn & 63;
    float v[8];
    if ((k >> 8) == (g & 1)) {
      const int s = (k & 255) >> 4, c0 = k & 15;
      const float ar = apr[pp * 17 + 15 - s], ai = api[pp * 17 + 15 - s];
#pragma unroll
      for (int i = 0; i < 8; ++i) {
        const float br = bbr[pp * 16 + c0 + i], bi = bbi[pp * 16 + c0 + i];
        v[i] = jn < 64 ? (ar * br - ai * bi) : (ar * bi + ai * br);
      }
    } else {
#pragma unroll
      for (int i = 0; i < 8; ++i) v[i] = 0.f;
    }
    u32x4 o; o.x = cvt_pk_bf16(v[0], v[1]); o.y = cvt_pk_bf16(v[2], v[3]); o.z = cvt_pk_bf16(v[4], v[5]); o.w = cvt_pk_bf16(v[6], v[7]);
    *(u32x4*)(bs1 + (size_t)jn * 512 + k) = o;
  }
  __syncthreads();
}

__device__ __forceinline__ size_t kf_off(int krow, int kvh, int kk, int hh) { return ((((size_t)(krow >> 5) * 4 + kvh) * 4 + kk) * 64 + hh * 32 + (krow & 31)) * 8; }
__device__ __forceinline__ size_t vf_off(int krow, int kvh, int d) {
  const int kin = krow & 15, hh = (kin >> 2) & 1, j = (kin >> 3) * 4 + (kin & 3);
  return ((((size_t)(krow >> 4) * 4 + kvh) * 2 + (d >> 5)) * 64 + hh * 32 + (d & 31)) * 8 + j;
}
__device__ __forceinline__ void cache_phase(const Params& p) {
  unsigned char* ws = p.ws;
  bf16_t* kb = (bf16_t*)(ws + W_KB); bf16_t* vt = (bf16_t*)(ws + W_VT);
  const int gt = bid_o() * 512 + tid_o(), nth = gdim_o() * 512;
  for (int e = gt; e < 32 * 128 * 32; e += nth) {
    const int i = e / (128 * 32), w = (e / 32) % 128, c8 = e % 32, kvh = c8 >> 3, d0 = (c8 & 7) * 8;
    const int krow = KS_BASE + i * 160 + w;
    const float* s = p.in[4] + ((size_t)i * 128 + w) * 256 + c8 * 8;
    const f32x4 a = *(const f32x4*)s, b = *(const f32x4*)(s + 4);
    u32x4 o; o.x = cvt_pk_bf16(a.x, a.y); o.y = cvt_pk_bf16(a.z, a.w); o.z = cvt_pk_bf16(b.x, b.y); o.w = cvt_pk_bf16(b.z, b.w);
    *(u32x4*)(kb + kf_off(krow, kvh, d0 >> 4, (d0 >> 3) & 1)) = o;
  }
  for (int e = gt; e < 32 * 128 * 256; e += nth) {
    const int i = e / (128 * 256), w = (e / 256) % 128, c = e % 256;
    vt[vf_off(KS_BASE + i * 160 + w, c >> 6, c & 63)] = f2bf(p.in[5][e]);
  }
}

template <int MODE>
__device__ __forceinline__ void norm_phase(const Params& p, const float* gain, int nks) {
  unsigned char* ws = p.ws;
  const int lane = tid_o() & 63, wv = tid_o() >> 6;
  bf16_t* ub = (bf16_t*)(ws + W_UB); float* rs = (float*)(ws + W_RS);
  if (MODE == 2) {
    const bf16_t* xb = (const bf16_t*)(ws + W_XB);
    for (int row = (bid_o() * 8 + wv) * 4; row < SPLIT_ROW0; row += gdim_o() * 32) {
      u32x2 raw[4][4];
#pragma unroll
      for (int q = 0; q < 4; ++q)
#pragma unroll
        for (int j = 0; j < 4; ++j) raw[q][j] = *(const u32x2*)(xb + (size_t)(row + q) * D + (lane + 64 * j) * 4);
#pragma unroll
      for (int q = 0; q < 4; ++q) {
        float s = 0.f;
#pragma unroll
        for (int j = 0; j < 4; ++j) { const f32x4 v = unpack4(raw[q][j]); s += (v.x * v.x + v.y * v.y) + (v.z * v.z + v.w * v.w); }
        const float r = rsqrtf(wave_sum(s, lane) * (1.f / D) + 1e-6f);
        if (lane == 0) rs[row + q] = r;
      }
    }
  }
  for (int row = ((MODE == 3 || MODE == 2) ? SPLIT_ROW0 : 0) + bid_o() * 8 + wv; row < R_PAD; row += gdim_o() * 8) {
    float* xr = xrow_ptr(p, row);
    f32x4 v[4];
    if (MODE == 0) {
      const float* src = xsrc_ptr(p, row);
#pragma unroll
      for (int j = 0; j < 4; ++j) v[j] = src ? *(const f32x4*)(src + (lane + 64 * j) * 4) : (f32x4){0.f, 0.f, 0.f, 0.f};
    } else {
      bf16_t* xbr = (bf16_t*)(ws + W_XB) + (size_t)row * D;
#pragma unroll
      for (int j = 0; j < 4; ++j) v[j] = unpack4(*(const u32x2*)(xbr + (lane + 64 * j) * 4));
      if (nks > 0 && row >= SPLIT_ROW0) {
        const float* pp = (const float*)(ws + W_PART) + (size_t)(row - SPLIT_ROW0) * D + lane * 4;
        for (int k = 0; k < nks; k += 4) {
          f32x4 t[4][4];
#pragma unroll
          for (int kk = 0; kk < 4; ++kk)
#pragma unroll
            for (int j = 0; j < 4; ++j) t[kk][j] = (k + kk < nks) ? *(const f32x4*)(pp + (size_t)(k + kk) * SPLIT_ROWS * D + 256 * j) : (f32x4){0.f, 0.f, 0.f, 0.f};
#pragma unroll
          for (int kk = 0; kk < 4; ++kk)
#pragma unroll
            for (int j = 0; j < 4; ++j) v[j] += t[kk][j];
        }
        if (MODE == 3) {
#pragma unroll
          for (int j = 0; j < 4; ++j) *(f32x4*)(xr + (lane + 64 * j) * 4) = v[j];
        } else {
#pragma unroll
          for (int j = 0; j < 4; ++j) { u32x2 o; o.x = cvt_pk_bf16(v[j].x, v[j].y); o.y = cvt_pk_bf16(v[j].z, v[j].w); *(u32x2*)(xbr + (lane + 64 * j) * 4) = o; }
        }
      }
    }
    if (MODE == 3) continue;
    float s = 0.f;
#pragma unroll
    for (int j = 0; j < 4; ++j) s += (v[j].x * v[j].x + v[j].y * v[j].y) + (v[j].z * v[j].z + v[j].w * v[j].w);
    const float r = rsqrtf(wave_sum(s, lane) * (1.f / D) + 1e-6f);
    if (MODE == 2) {
      if (lane == 0) rs[row] = r;
    }
    else {
#pragma unroll
      for (int j = 0; j < 4; ++j) {
        const f32x4 gg = *(const f32x4*)(gain + (lane + 64 * j) * 4);
        u32x2 o; o.x = cvt_pk_bf16(v[j].x * r * gg.x, v[j].y * r * gg.y); o.y = cvt_pk_bf16(v[j].z * r * gg.z, v[j].w * r * gg.w);
        const int col0 = (lane + 64 * j) * 4;
        if (row < R_REAL) {
          int cgi, s_;
          if (row < R_SAMPLE) { const int b_ = row >> 14, t = row & 16383; cgi = b_ * 1025 + 1 + (t >> 4); s_ = t & 15; }
          else if (row < R_META) { const int q = row - R_SAMPLE; cgi = 2050 + (q >> 4); s_ = q & 15; }
          else { cgi = 0; s_ = row - R_META; }
          const size_t off = (size_t)cgi * 16384 + (col0 >> 4) * 256 + s_ * 16 + (col0 & 15);
          *(u32x2*)(ub + off) = o;
          if (row >= R_META) *(u32x2*)(ub + off + (size_t)1025 * 16384) = o;
        }
      }
    }
  }
}

__device__ __forceinline__ void s2_phase(const Params& p, int l) {
  unsigned char* ws = p.ws;
  const float* sb = (const float*)(ws + W_SB); bf16_t* hin = (bf16_t*)(ws + W_HIN);
  const int lane = tid_o() & 63, wv = tid_o() >> 6;
  float* ex = (float*)shm;
  constexpr int SEG = 129;
  for (int item = bid_o(); item < 128; item += gdim_o()) {
    const int b = item >> 6, g = item & 63;
    const float* a16 = (const float*)(ws + W_A16) + (((size_t)l * 64 + g) * 64 + lane) * 2;
    const float ar = a16[0], ai = a16[1];
    const int c0 = wv * SEG, c1 = (c0 + SEG) < 1025 ? (c0 + SEG) : 1025;
    const float* sp = sb + (size_t)(b * 1025) * 8192 + g * 128 + lane;
    bf16_t* hp = hin + (size_t)(b * 1025) * 8192 + g * 128 + lane;
    float hr = 0.f, hi = 0.f;
    {
      int c = c0;
      float sr[8], si[8], pr[8], pi[8];
      if (c + 8 <= c1) {
#pragma unroll
        for (int u = 0; u < 8; ++u) { sr[u] = sp[(size_t)(c + u) * 8192]; si[u] = sp[(size_t)(c + u) * 8192 + 64]; }
      }
      for (; c + 8 <= c1; c += 8) {
        const bool more = c + 16 <= c1;
        if (more) {
#pragma unroll
          for (int u = 0; u < 8; ++u) { pr[u] = sp[(size_t)(c + 8 + u) * 8192]; pi[u] = sp[(size_t)(c + 8 + u) * 8192 + 64]; }
        }
#pragma unroll
        for (int u = 0; u < 8; ++u) { const float nr = ar * hr - ai * hi + sr[u], ni = ar * hi + ai * hr + si[u]; hr = nr; hi = ni; }
#pragma unroll
        for (int u = 0; u < 8; ++u) { sr[u] = pr[u]; si[u] = pi[u]; }
      }
      for (; c < c1; ++c) { const float sr = sp[(size_t)c * 8192], si = sp[(size_t)c * 8192 + 64]; const float nr = ar * hr - ai * hi + sr, ni = ar * hi + ai * hr + si; hr = nr; hi = ni; }
    }
    ex[(wv * 2) * 64 + lane] = hr; ex[(wv * 2 + 1) * 64 + lane] = hi;
    float qr = ar, qi = ai;
#pragma unroll
    for (int s = 0; s < 7; ++s) { const float t = qr * qr - qi * qi; qi = 2.f * qr * qi; qr = t; }
    { const float t = qr * ar - qi * ai; qi = qr * ai + qi * ar; qr = t; }
    __syncthreads();
    hr = 0.f; hi = 0.f;
    for (int j = 0; j < wv; ++j) { const float er = ex[(j * 2) * 64 + lane], ei = ex[(j * 2 + 1) * 64 + lane]; const float nr = qr * hr - qi * hi + er, ni = qr * hi + qi * hr + ei; hr = nr; hi = ni; }
    {
      int c = c0;
      float sr[8], si[8], pr[8], pi[8];
      if (c + 8 <= c1) {
#pragma unroll
        for (int u = 0; u < 8; ++u) { sr[u] = sp[(size_t)(c + u) * 8192]; si[u] = sp[(size_t)(c + u) * 8192 + 64]; }
      }
      for (; c + 8 <= c1; c += 8) {
        const bool more = c + 16 <= c1;
        if (more) {
#pragma unroll
          for (int u = 0; u < 8; ++u) { pr[u] = sp[(size_t)(c + 8 + u) * 8192]; pi[u] = sp[(size_t)(c + 8 + u) * 8192 + 64]; }
        }
#pragma unroll
        for (int u = 0; u < 8; ++u) {
          hp[(size_t)(c + u) * 8192] = f2bf(hr); hp[(size_t)(c + u) * 8192 + 64] = f2bf(hi);
          const float nr = ar * hr - ai * hi + sr[u], ni = ar * hi + ai * hr + si[u]; hr = nr; hi = ni;
        }
#pragma unroll
        for (int u = 0; u < 8; ++u) { sr[u] = pr[u]; si[u] = pi[u]; }
      }
      for (; c < c1; ++c) {
        const float sr = sp[(size_t)c * 8192], si = sp[(size_t)c * 8192 + 64];
        hp[(size_t)c * 8192] = f2bf(hr); hp[(size_t)c * 8192 + 64] = f2bf(hi);
        const float nr = ar * hr - ai * hi + sr, ni = ar * hi + ai * hr + si; hr = nr; hi = ni;
      }
    }
    if (wv == 7) {
      p.out[O_PRE + (((size_t)l * NB + b) * 64 + g) * 64 + lane] = hr; p.out[O_PIM + (((size_t)l * NB + b) * 64 + g) * 64 + lane] = hi;
    }
    __syncthreads();
  }
  for (int q = bid_o() * 8 + wv; q < 2048; q += gdim_o() * 8) {
    const int i = q >> 6, g = q & 63, c0 = 2050 + 2 * i;
    const size_t so = (((size_t)l * DB + i) * 64 + g) * 64 + lane;
    float hr = p.in[2][so], hi = p.in[3][so];
    const float* a16 = (const float*)(ws + W_A16) + (((size_t)l * 64 + g) * 64 + lane) * 2;
    const float ar = a16[0], ai = a16[1];
    const float* sp = sb + (size_t)c0 * 8192 + g * 128 + lane;
    bf16_t* hp = hin + (size_t)c0 * 8192 + g * 128 + lane;
#pragma unroll
    for (int c = 0; c < 2; ++c) {
      const float sr = sp[(size_t)c * 8192], si = sp[(size_t)c * 8192 + 64];
      hp[(size_t)c * 8192] = f2bf(hr); hp[(size_t)c * 8192 + 64] = f2bf(hi);
      const float nr = ar * hr - ai * hi + sr, ni = ar * hi + ai * hr + si; hr = nr; hi = ni;
    }
    p.out[O_SRE + so] = hr; p.out[O_SIM + so] = hi;
  }
}

__device__ __forceinline__ void kvfin_phase(const Params& p) {
  unsigned char* ws = p.ws;
  const float* kv = (const float*)(ws + W_KVRAW); bf16_t* kb = (bf16_t*)(ws + W_KB); bf16_t* vt = (bf16_t*)(ws + W_VT);
  const int lane = tid_o() & 63, wv = tid_o() >> 6;
  for (int row = bid_o() * 8 + wv; row < R_REAL; row += gdim_o() * 8) {
    const float* src = kv + (size_t)row * 512 + lane * 8;
    const f32x4 a = *(const f32x4*)src, b = *(const f32x4*)(src + 4);
    float v[8] = {a.x, a.y, a.z, a.w, b.x, b.y, b.z, b.w};
    const int col = (lane & 31) * 8, kvh = col >> 6, d0 = col & 63;
    int krow; float* ok = nullptr; float* ov = nullptr;
    if (row < R_SAMPLE) { const int b_ = row >> 14, t = row & 16383; krow = row;
      if (t >= SEQ - 128) { ok = p.out + O_PK + ((size_t)b_ * 128 + (t - (SEQ - 128))) * 256; ov = p.out + O_PV + ((size_t)b_ * 128 + (t - (SEQ - 128))) * 256; } }
    else if (row < R_META) { const int q = row - R_SAMPLE, i = q >> 5, j = q & 31; krow = KS_BASE + i * 160 + 128 + j;
      ok = p.out + O_SK + (size_t)q * 256; ov = p.out + O_SV + (size_t)q * 256; }
    else { krow = KM_BASE + (row - R_META); }
    if (lane < 32) {
      float s = 0.f;
#pragma unroll
      for (int i = 0; i < 8; ++i) s += v[i] * v[i];
      s += shx(s, 1, lane); s += shx(s, 2, lane); s += shx(s, 4, lane);
      const float r = rsqrtf(s * (1.f / 64.f) + 1e-6f);
#pragma unroll
      for (int i = 0; i < 8; ++i) v[i] = v[i] * r * p.in[22][d0 + i];
      u32x4 o; o.x = cvt_pk_bf16(v[0], v[1]); o.y = cvt_pk_bf16(v[2], v[3]); o.z = cvt_pk_bf16(v[4], v[5]); o.w = cvt_pk_bf16(v[6], v[7]);
      *(u32x4*)(kb + kf_off(krow, kvh, d0 >> 4, (d0 >> 3) & 1)) = o;
      if (ok) { *(f32x4*)(ok + col) = (f32x4){v[0], v[1], v[2], v[3]}; *(f32x4*)(ok + col + 4) = (f32x4){v[4], v[5], v[6], v[7]}; }
    } else {
      float s = 0.f; s += shx(s, 1, lane); s += shx(s, 2, lane); s += shx(s, 4, lane);
#pragma unroll
      for (int i = 0; i < 8; ++i) vt[vf_off(krow, kvh, d0 + i)] = f2bf(v[i]);
      if (ov) { *(f32x4*)(ov + col) = (f32x4){v[0], v[1], v[2], v[3]}; *(f32x4*)(ov + col + 4) = (f32x4){v[4], v[5], v[6], v[7]}; }
    }
  }
}

__device__ __forceinline__ int rel_bucket(int rel) {
  const int n = rel < 0 ? -rel : rel;
  const float nf = (float)(n < 1 ? 1 : n);
  int large = 8 + (int)(logf(nf / 8.f) / 2.772588722239781f * 8.f);
  large = large < 15 ? large : 15;
  return (rel > 0 ? 16 : 0) + (n < 8 ? n : large);
}

struct AttnItem { int kvh, nt_band, ktile0, sj0, tpos, qrow0, qi0, head; bool active; };
__device__ __forceinline__ AttnItem attn_item(int item, int wv) {
  AttnItem a;
  if (item < 2048) {
    const int b = item >> 10, n = (item >> 2) & 255; a.kvh = item & 3; a.head = a.kvh * 4 + (wv >> 1); const int qt = wv & 1;
    a.qi0 = qt * 32; a.qrow0 = b * SEQ + n * 64 + a.qi0; a.tpos = n * 64 + a.qi0;
    const int c0 = n >= 2 ? n - 2 : 0;
    a.nt_band = (n - c0 + 1) * 2;
    a.ktile0 = (b * SEQ + c0 * 64) >> 5;
    a.sj0 = n >= 2 ? 0 : (2 - n) * 64; a.active = true;
  } else {
    const int q = item - 2048, i = q >> 2; a.kvh = q & 3; a.head = a.kvh * 4 + (wv & 3); a.active = wv < 4;
    a.qi0 = 0; a.qrow0 = R_SAMPLE + i * 32; a.tpos = 1024; a.nt_band = 5;
    a.ktile0 = (KS_BASE + i * 160) >> 5; a.sj0 = 0;
  }
  return a;
}
constexpr int AT_BUF0 = 16896, AT_KV = 28672, AT_BUF = 2 * AT_KV;
__device__ __forceinline__ void attn_stage(const bf16_t* kb, const bf16_t* vt, int item, int buf, int wv, int lane) {
  const AttnItem a = attn_item(item, 0);
  LAS unsigned char* lds = (LAS unsigned char*)shm + AT_BUF0 + buf * AT_BUF;
#pragma unroll
  for (int t = 0; t < 7; ++t) {
    if (t <= a.nt_band) {
      const int T = t == 0 ? (KM_BASE >> 5) : a.ktile0 + (t - 1);
      const bf16_t* src; unsigned dst;
      if (wv < 4) { src = kb + ((((size_t)T * 4 + a.kvh) * 4 + wv) * 64 + lane) * 8; dst = t * 4096 + wv * 1024; }
      else { const int s = (wv - 4) >> 1, dt = (wv - 4) & 1; src = vt + (((((size_t)T * 2 + s) * 4 + a.kvh) * 2 + dt) * 64 + lane) * 8; dst = AT_KV + t * 4096 + (wv - 4) * 1024; }
      __builtin_amdgcn_global_load_lds((const unsigned*)src, (LAS unsigned*)(lds + dst), 16, 0, 0);
    }
  }
}

__device__ __forceinline__ void attn_phase(const Params& p, int jl) {
  unsigned char* ws = p.ws;
  float* lut = (float*)shm;
  float* qg = lut + 16 * 256;
  for (int e = tid_o(); e < 16 * 256; e += 512) {
    const int h = e >> 8, idx = e & 255; const int rel = idx - 191;
    lut[e] = idx < 255 ? p.in[27][rel_bucket(rel) * 16 + h] * 1.44269504089f : 0.f;
  }
  if (tid_o() < 64) qg[tid_o()] = p.in[24][jl * 64 + tid_o()] * (0.125f * 1.44269504089f);
  const bf16_t* qb = (const bf16_t*)(ws + W_UB); const bf16_t* kb = (const bf16_t*)(ws + W_KB); const bf16_t* vt = (const bf16_t*)(ws + W_VT);
  bf16_t* ao = (bf16_t*)(ws + W_YG);
  const int tid = tid_o(), lane = tid & 63, wv = __builtin_amdgcn_readfirstlane(tid >> 6), ql = lane & 31, hh = lane >> 5;
  const int G = gdim_o(), item0 = bid_o(), NITEM = 2048 + 128;
  u32x4 qraw[4];
  if (item0 < NITEM) {
    attn_stage(kb, vt, item0, 0, wv, lane);
    const AttnItem a = attn_item(item0, wv);
    const bf16_t* qp = qb + (size_t)(a.qrow0 + ql) * D + a.head * 64 + hh * 8;
#pragma unroll
    for (int kk = 0; kk < 4; ++kk) qraw[kk] = *(const u32x4*)(qp + kk * 16);
  }
  int cur = 0;
#pragma unroll 1
  for (int item = item0; item < NITEM; item += G, cur ^= 1) {
    asm volatile("s_waitcnt vmcnt(0)" ::: "memory");
    __syncthreads();
    const AttnItem a = attn_item(item, wv);
    u32x4 qcur[4];
#pragma unroll
    for (int kk = 0; kk < 4; ++kk) qcur[kk] = qraw[kk];
    if (item + G < NITEM) {
      attn_stage(kb, vt, item + G, cur ^ 1, wv, lane);
      const AttnItem an = attn_item(item + G, wv);
      const bf16_t* qp = qb + (size_t)(an.qrow0 + ql) * D + an.head * 64 + hh * 8;
#pragma unroll
      for (int kk = 0; kk < 4; ++kk) qraw[kk] = *(const u32x4*)(qp + kk * 16);
    }
    if (!a.active) continue;
    const int head = a.head, nt_band = a.nt_band, sj0 = a.sj0, qi0 = a.qi0, tpos = a.tpos, qrow0 = a.qrow0;
    const LAS unsigned char* kl = (const LAS unsigned char*)shm + AT_BUF0 + cur * AT_BUF + lane * 16;
    bf16x8 qf[4];
    {
      float qv[32]; float s = 0.f;
#pragma unroll
      for (int kk = 0; kk < 4; ++kk) {
        const unsigned w[4] = {qcur[kk].x, qcur[kk].y, qcur[kk].z, qcur[kk].w};
#pragma unroll
        for (int i = 0; i < 4; ++i) { qv[kk * 8 + 2 * i] = bf2f(w[i] & 0xffffu); qv[kk * 8 + 2 * i + 1] = bf2f(w[i] >> 16); }
      }
#pragma unroll
      for (int i = 0; i < 32; ++i) s += qv[i] * qv[i];
      s += shx(s, 32, lane);
      const float r = rsqrtf(s * (1.f / 64.f) + 1e-6f);
#pragma unroll
      for (int kk = 0; kk < 4; ++kk) {
        u32x4 o; const float* g8 = qg + kk * 16 + hh * 8;
        o.x = cvt_pk_bf16(qv[kk * 8 + 0] * r * g8[0], qv[kk * 8 + 1] * r * g8[1]); o.y = cvt_pk_bf16(qv[kk * 8 + 2] * r * g8[2], qv[kk * 8 + 3] * r * g8[3]);
        o.z = cvt_pk_bf16(qv[kk * 8 + 4] * r * g8[4], qv[kk * 8 + 5] * r * g8[5]); o.w = cvt_pk_bf16(qv[kk * 8 + 6] * r * g8[6], qv[kk * 8 + 7] * r * g8[7]);
        qf[kk] = __builtin_bit_cast(bf16x8, o);
      }
    }
    f32x16 sc[7];
#pragma unroll
    for (int t = 0; t < 7; ++t) {
      if (t <= nt_band) {
        f32x16 a_ = {0.f, 0.f, 0.f, 0.f, 0.f, 0.f, 0.f, 0.f, 0.f, 0.f, 0.f, 0.f, 0.f, 0.f, 0.f, 0.f};
#pragma unroll
        for (int kk = 0; kk < 4; ++kk) {
          const bf16x8 kf = *(const LAS bf16x8*)(kl + t * 4096 + kk * 1024);
          a_ = __builtin_amdgcn_mfma_f32_32x32x16_bf16(kf, qf[kk], a_, 0, 0, 0);
        }
        sc[t] = a_;
      }
    }
    const float sink = p.in[25][jl * 16 + head] * 1.44269504089f;
    const float* lh = lut + head * 256 + 191;
    float mx = sink;
    const int qi = qi0 + ql;
#pragma unroll
    for (int t = 0; t < 7; ++t) {
      if (t <= nt_band) {
#pragma unroll
        for (int r = 0; r < 16; ++r) {
          const int key = 8 * (r >> 2) + 4 * hh + (r & 3);
          float v;
          if (t == 0) {
            if (r < 8) { int rel = key - 16 - (tpos + ql); rel = rel < -191 ? -191 : rel; v = sc[t][r] + lh[rel]; } else v = -1e30f;
          } else {
            const int rel = sj0 + (t - 1) * 32 + key - 128 - qi;
            v = sc[t][r] + lh[rel];
          }
          sc[t][r] = v; mx = fmaxf(mx, v);
        }
      }
    }
    mx = fmaxf(mx, shx(mx, 32, lane));
    float sum = 0.f;
#pragma unroll
    for (int t = 0; t < 7; ++t) {
      if (t <= nt_band) {
#pragma unroll
        for (int r = 0; r < 16; ++r) { const float e = __builtin_amdgcn_exp2f(sc[t][r] - mx); sc[t][r] = e; sum += e; }
      }
    }
    sum += shx(sum, 32, lane);
    const float inv = 1.f / (sum + __builtin_amdgcn_exp2f(sink - mx));
    f32x16 o0 = {0.f, 0.f, 0.f, 0.f, 0.f, 0.f, 0.f, 0.f, 0.f, 0.f, 0.f, 0.f, 0.f, 0.f, 0.f, 0.f}, o1 = o0;
#pragma unroll
    for (int t = 0; t < 7; ++t) {
      if (t <= nt_band) {
#pragma unroll
        for (int s = 0; s < 2; ++s) {
          if (t == 0 && s == 1) continue;
          u32x4 pa; pa.x = cvt_pk_bf16(sc[t][8 * s + 0] * inv, sc[t][8 * s + 1] * inv); pa.y = cvt_pk_bf16(sc[t][8 * s + 2] * inv, sc[t][8 * s + 3] * inv);
          pa.z = cvt_pk_bf16(sc[t][8 * s + 4] * inv, sc[t][8 * s + 5] * inv); pa.w = cvt_pk_bf16(sc[t][8 * s + 6] * inv, sc[t][8 * s + 7] * inv);
          const bf16x8 pf = __builtin_bit_cast(bf16x8, pa);
          const bf16x8 b0 = *(const LAS bf16x8*)(kl + AT_KV + t * 4096 + s * 2048), b1 = *(const LAS bf16x8*)(kl + AT_KV + t * 4096 + s * 2048 + 1024);
          o0 = __builtin_amdgcn_mfma_f32_32x32x16_bf16(pf, b0, o0, 0, 0, 0);
          o1 = __builtin_amdgcn_mfma_f32_32x32x16_bf16(pf, b1, o1, 0, 0, 0);
        }
      }
    }
#pragma unroll
    for (int r = 0; r < 16; ++r) {
      const int q = 8 * (r >> 2) + 4 * hh + (r & 3);
      bf16_t* op = ao + (size_t)(qrow0 + q) * D + head * 64 + ql;
      op[0] = f2bf(o0[r]); op[32] = f2bf(o1[r]);
    }
  }
  asm volatile("s_waitcnt vmcnt(0)" ::: "memory");
  __syncthreads();
}

__global__ void __launch_bounds__(512) fwd_megakernel(Params p) {
  cg::grid_group grid = cg::this_grid();
  unsigned char* ws = p.ws;
  volatile LAS unsigned* xst = (volatile LAS unsigned*)((LAS unsigned char*)shm + XB_LDS_OFF);
  if (threadIdx.x < 4) xst[threadIdx.x] = 0u;
  __syncthreads();
  (void)xcd_barrier_post((unsigned*)(ws + W_BAR), xst);
  for (int it = bid_o(); it < 128; it += gdim_o()) s5_matrices(p, it >> 6, it & 63);
  weights_phase(p);
  cache_phase(p);
  norm_phase<0>(p, p.in[7], 0);
  if (p.ws == nullptr) grid.sync();
  xcd_barrier(p.ws);
#pragma unroll 1
  for (int l = 0; l < 4; ++l) {
    if (l < 2) {
      if (l == 1) { norm_phase<1>(p, p.in[7] + D, 11); xcd_barrier(p.ws); }
      gemm_phase<G_S1>(p, nullptr, 0, (const bf16_t*)(ws + W_BS1) + (size_t)l * 8192 * 512, 8192, 512);
      xcd_barrier(p.ws);
      if (PROBE == 9) { gemm_phase<G_S1>(p, nullptr, 0, (const bf16_t*)(ws + W_BS1) + (size_t)l * 8192 * 512, 8192, 512); xcd_barrier(p.ws); }
      s2_phase(p, l);
      xcd_barrier(p.ws);
      if (PROBE == 3) { s2_phase(p, l); xcd_barrier(p.ws); s2_phase(p, l); xcd_barrier(p.ws); }
      gemm_phase<G_S3>(p, nullptr, 0, (const bf16_t*)(ws + W_BS3) + (size_t)l * 16384 * 384, 16384, 384);
      xcd_barrier(p.ws);
      if (PROBE == 10) { gemm_phase<G_S3>(p, nullptr, 0, (const bf16_t*)(ws + W_BS3) + (size_t)l * 16384 * 384, 16384, 384); xcd_barrier(p.ws); }
      gemm_phase<G_GLU>(p, (const bf16_t*)(ws + W_YG), D, (const bf16_t*)(ws + W_WGLU) + (size_t)l * 2048 * 1024, 2048, 1024, l == 0);
      xcd_barrier(p.ws);
    } else {
      norm_phase<2>(p, nullptr, 11);
      xcd_barrier(p.ws);
      if (l == 2) gemm_phase_stream<G_QKV>(p, (const bf16_t*)(ws + W_XB), D, (const bf16_t*)(ws + W_WQKV), 1536, 1024);
      else gemm_phase_stream<G_QKV>(p, (const bf16_t*)(ws + W_XB), D, (const bf16_t*)(ws + W_WQKV) + (size_t)1536 * 1024, 1024, 1024);
      xcd_barrier(p.ws);
      if (l == 2) { kvfin_phase(p); xcd_barrier(p.ws); }
      attn_phase(p, l - 2);
      xcd_barrier(p.ws);
      if (PROBE == 4) { attn_phase(p, l - 2); xcd_barrier(p.ws); attn_phase(p, l - 2); xcd_barrier(p.ws); }
      gemm_phase<G_RESID>(p, (const bf16_t*)(ws + W_YG), D, (const bf16_t*)(ws + W_WO) + (size_t)(l - 2) * 1024 * 1024, 1024, 1024);
      xcd_barrier(p.ws);
    }
    norm_phase<2>(p, nullptr, l < 2 ? 0 : 4);
    xcd_barrier(p.ws);
    gemm_phase_stream<G_FFIN>(p, (const bf16_t*)(ws + W_XB), D, (const bf16_t*)(ws + W_WIN) + (size_t)l * 5632 * 1024, 5632, 1024);
    xcd_barrier(p.ws);
    if (PROBE == 1) { gemm_phase_stream<G_FFIN>(p, (const bf16_t*)(ws + W_XB), D, (const bf16_t*)(ws + W_WIN) + (size_t)l * 5632 * 1024, 5632, 1024); xcd_barrier(p.ws); }
    if (PROBE == 2) { for (int q = 0; q < 10; ++q) xcd_barrier(p.ws); }
    gemm_phase<G_RESID>(p, (const bf16_t*)(ws + W_HB), FF, (const bf16_t*)(ws + W_WOUT) + (size_t)l * 1024 * FF, 1024, FF, l == 3 ? 2 : 0);
    xcd_barrier(p.ws);
  }
  norm_phase<3>(p, nullptr, 11);
}

extern "C" void kernel_launch(void* const* d_in, const int* in_sizes, int n_in, void* d_out, int out_size, void* d_ws, size_t ws_size, hipStream_t stream) {
  static int grid_blocks = 0;
  if (grid_blocks == 0) {
    if (n_in != 28 || (size_t)out_size != O_END || ws_size < W_END) { fprintf(stderr, "kernel_launch: unexpected shapes (n_in %d out %d ws %zu need %zu)\n", n_in, out_size, ws_size, (size_t)W_END); grid_blocks = -1; return; }
    int dev = 0, cus = 0, per_cu = 0;
    hipGetDevice(&dev);
    hipDeviceGetAttribute(&cus, hipDeviceAttributeMultiprocessorCount, dev);
    if (hipFuncSetAttribute((const void*)fwd_megakernel, hipFuncAttributeMaxDynamicSharedMemorySize, LDS_BYTES) != hipSuccess) { fprintf(stderr, "kernel_launch: hipFuncSetAttribute failed\n"); }
    hipOccupancyMaxActiveBlocksPerMultiprocessor(&per_cu, (const void*)fwd_megakernel, 512, LDS_BYTES);
    if (per_cu < 1) { fprintf(stderr, "kernel_launch: occupancy query says %d blocks/CU\n", per_cu); per_cu = 1; }
    (void)hipGetLastError();
    grid_blocks = cus;
  }
  if (grid_blocks < 0) return;
  if (hipMemsetAsync((char*)d_ws + W_BAR, 0, 4096 * 4, stream) != hipSuccess) { fprintf(stderr, "kernel_launch: memset failed\n"); return; }
  Params p{};
  for (int i = 0; i < 28; ++i) p.in[i] = (const float*)d_in[i];
  p.out = (float*)d_out; p.ws = (unsigned char*)d_ws;
  void* args[] = {&p};
  hipError_t e = hipLaunchCooperativeKernel((const void*)fwd_megakernel, dim3(grid_blocks), dim3(512), args, LDS_BYTES, stream);
  if (e != hipSuccess) fprintf(stderr, "cooperative launch failed: %s (grid %d)\n", hipGetErrorString(e), grid_blocks);
}
```

```cpp
#include <hip/hip_runtime.h>
#include <hip/hip_cooperative_groups.h>
#include <cstdio>
#include <cstdint>
namespace cg = cooperative_groups;

typedef unsigned short bf16_t;
typedef short bf16x8 __attribute__((ext_vector_type(8)));
typedef float f32x4 __attribute__((ext_vector_type(4)));
typedef float f32x16 __attribute__((ext_vector_type(16)));
typedef unsigned u32x4 __attribute__((ext_vector_type(4)));
typedef unsigned u32x2 __attribute__((ext_vector_type(2)));

constexpr int D = 1024, SEQ = 16384, NB = 2, DB = 32, DS = 32, FF = 2816;
constexpr int R_PROMPT = 0, R_SAMPLE = 32768, R_META = 33792, R_REAL = 33808, R_PAD = 34048;
constexpr int NTM = R_PAD / 256;
constexpr int NCH = 2 * 1025 + 64, NCH_PAD = 2304;
constexpr int KROWS = 32768 + 32 * 160 + 16;
constexpr int KS_BASE = 32768, KM_BASE = 32768 + 5120;
constexpr size_t VT_S = (size_t)2 * 4 * 64 * 16384, VT_M = VT_S + (size_t)32 * 4 * 64 * 160;

constexpr size_t O_YP = 0, O_YS = 33554432, O_PRE = O_YS + 1048576, O_PIM = O_PRE + 16384, O_PK = O_PIM + 16384, O_PV = O_PK + 65536,
                 O_SRE = O_PV + 65536, O_SIM = O_SRE + 262144, O_SK = O_SIM + 262144, O_SV = O_SK + 262144, O_END = O_SV + 262144;

constexpr size_t al(size_t x) { return (x + 255) & ~(size_t)255; }
constexpr size_t W_XMETA = 0;
constexpr size_t W_XB = al(W_XMETA + (size_t)256 * D * 4);
constexpr size_t W_RS = al(W_XB + (size_t)R_PAD * D * 2);
constexpr size_t W_UB = al(W_RS + (size_t)R_PAD * 4);
constexpr size_t W_YG = al(W_UB + (size_t)R_PAD * D * 2);
constexpr size_t W_SB = al(W_YG + (size_t)R_PAD * D * 2);
constexpr size_t W_HIN = al(W_SB + (size_t)NCH_PAD * 8192 * 4);
constexpr size_t W_KB = al(W_HIN + (size_t)NCH_PAD * 8192 * 2);
constexpr size_t W_VT = al(W_KB + (size_t)(KROWS + 16) * 256 * 2);
constexpr size_t W_WGLU = al(W_VT + (size_t)(KROWS + 16) * 256 * 2);
constexpr size_t W_WIN = al(W_WGLU + (size_t)2 * 2048 * 1024 * 2);
constexpr size_t W_WOUT = al(W_WIN + (size_t)4 * 5632 * 1024 * 2);
constexpr size_t W_WQKV = al(W_WOUT + (size_t)4 * 1024 * FF * 2);
constexpr size_t W_WO = al(W_WQKV + (size_t)2560 * 1024 * 2);
constexpr size_t W_BS1 = al(W_WO + (size_t)2 * 1024 * 1024 * 2);
constexpr size_t W_BS3 = al(W_BS1 + (size_t)2 * 8192 * 512 * 2);
constexpr size_t W_A16 = al(W_BS3 + (size_t)2 * 16384 * 384 * 2);
constexpr size_t W_BAR = al(W_A16 + (size_t)2 * 64 * 64 * 8);
constexpr size_t W_END = al(W_BAR + (size_t)4096 * 4);
constexpr size_t W_HB = W_UB;
constexpr size_t W_KVRAW = W_SB;
constexpr size_t W_PART = W_UB + (size_t)R_PAD * FF * 2;
constexpr int SPLIT_ROW0 = 32768, SPLIT_ROWS = R_PAD - 32768, SPLIT_PM0 = 128;
static_assert(W_PART + (size_t)11 * SPLIT_ROWS * D * 4 <= W_KB, "partials overlay");
static_assert((size_t)R_PAD * FF * 2 <= W_HIN - W_UB, "hb overlay");
static_assert((size_t)R_PAD * 512 * 4 <= W_HIN - W_SB, "kvraw overlay");
static_assert(W_END <= (size_t)512 * 1024 * 1024, "workspace");

constexpr int LDS_BYTES = 147456;
constexpr int XB_LDS_OFF = LDS_BYTES - 16;
constexpr int PROBE = 0;

struct Params {
  const float* in[28];
  float* out;
  unsigned char* ws;
};

extern __shared__ __attribute__((aligned(16))) unsigned char shm[];

__device__ __forceinline__ unsigned cvt_pk_bf16(float lo, float hi) { unsigned r; asm volatile("v_cvt_pk_bf16_f32 %0, %1, %2" : "=v"(r) : "v"(lo), "v"(hi)); return r; }
__device__ __forceinline__ bf16_t f2bf(float f) { return (bf16_t)(cvt_pk_bf16(f, 0.f) & 0xffffu); }
__device__ __forceinline__ float bf2f(unsigned b) { return __uint_as_float(b << 16); }
__device__ __forceinline__ f32x4 unpack4(u32x2 r) { return (f32x4){__uint_as_float(r.x << 16), __uint_as_float(r.x & 0xffff0000u), __uint_as_float(r.y << 16), __uint_as_float(r.y & 0xffff0000u)}; }
__device__ __forceinline__ float shx(float v, int o, int lane) { return __int_as_float(__builtin_amdgcn_ds_bpermute((lane ^ o) << 2, __float_as_int(v))); }
__device__ __forceinline__ float wave_sum(float v, int lane) {
#pragma unroll
  for (int o = 1; o < 64; o <<= 1) v += shx(v, o, lane);
  return v;
}
__device__ __forceinline__ int tid_o() { int t = threadIdx.x; asm volatile("" : "+v"(t)); return t; }
__device__ __forceinline__ int bid_o() { int b = blockIdx.x; asm volatile("" : "+s"(b)); return b; }
__device__ __forceinline__ int gdim_o() { int b = gridDim.x; asm volatile("" : "+s"(b)); return b; }
__device__ __forceinline__ float sigmoidf_(float x) { return __builtin_amdgcn_rcpf(1.f + __expf(-x)); }
__device__ __forceinline__ float gelu_tanh(float x) {
  const float x2 = x * x;
  const float w = x * (-2.302208198f - 0.102943242f * x2);
  return x * __builtin_amdgcn_rcpf(1.f + __builtin_amdgcn_exp2f(w));
}
__device__ __forceinline__ float* xrow_ptr(const Params& p, int row) {
  return row < R_META ? p.out + (size_t)row * D : (float*)(p.ws + W_XMETA) + (size_t)(row - R_META) * D;
}
__device__ __forceinline__ const float* xsrc_ptr(const Params& p, int row) {
  return row < R_SAMPLE ? p.in[0] + (size_t)row * D : row < R_META ? p.in[1] + (size_t)(row - R_SAMPLE) * D : row < R_REAL ? p.in[6] + (size_t)(row - R_META) * D : nullptr;
}
__device__ __forceinline__ int chunk_row(int cgi) {
  if (cgi >= NCH) cgi = 0;
  if (cgi < 2050) { const int b = cgi >= 1025 ? 1 : 0; const int c = cgi - b * 1025; return c == 0 ? R_META : b * SEQ + (c - 1) * 16; }
  return R_SAMPLE + (cgi - 2050) * 16;
}

#define LAS __attribute__((address_space(3)))
constexpr int BM = 256, BK = 64, HALF = 128, HTB = HALF * BK * 2;
__device__ __forceinline__ int lds_byte(int r, int c) {
  int st = (r >> 4) * 2 + (c >> 5), rr = r & 15, cc = c & 31, ob = rr * 64 + cc * 2;
  return st * 1024 + (ob ^ (((ob >> 9) & 1) << 5));
}
__device__ __forceinline__ void stage_rc(int b, int& R, int& C) {
  int st = b / 1024, sb = b % 1024, swz = sb ^ (((sb >> 9) & 1) << 5);
  R = (st >> 1) * 16 + swz / 64; C = (st & 1) * 32 + (swz % 64) / 2;
}

typedef f32x4 acc_t[2][2][4][2];

struct ARow {
  const char* base; unsigned hstep; unsigned voff[2];
  __device__ __forceinline__ void init(const bf16_t* A, int lda, int brow) {
    base = (const char*)(A + (size_t)brow * lda); hstep = (unsigned)HALF * lda * 2u;
#pragma unroll
    for (int i = 0; i < 2; ++i) { int R, C; stage_rc(tid_o() * 16 + i * 8192, R, C); voff[i] = (unsigned)(R * lda + C) * 2u; }
  }
  __device__ __forceinline__ const char* ptr(int h, int i, int kt) const { return base + (size_t)h * hstep + (size_t)kt * 128 + voff[i]; }
};
struct AS1 {
  const char* ub; unsigned voff[2][2]; int pn;
  __device__ __forceinline__ void init(const bf16_t* u, int brow, int pn_) {
    ub = (const char*)u; pn = pn_;
#pragma unroll
    for (int h = 0; h < 2; ++h)
#pragma unroll
      for (int i = 0; i < 2; ++i) { int R, C; stage_rc(tid_o() * 16 + i * 8192, R, C);
        voff[h][i] = (unsigned)(chunk_row(brow + h * 128 + R) + (C >> 4)) * 2048u + (unsigned)(C & 15) * 2u; }
  }
  __device__ __forceinline__ const char* ptr(int h, int i, int kt) const { return ub + (size_t)((pn * 2 + (kt >> 2)) * 32 + (kt & 3) * 8192) + voff[h][i]; }
};
struct AS3 {
  const char* ub; const char* hin; unsigned voffu[2][2], voffh[2][2]; int g;
  __device__ __forceinline__ void init(const bf16_t* u, const bf16_t* hn, int brow, int g_) {
    ub = (const char*)u; hin = (const char*)hn; g = g_;
#pragma unroll
    for (int h = 0; h < 2; ++h)
#pragma unroll
      for (int i = 0; i < 2; ++i) { int R, C; stage_rc(tid_o() * 16 + i * 8192, R, C);
        int cgi = brow + h * 128 + R; if (cgi >= NCH) cgi = 0;
        voffu[h][i] = (unsigned)cgi * 32768u + (unsigned)C * 2u;
        voffh[h][i] = (unsigned)cgi * 16384u + (unsigned)C * 2u; }
  }
  __device__ __forceinline__ const char* ptr(int h, int i, int kt) const {
    return kt < 4 ? ub + (size_t)(g * 512 + kt * 128) + voffu[h][i] : hin + (size_t)(g * 256 + (kt - 4) * 128) + voffh[h][i];
  }
};

template <class AF>
__device__ __forceinline__ void gemm_mainloop(acc_t& acc, const AF& A, const bf16_t* Bt, int K, int bcol, int nt) {
  LAS unsigned char* lds = (LAS unsigned char*)shm;
  const int tid = tid_o(), wid = __builtin_amdgcn_readfirstlane(tid >> 6), lane = tid & 63, wr = wid >> 2, wc = wid & 3, fr = lane & 15, fq = lane >> 4;
  unsigned voffB[2];
#pragma unroll
  for (int i = 0; i < 2; ++i) { int R, C; stage_rc(tid * 16 + i * 8192, R, C); voffB[i] = (unsigned)(R * K + C) * 2u; }
  const char* cB = (const char*)(Bt + (size_t)bcol * K);
  const size_t hstepB = (size_t)HALF * K * 2;
  const unsigned ldsw = (unsigned)wid * 1024u;
  const int aoff = lds_byte(wr * 64 + fr, fq * 8), boff = lds_byte(wc * 32 + fr, fq * 8);
#define SA(b, h) (((b) * 2 + (h)) * HTB)
#define SB(b, h) ((4 + (b) * 2 + (h)) * HTB)
#define STAGE_A(bufoff, h, kt) do { _Pragma("unroll") for (int _i = 0; _i < 2; ++_i) \
    __builtin_amdgcn_global_load_lds((const unsigned*)A.ptr(h, _i, kt), (LAS unsigned*)(lds + (bufoff) + ldsw + _i * 8192), 16, 0, 0); } while (0)
#define STAGE_B(bufoff, h, kt) do { _Pragma("unroll") for (int _i = 0; _i < 2; ++_i) \
    __builtin_amdgcn_global_load_lds((const unsigned*)(cB + (size_t)(h) * hstepB + (size_t)(kt) * 128 + voffB[_i]), (LAS unsigned*)(lds + (bufoff) + ldsw + _i * 8192), 16, 0, 0); } while (0)
#define LDA(dst, b, h) do { _Pragma("unroll") for (int m = 0; m < 4; ++m) _Pragma("unroll") for (int k = 0; k < 2; ++k) dst[m][k] = *(const LAS bf16x8*)(lds + SA(b, h) + aoff + m * 2048 + k * 1024); } while (0)
#define LDB(dst, b, h) do { _Pragma("unroll") for (int n = 0; n < 2; ++n) _Pragma("unroll") for (int k = 0; k < 2; ++k) dst[n][k] = *(const LAS bf16x8*)(lds + SB(b, h) + boff + n * 2048 + k * 1024); } while (0)
#define MMA(ai, bj, At_, Bt_) do { __builtin_amdgcn_s_setprio(1); _Pragma("unroll") for (int m = 0; m < 4; ++m) _Pragma("unroll") for (int n = 0; n < 2; ++n) _Pragma("unroll") for (int k = 0; k < 2; ++k) \
      acc[ai][bj][m][n] = __builtin_amdgcn_mfma_f32_16x16x32_bf16(Bt_[n][k], At_[m][k], acc[ai][bj][m][n], 0, 0, 0); \
    __builtin_amdgcn_s_setprio(0); } while (0)
#define WAIT_V(n) asm volatile("s_waitcnt vmcnt(" #n ")" ::: "memory")
#define WAIT_L(n) asm volatile("s_waitcnt lgkmcnt(" #n ")" ::: "memory")
#define BAR __builtin_amdgcn_s_barrier()
#define SCHED __builtin_amdgcn_sched_barrier(0)
#pragma unroll
  for (int a = 0; a < 2; ++a)
#pragma unroll
    for (int b = 0; b < 2; ++b)
#pragma unroll
      for (int m = 0; m < 4; ++m)
#pragma unroll
        for (int n = 0; n < 2; ++n) acc[a][b][m][n] = (f32x4){0.f, 0.f, 0.f, 0.f};
  bf16x8 At[4][2], B0[2][2], B1[2][2];
  STAGE_B(SB(0, 0), 0, 0); STAGE_B(SB(0, 1), 1, 0); STAGE_A(SA(0, 0), 0, 0); STAGE_A(SA(0, 1), 1, 0);
  if (wr == 1) BAR;
  WAIT_V(2); BAR;
  STAGE_B(SB(1, 0), 0, 1); STAGE_A(SA(1, 0), 0, 1); STAGE_B(SB(1, 1), 1, 1);
  WAIT_V(6); BAR;
#pragma unroll 1
  for (int t = 0; t < nt - 2; t += 2) {
    const int k2 = t + 2, k3 = t + 3;
    LDB(B0, 0, 0); LDB(B1, 0, 1); SCHED; LDA(At, 0, 0); STAGE_A(SA(1, 1), 1, t + 1);
    WAIT_V(8); WAIT_L(0); BAR; MMA(0, 0, At, B0); MMA(0, 1, At, B1); BAR; SCHED;
    LDA(At, 0, 1); STAGE_B(SB(0, 0), 0, k2); STAGE_B(SB(0, 1), 1, k2); STAGE_A(SA(0, 0), 0, k2);
    WAIT_V(8); WAIT_L(0); BAR; MMA(1, 0, At, B0); MMA(1, 1, At, B1); BAR; SCHED;
    LDB(B0, 1, 0); LDB(B1, 1, 1); SCHED; LDA(At, 1, 0); STAGE_A(SA(0, 1), 1, k2);
    WAIT_V(8); WAIT_L(0); BAR; MMA(0, 0, At, B0); MMA(0, 1, At, B1); BAR; SCHED;
    LDA(At, 1, 1); STAGE_B(SB(1, 0), 0, k3); STAGE_B(SB(1, 1), 1, k3); STAGE_A(SA(1, 0), 0, k3);
    WAIT_V(8); WAIT_L(0); BAR; MMA(1, 0, At, B0); MMA(1, 1, At, B1); BAR; SCHED;
  }
  {
    LDB(B0, 0, 0); LDB(B1, 0, 1); SCHED; LDA(At, 0, 0); STAGE_A(SA(1, 1), 1, nt - 1);
    WAIT_V(8); WAIT_L(0); BAR; MMA(0, 0, At, B0); MMA(0, 1, At, B1); BAR; SCHED;
    LDA(At, 0, 1);
    WAIT_V(2); WAIT_L(0); BAR; MMA(1, 0, At, B0); MMA(1, 1, At, B1); BAR; SCHED;
    LDB(B0, 1, 0); LDB(B1, 1, 1); SCHED; LDA(At, 1, 0);
    WAIT_V(0); WAIT_L(0); BAR; MMA(0, 0, At, B0); MMA(0, 1, At, B1); BAR; SCHED;
    LDA(At, 1, 1);
    WAIT_L(0); BAR; MMA(1, 0, At, B0); MMA(1, 1, At, B1); BAR;
  }
  WAIT_V(0);
  if (wr == 0) BAR;
  BAR;
#undef SA
#undef SB
}


#define XB_TMO      128
#define XB_XCNT(j)  (256  + 64 * (j))
#define XB_XSUB(j)  (1280 + 64 * (j))
#define XB_XGEN(j)  (2304 + 64 * (j))
#define XB_TOP      3328
#define XB_TOPGEN   3392
#define XCD_BAR_WORDS 3456
#define XB_SPIN_CAP (1u << 18)
__device__ __forceinline__ unsigned xb_ld(unsigned* p)              { return __hip_atomic_load(p, __ATOMIC_RELAXED, __HIP_MEMORY_SCOPE_AGENT); }
__device__ __forceinline__ unsigned xb_add(unsigned* p, unsigned v) { return __hip_atomic_fetch_add(p, v, __ATOMIC_RELAXED, __HIP_MEMORY_SCOPE_AGENT); }
__device__ __forceinline__ unsigned xb_xcc_id() { return (unsigned)__builtin_amdgcn_s_getreg((3 << 11) | 20) & 0xFu; }
#define XB_SPIN(cond, bar) do { unsigned _sp = 0; while (cond) { __builtin_amdgcn_s_sleep(1); \
    if ((++_sp & 255u) == 0u) { if (xb_ld(&(bar)[XB_TMO])) break; if (_sp > XB_SPIN_CAP) { atomicAdd(&(bar)[XB_TMO], 1u); break; } } } } while (0)
struct XcdBarrier { unsigned* bar; unsigned x; volatile LAS unsigned* st; };
__device__ __forceinline__ XcdBarrier xcd_barrier_post(unsigned* bar, volatile LAS unsigned* st) {
  XcdBarrier b; b.bar = bar; b.x = xb_xcc_id(); b.st = st;
  if (threadIdx.x == 0) (void)xb_add(&bar[XB_XCNT(b.x)], 1u);
  return b;
}
__device__ __forceinline__ void xcd_barrier_complete(unsigned* bar, unsigned x, unsigned& nloc, unsigned& nx) {
  const unsigned G = gridDim.x * gridDim.y * gridDim.z;
  unsigned sum, cnt, mine, sp = 0u;
  for (;;) {
    sum = 0u; cnt = 0u; mine = 0u;
#pragma unroll
    for (unsigned j = 0; j < 16; ++j) { const unsigned c = xb_ld(&bar[XB_XCNT(j)]); sum += c; cnt += (c > 0u) ? 1u : 0u; mine = (j == x) ? c : mine; }
    if (sum == G) break;
    __builtin_amdgcn_s_sleep(1);
    if ((++sp & 255u) == 0u) { if (xb_ld(&bar[XB_TMO])) break; if (sp > XB_SPIN_CAP) { atomicAdd(&bar[XB_TMO], 1u); break; } }
  }
  nloc = mine > 0u ? mine : 1u; nx = cnt > 0u ? cnt : 1u;
}
__device__ __forceinline__ void xcd_barrier(unsigned char* ws_) {
  XcdBarrier b; b.bar = (unsigned*)(ws_ + W_BAR); b.x = xb_xcc_id(); b.st = (volatile LAS unsigned*)((LAS unsigned char*)shm + XB_LDS_OFF);
  asm volatile("s_waitcnt vmcnt(0)" ::: "memory");
  __syncthreads();
  if (threadIdx.x == 0) {
    unsigned* bar = b.bar;
    __builtin_amdgcn_s_waitcnt(0);
    unsigned nloc = b.st[0], nx = b.st[1];
    if (nloc == 0u) { xcd_barrier_complete(bar, b.x, nloc, nx); b.st[0] = nloc; b.st[1] = nx; }
    const unsigned old = xb_add(&bar[XB_XSUB(b.x)], 1u);
    const unsigned gen = old / nloc;
    if (old + 1u == (gen + 1u) * nloc) {
      __builtin_amdgcn_fence(__ATOMIC_RELEASE, "agent");
      asm volatile("s_waitcnt vmcnt(0)" ::: "memory");
      const unsigned og = xb_add(&bar[XB_TOP], 1u);
      const unsigned tg = og / nx;
      if (og + 1u == (tg + 1u) * nx) xb_add(&bar[XB_TOPGEN], 1u);
      else XB_SPIN(xb_ld(&bar[XB_TOPGEN]) == tg, bar);
      __builtin_amdgcn_fence(__ATOMIC_ACQUIRE, "agent");
      xb_add(&bar[XB_XGEN(b.x)], 1u);
      asm volatile("s_waitcnt vmcnt(0)" ::: "memory");
    } else {
      XB_SPIN(xb_ld(&bar[XB_XGEN(b.x)]) == gen, bar);
      __builtin_amdgcn_fence(__ATOMIC_ACQUIRE, "agent");
      asm volatile("s_waitcnt vmcnt(0)" ::: "memory");
    }
  }
  __syncthreads();
}

__device__ __forceinline__ bool tile_at(long L, int nM, int nN, int& pm, int& pn) {
  const int nwg = nM * nN;
  if (L >= nwg) return false;
  int wgid = (int)L;
  { const int q = nwg / 8, r = nwg % 8, xcd = wgid % 8, off = wgid / 8; wgid = (xcd < r ? xcd * (q + 1) : r * (q + 1) + (xcd - r) * q) + off; }
  const int nig = 8 * nN, gid = wgid / nig, fm = gid * 8, gsz = (nM - fm) < 8 ? (nM - fm) : 8;
  pm = fm + ((wgid % nig) % gsz); pn = (wgid % nig) / gsz;
  return true;
}
__device__ __forceinline__ bool tile_next(int it, int nM, int nN, int& pm, int& pn) { return tile_at((long)it * gdim_o() + bid_o(), nM, nN, pm, pn); }

#define EPI_ROWS_BEGIN \
  const int wid = tid_o() >> 6, lane = tid_o() & 63, wr = wid >> 2, wc = wid & 3, fr = lane & 15, fq = lane >> 4; \
  _Pragma("unroll") for (int ai = 0; ai < 2; ++ai) _Pragma("unroll") for (int m = 0; m < 4; ++m) { \
    const int row = brow + ai * 128 + wr * 64 + m * 16 + fr;
#define EPI_ROWS_END }

enum { G_GLU = 0, G_FFIN = 1, G_RESID = 2, G_QKV = 3, G_S1 = 4, G_S3 = 5 };

template <int MODE>
__device__ __forceinline__ void gemm_epilogue(const Params& p, acc_t& acc, int brow, int bcol, int pn, bool split, int ksi, int first, const float (&rsv)[8]) {
  unsigned char* ws = p.ws;
    if (MODE == G_GLU) {
      bf16_t* xb = (bf16_t*)(ws + W_XB);
      EPI_ROWS_BEGIN
        bf16_t* xr = xb + (size_t)row * D;
        const int oc = (bcol >> 1) + wc * 32 + fq * 8;
        f32x4 x0, x1;
        if (first & 1) { const float* xs = xsrc_ptr(p, row); x0 = xs ? *(const f32x4*)(xs + oc) : (f32x4){0.f, 0.f, 0.f, 0.f}; x1 = xs ? *(const f32x4*)(xs + oc + 4) : (f32x4){0.f, 0.f, 0.f, 0.f}; }
        else { const u32x4 raw = *(const u32x4*)(xr + oc); x0 = unpack4((u32x2){raw.x, raw.y}); x1 = unpack4((u32x2){raw.z, raw.w}); }
#pragma unroll
        for (int j = 0; j < 4; ++j) { x0[j] += acc[ai][0][m][0][j] * sigmoidf_(acc[ai][1][m][0][j]); x1[j] += acc[ai][0][m][1][j] * sigmoidf_(acc[ai][1][m][1][j]); }
        u32x4 o; o.x = cvt_pk_bf16(x0[0], x0[1]); o.y = cvt_pk_bf16(x0[2], x0[3]); o.z = cvt_pk_bf16(x1[0], x1[1]); o.w = cvt_pk_bf16(x1[2], x1[3]);
        *(u32x4*)(xr + oc) = o;
      EPI_ROWS_END
    } else if (MODE == G_FFIN) {
      bf16_t* hb = (bf16_t*)(ws + W_HB); const float* rs = (const float*)(ws + W_RS);
      EPI_ROWS_BEGIN
        const float s = rsv[ai * 4 + m];
        const int oc = (bcol >> 1) + wc * 32 + fq * 8;
        float hv[8];
#pragma unroll
        for (int n = 0; n < 2; ++n)
#pragma unroll
          for (int j = 0; j < 4; ++j) { const float gt = acc[ai][0][m][n][j] * s, up = acc[ai][1][m][n][j] * s; hv[n * 4 + j] = gt * sigmoidf_(gt) * up; }
        u32x4 o; o.x = cvt_pk_bf16(hv[0], hv[1]); o.y = cvt_pk_bf16(hv[2], hv[3]); o.z = cvt_pk_bf16(hv[4], hv[5]); o.w = cvt_pk_bf16(hv[6], hv[7]);
        *(u32x4*)(hb + (size_t)row * FF + oc) = o;
      EPI_ROWS_END
    } else if (MODE == G_RESID) {
      bf16_t* xb = (bf16_t*)(ws + W_XB);
      EPI_ROWS_BEGIN
        bf16_t* xr = xb + (size_t)row * D;
#pragma unroll
        for (int bj = 0; bj < 2; ++bj)
#pragma unroll
          for (int n = 0; n < 2; ++n) {
            const int oc = bcol + bj * 128 + wc * 32 + n * 16 + fq * 4;
            if (split) {
              *(f32x4*)((float*)(ws + W_PART) + ((size_t)ksi * SPLIT_ROWS + (row - SPLIT_ROW0)) * D + oc) = acc[ai][bj][m][n];
            } else {
              f32x4 x = unpack4(*(const u32x2*)(xr + oc));
              x += acc[ai][bj][m][n];
              if (first & 2) *(f32x4*)(xrow_ptr(p, row) + oc) = x;
              else { u32x2 o; o.x = cvt_pk_bf16(x[0], x[1]); o.y = cvt_pk_bf16(x[2], x[3]); *(u32x2*)(xr + oc) = o; }
            }
          }
      EPI_ROWS_END
    } else if (MODE == G_QKV) {
      bf16_t* qb = (bf16_t*)(ws + W_UB); float* kv = (float*)(ws + W_KVRAW); const float* rs = (const float*)(ws + W_RS);
      EPI_ROWS_BEGIN
        const float s = rsv[ai * 4 + m];
#pragma unroll
        for (int bj = 0; bj < 2; ++bj)
#pragma unroll
          for (int n = 0; n < 2; ++n) {
            const int oc = bcol + bj * 128 + wc * 32 + n * 16 + fq * 4;
            const f32x4 v = acc[ai][bj][m][n] * s;
            if (bcol < 1024) { u32x2 o; o.x = cvt_pk_bf16(v[0], v[1]); o.y = cvt_pk_bf16(v[2], v[3]); *(u32x2*)(qb + (size_t)row * D + oc) = o; }
            else *(f32x4*)(kv + (size_t)row * 512 + (oc - 1024)) = v;
          }
      EPI_ROWS_END
    } else if (MODE == G_S1) {
      float* sb = (float*)(ws + W_SB);
      EPI_ROWS_BEGIN
#pragma unroll
        for (int bj = 0; bj < 2; ++bj)
#pragma unroll
          for (int n = 0; n < 2; ++n) {
            const int oc = bcol + bj * 128 + wc * 32 + n * 16 + fq * 4;
            *(f32x4*)(sb + (size_t)row * 8192 + oc) = acc[ai][bj][m][n];
          }
      EPI_ROWS_END
    } else if (MODE == G_S3) {
      bf16_t* yg = (bf16_t*)(ws + W_YG);
      EPI_ROWS_BEGIN
        const bool valid = row < NCH && row != 1025;
        const int tr = chunk_row(row);
        if (valid) {
#pragma unroll
          for (int bj = 0; bj < 2; ++bj)
#pragma unroll
            for (int n = 0; n < 2; ++n) {
              const int t = bj * 8 + wc * 2 + n;
              const f32x4 v = acc[ai][bj][m][n];
              u32x2 o; o.x = cvt_pk_bf16(gelu_tanh(v[0]), gelu_tanh(v[1])); o.y = cvt_pk_bf16(gelu_tanh(v[2]), gelu_tanh(v[3]));
              *(u32x2*)(yg + (size_t)(tr + t) * D + pn * 16 + fq * 4) = o;
            }
        }
      EPI_ROWS_END
    }
}

template <int MODE>
__device__ __forceinline__ void gemm_phase(const Params& p, const bf16_t* A, int lda, const bf16_t* Bt, int N, int K, int first = 0) {
  const int nM = (MODE == G_S1 || MODE == G_S3) ? NCH_PAD / 256 : NTM, nN = N / 256, nt = K / BK;
  unsigned char* ws = p.ws;
  const int G = gdim_o(), ks = nt / 4, nsplit = (NTM - SPLIT_PM0) * nN * ks, nMw = (MODE == G_RESID) ? SPLIT_PM0 : nM;
  const int nfull_it = (nMw * nN + G - 1) / G;
#pragma unroll 1
  for (int it = 0;; ++it) {
    int pm, pn; bool split = false; int kt0 = 0, ntu = nt, ksi = 0;
    if (MODE == G_RESID && it >= nfull_it) {
      const int u = (it - nfull_it) * G + bid_o();
      if (u >= nsplit) break;
      ksi = u % ks; const int tq = u / ks; pn = tq % nN; pm = SPLIT_PM0 + tq / nN;
      split = true; kt0 = ksi * 4; ntu = 4;
    } else if (!tile_next(it, nMw, nN, pm, pn)) { if (MODE == G_RESID) continue; else break; }
    const int brow = pm * 256, bcol = pn * 256;
    float rsv[8];
    if (MODE == G_FFIN || MODE == G_QKV) {
      const int tid_ = tid_o(), wr_ = (tid_ >> 6) >> 2, fr_ = tid_ & 15;
      const float* rsp = (const float*)(ws + W_RS) + brow + wr_ * 64 + fr_;
#pragma unroll
      for (int q = 0; q < 8; ++q) rsv[q] = rsp[(q >> 2) * 128 + (q & 3) * 16];
    }
    acc_t acc;
    if (MODE == G_S1) { ARow af; af.init((const bf16_t*)(ws + W_UB) + pn * 512, 16384, brow); gemm_mainloop(acc, af, Bt, K, bcol, nt); }
    else if (MODE == G_S3) { AS3 af; af.init((const bf16_t*)(ws + W_UB), (const bf16_t*)(ws + W_HIN), brow, pn); gemm_mainloop(acc, af, Bt, K, bcol, nt); }
    else { ARow af; af.init(A + kt0 * BK, lda, brow); gemm_mainloop(acc, af, Bt + kt0 * BK, K, bcol, ntu); }
    gemm_epilogue<MODE>(p, acc, brow, bcol, pn, split, ksi, first, rsv);
    __builtin_amdgcn_s_barrier();
  }
}

template <int MODE>
__device__ __forceinline__ void gemm_phase_stream(const Params& p, const bf16_t* A, int lda, const bf16_t* Bt, int N, int K) {
  const int nM = NTM, nN = N / 256, nt = K / BK;
  unsigned char* ws = p.ws;
  LAS unsigned char* lds = (LAS unsigned char*)shm;
  const int tid = tid_o(), wid = __builtin_amdgcn_readfirstlane(tid >> 6), lane = tid & 63, wr = wid >> 2, wc = wid & 3, fr = lane & 15, fq = lane >> 4;
  unsigned voffA[2], voffB[2];
#pragma unroll
  for (int i = 0; i < 2; ++i) { int R, C; stage_rc(tid * 16 + i * 8192, R, C); voffA[i] = (unsigned)(R * lda + C) * 2u; voffB[i] = (unsigned)(R * K + C) * 2u; }
  const size_t kstep = (size_t)(BK * 2);
  const size_t hstepA = (size_t)HALF * lda * 2, hstepB = (size_t)HALF * K * 2;
  const unsigned ldsw = (unsigned)wid * 1024u;
  const int aoff = lds_byte(wr * 64 + fr, fq * 8), boff = lds_byte(wc * 32 + fr, fq * 8);
#define SA(b, h) (((b) * 2 + (h)) * HTB)
#define SB(b, h) ((4 + (b) * 2 + (h)) * HTB)
#define STG(bufoff, gbase, voff) do { _Pragma("unroll") for (int _i = 0; _i < 2; ++_i) \
    __builtin_amdgcn_global_load_lds((const unsigned*)((const char*)(gbase) + (voff)[_i]), (LAS unsigned*)(lds + (bufoff) + ldsw + _i * 8192), 16, 0, 0); } while (0)
  int cpm, cpn, npm, npn, ui = 0;
  if (!tile_next(0, nM, nN, cpm, cpn)) return;
  acc_t acc;
#pragma unroll
  for (int a = 0; a < 2; ++a)
#pragma unroll
    for (int b = 0; b < 2; ++b)
#pragma unroll
      for (int m = 0; m < 4; ++m)
#pragma unroll
        for (int n = 0; n < 2; ++n) acc[a][b][m][n] = (f32x4){0.f, 0.f, 0.f, 0.f};
  bf16x8 At[4][2], B0[2][2], B1[2][2];
  float rsv[8];
  const float* rsb = (const float*)(ws + W_RS) + wr * 64 + fr;
#pragma unroll
  for (int q = 0; q < 8; ++q) rsv[q] = rsb[cpm * 256 + (q >> 2) * 128 + (q & 3) * 16];
  const char* cA = (const char*)A + (size_t)cpm * 2 * hstepA; const char* cB = (const char*)Bt + (size_t)cpn * 2 * hstepB;
  STG(SB(0, 0), cB, voffB); STG(SB(0, 1), cB + hstepB, voffB); STG(SA(0, 0), cA, voffA); STG(SA(0, 1), cA + hstepA, voffA);
  if (wr == 1) BAR;
  WAIT_V(2); BAR;
  STG(SB(1, 0), cB + kstep, voffB); STG(SA(1, 0), cA + kstep, voffA); STG(SB(1, 1), cB + hstepB + kstep, voffB);
  WAIT_V(6); BAR;
#pragma unroll 1
  for (;;) {
    const bool has_next = tile_next(ui + 1, nM, nN, npm, npn);
    const char* nA = has_next ? (const char*)A + (size_t)npm * 2 * hstepA : cA; const char* nB = has_next ? (const char*)Bt + (size_t)npn * 2 * hstepB : cB;
#pragma unroll 1
    for (int t = 0; t < nt; t += 2) {
      const bool last = (t == nt - 2);
      const char* a1 = cA + (size_t)(t + 1) * kstep;
      const char* a2 = last ? nA : cA + (size_t)(t + 2) * kstep; const char* b2 = last ? nB : cB + (size_t)(t + 2) * kstep;
      const char* a3 = a2 + kstep; const char* b3 = b2 + kstep;
      LDB(B0, 0, 0); LDB(B1, 0, 1); SCHED; LDA(At, 0, 0); STG(SA(1, 1), a1 + hstepA, voffA);
      WAIT_V(8); WAIT_L(0); BAR; MMA(0, 0, At, B0); MMA(0, 1, At, B1); BAR; SCHED;
      LDA(At, 0, 1); STG(SB(0, 0), b2, voffB); STG(SB(0, 1), b2 + hstepB, voffB); STG(SA(0, 0), a2, voffA);
      WAIT_V(8); WAIT_L(0); BAR; MMA(1, 0, At, B0); MMA(1, 1, At, B1); BAR; SCHED;
      LDB(B0, 1, 0); LDB(B1, 1, 1); SCHED; LDA(At, 1, 0); STG(SA(0, 1), a2 + hstepA, voffA);
      WAIT_V(8); WAIT_L(0); BAR; MMA(0, 0, At, B0); MMA(0, 1, At, B1); BAR; SCHED;
      LDA(At, 1, 1); STG(SB(1, 0), b3, voffB); STG(SB(1, 1), b3 + hstepB, voffB); STG(SA(1, 0), a3, voffA);
      WAIT_V(8); WAIT_L(0); BAR; MMA(1, 0, At, B0); MMA(1, 1, At, B1); BAR; SCHED;
    }
    if (wr == 0) BAR;
    gemm_epilogue<MODE>(p, acc, cpm * 256, cpn * 256, cpn, false, 0, 0, rsv);
    if (!has_next) break;
#pragma unroll
    for (int a = 0; a < 2; ++a)
#pragma unroll
      for (int b = 0; b < 2; ++b)
#pragma unroll
        for (int m = 0; m < 4; ++m)
#pragma unroll
          for (int n = 0; n < 2; ++n) acc[a][b][m][n] = (f32x4){0.f, 0.f, 0.f, 0.f};
    cpm = npm; cpn = npn; cA = nA; cB = nB; ++ui;
#pragma unroll
    for (int q = 0; q < 8; ++q) rsv[q] = rsb[cpm * 256 + (q >> 2) * 128 + (q & 3) * 16];
    if (wr == 1) BAR;
  }
  WAIT_V(0);
  BAR;
#undef SA
#undef SB
#undef STG
}

__device__ __forceinline__ int perm32(int rho) { return 8 * ((rho & 15) >> 2) + 4 * (rho >> 4) + (rho & 3); }
__device__ __forceinline__ int srccol(int np, int mode, int Nh) {
  if (mode == 0) return np;
  const int t256 = np >> 8, r = np & 255, bj = r >> 7, r128 = r & 127, out = t256 * 128 + (r128 & ~31) + perm32(r128 & 31);
  return bj ? Nh + out : out;
}
__device__ __forceinline__ void transpose_tile(const float* W, int K, int N, bf16_t* Wt, int np0, int k0, int mode, int Nh, const float* gain) {
  float* tile = (float*)shm;
  const int tid = tid_o(), c4 = tid & 63, r0 = tid >> 6;
  const int sc = srccol(np0 + c4 * 4, mode, Nh);
  f32x4 v[8];
#pragma unroll
  for (int q = 0; q < 8; ++q) v[q] = *(const f32x4*)(W + (size_t)(k0 + r0 + q * 8) * N + sc);
#pragma unroll
  for (int q = 0; q < 8; ++q) { const int r = r0 + q * 8; const float g = gain ? gain[k0 + r] : 1.f; float* t = tile + r * 257 + c4 * 4; t[0] = v[q].x * g; t[1] = v[q].y * g; t[2] = v[q].z * g; t[3] = v[q].w * g; }
  __syncthreads();
#pragma unroll
  for (int q = 0; q < 4; ++q) {
    const int e = tid + q * 512, n = e & 255, ks = e >> 8;
    const float* s = tile + (ks * 8) * 257 + n;
    u32x4 o; o.x = cvt_pk_bf16(s[0], s[257]); o.y = cvt_pk_bf16(s[2 * 257], s[3 * 257]); o.z = cvt_pk_bf16(s[4 * 257], s[5 * 257]); o.w = cvt_pk_bf16(s[6 * 257], s[7 * 257]);
    *(u32x4*)(Wt + (size_t)(np0 + n) * K + k0 + ks * 8) = o;
  }
  __syncthreads();
}

__device__ __forceinline__ void weights_phase(const Params& p) {
  unsigned char* ws = p.ws;
  const int total = 2 * 128 + 4 * 352 + 4 * 176 + 64 + 32 + 64 + 2 * 64;
  unsigned* qctr = (unsigned*)(ws + W_BAR) + 3600;
  volatile LAS int* qslot = (volatile LAS int*)((LAS unsigned char*)shm + XB_LDS_OFF + 8);
  for (;;) {
    __syncthreads();
    if (tid_o() == 0) *qslot = (int)__hip_atomic_fetch_add(qctr, 1u, __ATOMIC_RELAXED, __HIP_MEMORY_SCOPE_AGENT);
    __syncthreads();
    const int t = *qslot;
    if (t >= total) break;
    int r = t; const float* W; int K, N, mode = 0, Nh = 0; const float* gain = nullptr; bf16_t* dst;
    if (r < 256) { const int l = r / 128; r -= l * 128; W = p.in[17] + (size_t)l * 1024 * 2048; K = 1024; N = 2048; mode = 1; Nh = 1024; dst = (bf16_t*)(ws + W_WGLU) + (size_t)l * 2048 * 1024; }
    else if ((r -= 256) < 1408) { const int l = r / 352; r -= l * 352; W = p.in[18] + (size_t)l * 1024 * 5632; K = 1024; N = 5632; mode = 1; Nh = FF; gain = p.in[8] + l * D; dst = (bf16_t*)(ws + W_WIN) + (size_t)l * 5632 * 1024; }
    else if ((r -= 1408) < 704) { const int l = r / 176; r -= l * 176; W = p.in[19] + (size_t)l * FF * 1024; K = FF; N = 1024; dst = (bf16_t*)(ws + W_WOUT) + (size_t)l * 1024 * FF; }
    else if ((r -= 704) < 64) { W = p.in[23]; K = 1024; N = 1024; gain = p.in[7] + 2 * D; dst = (bf16_t*)(ws + W_WQKV); }
    else if ((r -= 64) < 32) { W = p.in[21]; K = 1024; N = 512; gain = p.in[20]; dst = (bf16_t*)(ws + W_WQKV) + (size_t)1024 * 1024; }
    else if ((r -= 32) < 64) { W = p.in[23] + (size_t)1024 * 1024; K = 1024; N = 1024; gain = p.in[7] + 3 * D; dst = (bf16_t*)(ws + W_WQKV) + (size_t)1536 * 1024; }
    else { r -= 64; const int l = r / 64; r -= l * 64; W = p.in[26] + (size_t)l * 1024 * 1024; K = 1024; N = 1024; dst = (bf16_t*)(ws + W_WO) + (size_t)l * 1024 * 1024; }
    const int nkt = K / 64, kt = r % nkt, nb = r / nkt;
    transpose_tile(W, K, N, dst, nb * 256, kt * 64, mode, Nh, gain);
  }
}

__device__ __forceinline__ void s5_matrices(const Params& p, int l, int g) {
  float* L = (float*)shm;
  float* apr = L;
  float* api = apr + 64 * 17;
  float* bbr = api + 64 * 17;
  float* bbi = bbr + 1024;
  float* ccr = bbi + 1024;
  float* cci = ccr + 1024;
  float* fre = cci + 1024;
  float* fim = fre + 64;
  float* Kv = fim + 64;
  const int tid = tid_o();
  unsigned char* ws = p.ws;
  const size_t lg = (size_t)l * 64 + g;
  if (tid < 64) {
    const int pp = tid;
    const double dt = exp((double)p.in[11][lg]);
    const double are = p.in[9][lg * 64 + pp], aim = p.in[10][lg * 64 + pp];
    const double mg = exp(are * dt), an = aim * dt, br = mg * cos(an), bi = mg * sin(an);
    { double pr = 1.0, pi = 0.0;
      for (int j = 0; j <= 16; ++j) { apr[pp * 17 + j] = (float)pr; api[pp * 17 + j] = (float)pi; const double t = pr * br - pi * bi; pi = pr * bi + pi * br; pr = t; } }
    const double nr = br - 1.0, ni = bi, inv = 1.0 / (are * are + aim * aim);
    fre[pp] = (float)((nr * are + ni * aim) * inv); fim[pp] = (float)((ni * are - nr * aim) * inv);
    float* a16 = (float*)(ws + W_A16) + (lg * 64 + pp) * 2;
    a16[0] = apr[pp * 17 + 16]; a16[1] = api[pp * 17 + 16];
  }
  __syncthreads();
  for (int e = tid; e < 1024; e += 512) {
    const int pp = e >> 4;
    const float br = p.in[12][lg * 1024 + e], bi = p.in[13][lg * 1024 + e];
    bbr[e] = fre[pp] * br - fim[pp] * bi; bbi[e] = fre[pp] * bi + fim[pp] * br;
    ccr[e] = p.in[14][lg * 1024 + e]; cci[e] = p.in[15][lg * 1024 + e];
  }
  __syncthreads();
  for (int e = tid; e < 4096; e += 512) {
    const int j = e >> 8, cp = (e >> 4) & 15, c = e & 15;
    float s = 0.f;
    for (int pp = 0; pp < 64; ++pp) {
      const float xr = ccr[cp * 64 + pp] * apr[pp * 17 + j] - cci[cp * 64 + pp] * api[pp * 17 + j];
      const float xi = ccr[cp * 64 + pp] * api[pp * 17 + j] + cci[cp * 64 + pp] * apr[pp * 17 + j];
      s += xr * bbr[pp * 16 + c] - xi * bbi[pp * 16 + c];
    }
    if (j == 0 && cp == c) s += p.in[16][lg * 16 + c];
    Kv[e] = s;
  }
  __syncthreads();
  bf16_t* bs3 = (bf16_t*)(ws + W_BS3) + ((size_t)l * 16384 + (size_t)g * 256) * 384;
  for (int e = tid; e < 256 * 48; e += 512) {
    const int n = e / 48, k8 = e % 48, t = n >> 4, cp = n & 15;
    float v[8];
    if (k8 < 32) {
      const int s = k8 >> 1, c0 = (k8 & 1) * 8;
#pragma unroll
      for (int i = 0; i < 8; ++i) v[i] = (s <= t) ? Kv[((t - s) * 16 + cp) * 16 + c0 + i] : 0.f;
    } else {
      const int kk = (k8 - 32) * 8;
#pragma unroll
      for (int i = 0; i < 8; ++i) {
        const int q = kk + i, pp = q & 63;
        const float cr = ccr[cp * 64 + pp], ci = cci[cp * 64 + pp], ar = apr[pp * 17 + t + 1], ai = api[pp * 17 + t + 1];
        v[i] = q < 64 ? (cr * ar - ci * ai) : -(cr * ai + ci * ar);
      }
    }
    u32x4 o; o.x = cvt_pk_bf16(v[0], v[1]); o.y = cvt_pk_bf16(v[2], v[3]); o.z = cvt_pk_bf16(v[4], v[5]); o.w = cvt_pk_bf16(v[6], v[7]);
    *(u32x4*)(bs3 + (size_t)n * 384 + k8 * 8) = o;
  }
  bf16_t* bs1 = (bf16_t*)(ws + W_BS1) + ((size_t)l * 8192 + (size_t)(g >> 1) * 256 + (g & 1) * 128) * 512;
  for (int e = tid; e < 128 * 64; e += 512) {
    const int jn = e >> 6, k8 = e & 63, k = k8 * 8, pp = jn & 63;
    float v[8];
    if ((k >> 8) == (g & 1)) {
      const int s = (k & 255) >> 4, c0 = k & 15;
      const float ar = apr[pp * 17 + 15 - s], ai = api[pp * 17 + 15 - s];
#pragma unroll
      for (int i = 0; i < 8; ++i) {
        const float br = bbr[pp * 16 + c0 + i], bi = bbi[pp * 16 + c0 + i];
        v[i] = jn < 64 ? (ar * br - ai * bi) : (ar * bi + ai * br);
      }
    } else {
#pragma unroll
      for (int i = 0; i < 8; ++i) v[i] = 0.f;
    }
    u32x4 o; o.x = cvt_pk_bf16(v[0], v[1]); o.y = cvt_pk_bf16(v[2], v[3]); o.z = cvt_pk_bf16(v[4], v[5]); o.w = cvt_pk_bf16(v[6], v[7]);
    *(u32x4*)(bs1 + (size_t)jn * 512 + k) = o;
  }
  __syncthreads();
}

__device__ __forceinline__ size_t kf_off(int krow, int kvh, int kk, int hh) { return ((((size_t)(krow >> 5) * 4 + kvh) * 4 + kk) * 64 + hh * 32 + (krow & 31)) * 8; }
__device__ __forceinline__ size_t vf_off(int krow, int kvh, int d) {
  const int kin = krow & 15, hh = (kin >> 2) & 1, j = (kin >> 3) * 4 + (kin & 3);
  return ((((size_t)(krow >> 4) * 4 + kvh) * 2 + (d >> 5)) * 64 + hh * 32 + (d & 31)) * 8 + j;
}
__device__ __forceinline__ void cache_phase(const Params& p) {
  unsigned char* ws = p.ws;
  bf16_t* kb = (bf16_t*)(ws + W_KB); bf16_t* vt = (bf16_t*)(ws + W_VT);
  const int gt = bid_o() * 512 + tid_o(), nth = gdim_o() * 512;
  for (int e = gt; e < 32 * 128 * 32; e += nth) {
    const int i = e / (128 * 32), w = (e / 32) % 128, c8 = e % 32, kvh = c8 >> 3, d0 = (c8 & 7) * 8;
    const int krow = KS_BASE + i * 160 + w;
    const float* s = p.in[4] + ((size_t)i * 128 + w) * 256 + c8 * 8;
    const f32x4 a = *(const f32x4*)s, b = *(const f32x4*)(s + 4);
    u32x4 o; o.x = cvt_pk_bf16(a.x, a.y); o.y = cvt_pk_bf16(a.z, a.w); o.z = cvt_pk_bf16(b.x, b.y); o.w = cvt_pk_bf16(b.z, b.w);
    *(u32x4*)(kb + kf_off(krow, kvh, d0 >> 4, (d0 >> 3) & 1)) = o;
  }
  for (int e = gt; e < 32 * 128 * 256; e += nth) {
    const int i = e / (128 * 256), w = (e / 256) % 128, c = e % 256;
    vt[vf_off(KS_BASE + i * 160 + w, c >> 6, c & 63)] = f2bf(p.in[5][e]);
  }
}

template <int MODE>
__device__ __forceinline__ void norm_phase(const Params& p, const float* gain, int nks) {
  unsigned char* ws = p.ws;
  const int lane = tid_o() & 63, wv = tid_o() >> 6;
  bf16_t* ub = (bf16_t*)(ws + W_UB); float* rs = (float*)(ws + W_RS);
  if (MODE == 2) {
    const bf16_t* xb = (const bf16_t*)(ws + W_XB);
    for (int row = (bid_o() * 8 + wv) * 4; row < SPLIT_ROW0; row += gdim_o() * 32) {
      u32x2 raw[4][4];
#pragma unroll
      for (int q = 0; q < 4; ++q)
#pragma unroll
        for (int j = 0; j < 4; ++j) raw[q][j] = *(const u32x2*)(xb + (size_t)(row + q) * D + (lane + 64 * j) * 4);
#pragma unroll
      for (int q = 0; q < 4; ++q) {
        float s = 0.f;
#pragma unroll
        for (int j = 0; j < 4; ++j) { const f32x4 v = unpack4(raw[q][j]); s += (v.x * v.x + v.y * v.y) + (v.z * v.z + v.w * v.w); }
        const float r = rsqrtf(wave_sum(s, lane) * (1.f / D) + 1e-6f);
        if (lane == 0) rs[row + q] = r;
      }
    }
  }
  for (int row = ((MODE == 3 || MODE == 2) ? SPLIT_ROW0 : 0) + bid_o() * 8 + wv; row < R_PAD; row += gdim_o() * 8) {
    float* xr = xrow_ptr(p, row);
    f32x4 v[4];
    if (MODE == 0) {
      const float* src = xsrc_ptr(p, row);
#pragma unroll
      for (int j = 0; j < 4; ++j) v[j] = src ? *(const f32x4*)(src + (lane + 64 * j) * 4) : (f32x4){0.f, 0.f, 0.f, 0.f};
    } else {
      bf16_t* xbr = (bf16_t*)(ws + W_XB) + (size_t)row * D;
#pragma unroll
      for (int j = 0; j < 4; ++j) v[j] = unpack4(*(const u32x2*)(xbr + (lane + 64 * j) * 4));
      if (nks > 0 && row >= SPLIT_ROW0) {
        const float* pp = (const float*)(ws + W_PART) + (size_t)(row - SPLIT_ROW0) * D + lane * 4;
        for (int k = 0; k < nks; k += 4) {
          f32x4 t[4][4];
#pragma unroll
          for (int kk = 0; kk < 4; ++kk)
#pragma unroll
            for (int j = 0; j < 4; ++j) t[kk][j] = (k + kk < nks) ? *(const f32x4*)(pp + (size_t)(k + kk) * SPLIT_ROWS * D + 256 * j) : (f32x4){0.f, 0.f, 0.f, 0.f};
#pragma unroll
          for (int kk = 0; kk < 4; ++kk)
#pragma unroll
            for (int j = 0; j < 4; ++j) v[j] += t[kk][j];
        }
        if (MODE == 3) {
#pragma unroll
          for (int j = 0; j < 4; ++j) *(f32x4*)(xr + (lane + 64 * j) * 4) = v[j];
        } else {
#pragma unroll
          for (int j = 0; j < 4; ++j) { u32x2 o; o.x = cvt_pk_bf16(v[j].x, v[j].y); o.y = cvt_pk_bf16(v[j].z, v[j].w); *(u32x2*)(xbr + (lane + 64 * j) * 4) = o; }
        }
      }
    }
    if (MODE == 3) continue;
    float s = 0.f;
#pragma unroll
    for (int j = 0; j < 4; ++j) s += (v[j].x * v[j].x + v[j].y * v[j].y) + (v[j].z * v[j].z + v[j].w * v[j].w);
    const float r = rsqrtf(wave_sum(s, lane) * (1.f / D) + 1e-6f);
    if (MODE == 2) {
      if (lane == 0) rs[row] = r;
    }
    else {
#pragma unroll
      for (int j = 0; j < 4; ++j) {
        const f32x4 gg = *(const f32x4*)(gain + (lane + 64 * j) * 4);
        u32x2 o; o.x = cvt_pk_bf16(v[j].x * r * gg.x, v[j].y * r * gg.y); o.y = cvt_pk_bf16(v[j].z * r * gg.z, v[j].w * r * gg.w);
        const int col0 = (lane + 64 * j) * 4;
        if (row < R_REAL) {
          int cgi, s_;
          if (row < R_SAMPLE) { const int b_ = row >> 14, t = row & 16383; cgi = b_ * 1025 + 1 + (t >> 4); s_ = t & 15; }
          else if (row < R_META) { const int q = row - R_SAMPLE; cgi = 2050 + (q >> 4); s_ = q & 15; }
          else { cgi = 0; s_ = row - R_META; }
          const size_t off = (size_t)cgi * 16384 + (col0 >> 4) * 256 + s_ * 16 + (col0 & 15);
          *(u32x2*)(ub + off) = o;
          if (row >= R_META) *(u32x2*)(ub + off + (size_t)1025 * 16384) = o;
        }
      }
    }
  }
}

__device__ __forceinline__ void s2_phase(const Params& p, int l) {
  unsigned char* ws = p.ws;
  const float* sb = (const float*)(ws + W_SB); bf16_t* hin = (bf16_t*)(ws + W_HIN);
  const int lane = tid_o() & 63, wv = tid_o() >> 6;
  float* ex = (float*)shm;
  constexpr int SEG = 129;
  for (int item = bid_o(); item < 128; item += gdim_o()) {
    const int b = item >> 6, g = item & 63;
    const float* a16 = (const float*)(ws + W_A16) + (((size_t)l * 64 + g) * 64 + lane) * 2;
    const float ar = a16[0], ai = a16[1];
    const int c0 = wv * SEG, c1 = (c0 + SEG) < 1025 ? (c0 + SEG) : 1025;
    const float* sp = sb + (size_t)(b * 1025) * 8192 + g * 128 + lane;
    bf16_t* hp = hin + (size_t)(b * 1025) * 8192 + g * 128 + lane;
    float hr = 0.f, hi = 0.f;
    {
      int c = c0;
      float sr[8], si[8], pr[8], pi[8];
      if (c + 8 <= c1) {
#pragma unroll
        for (int u = 0; u < 8; ++u) { sr[u] = sp[(size_t)(c + u) * 8192]; si[u] = sp[(size_t)(c + u) * 8192 + 64]; }
      }
      for (; c + 8 <= c1; c += 8) {
        const bool more = c + 16 <= c1;
        if (more) {
#pragma unroll
          for (int u = 0; u < 8; ++u) { pr[u] = sp[(size_t)(c + 8 + u) * 8192]; pi[u] = sp[(size_t)(c + 8 + u) * 8192 + 64]; }
        }
#pragma unroll
        for (int u = 0; u < 8; ++u) { const float nr = ar * hr - ai * hi + sr[u], ni = ar * hi + ai * hr + si[u]; hr = nr; hi = ni; }
#pragma unroll
        for (int u = 0; u < 8; ++u) { sr[u] = pr[u]; si[u] = pi[u]; }
      }
      for (; c < c1; ++c) { const float sr = sp[(size_t)c * 8192], si = sp[(size_t)c * 8192 + 64]; const float nr = ar * hr - ai * hi + sr, ni = ar * hi + ai * hr + si; hr = nr; hi = ni; }
    }
    ex[(wv * 2) * 64 + lane] = hr; ex[(wv * 2 + 1) * 64 + lane] = hi;
    float qr = ar, qi = ai;
#pragma unroll
    for (int s = 0; s < 7; ++s) { const float t = qr * qr - qi * qi; qi = 2.f * qr * qi; qr = t; }
    { const float t = qr * ar - qi * ai; qi = qr * ai + qi * ar; qr = t; }
    __syncthreads();
    hr = 0.f; hi = 0.f;
    for (int j = 0; j < wv; ++j) { const float er = ex[(j * 2) * 64 + lane], ei = ex[(j * 2 + 1) * 64 + lane]; const float nr = qr * hr - qi * hi + er, ni = qr * hi + qi * hr + ei; hr = nr; hi = ni; }
    {
      int c = c0;
      float sr[8], si[8], pr[8], pi[8];
      if (c + 8 <= c1) {
#pragma unroll
        for (int u = 0; u < 8; ++u) { sr[u] = sp[(size_t)(c + u) * 8192]; si[u] = sp[(size_t)(c + u) * 8192 + 64]; }
      }
      for (; c + 8 <= c1; c += 8) {
        const bool more = c + 16 <= c1;
        if (more) {
#pragma unroll
          for (int u = 0; u < 8; ++u) { pr[u] = sp[(size_t)(c + 8 + u) * 8192]; pi[u] = sp[(size_t)(c + 8 + u) * 8192 + 64]; }
        }
#pragma unroll
        for (int u = 0; u < 8; ++u) {
          hp[(size_t)(c + u) * 8192] = f2bf(hr); hp[(size_t)(c + u) * 8192 + 64] = f2bf(hi);
          const float nr = ar * hr - ai * hi + sr[u], ni = ar * hi + ai * hr + si[u]; hr = nr; hi = ni;
        }
#pragma unroll
        for (int u = 0; u < 8; ++u) { sr[u] = pr[u]; si[u] = pi[u]; }
      }
      for (; c < c1; ++c) {
        const float sr = sp[(size_t)c * 8192], si = sp[(size_t)c * 8192 + 64];
        hp[(size_t)c * 8192] = f2bf(hr); hp[(size_t)c * 8192 + 64] = f2bf(hi);
        const float nr = ar * hr - ai * hi + sr, ni = ar * hi + ai * hr + si; hr = nr; hi = ni;
      }
    }
    if (wv == 7) {
      p.out[O_PRE + (((size_t)l * NB + b) * 64 + g) * 64 + lane] = hr; p.out[O_PIM + (((size_t)l * NB + b) * 64 + g) * 64 + lane] = hi;
    }
    __syncthreads();
  }
  for (int q = bid_o() * 8 + wv; q < 2048; q += gdim_o() * 8) {
    const int i = q >> 6, g = q & 63, c0 = 2050 + 2 * i;
    const size_t so = (((size_t)l * DB + i) * 64 + g) * 64 + lane;
    float hr = p.in[2][so], hi = p.in[3][so];
    const float* a16 = (const float*)(ws + W_A16) + (((size_t)l * 64 + g) * 64 + lane) * 2;
    const float ar = a16[0], ai = a16[1];
    const float* sp = sb + (size_t)c0 * 8192 + g * 128 + lane;
    bf16_t* hp = hin + (size_t)c0 * 8192 + g * 128 + lane;
#pragma unroll
    for (int c = 0; c < 2; ++c) {
      const float sr = sp[(size_t)c * 8192], si = sp[(size_t)c * 8192 + 64];
      hp[(size_t)c * 8192] = f2bf(hr); hp[(size_t)c * 8192 + 64] = f2bf(hi);
      const float nr = ar * hr - ai * hi + sr, ni = ar * hi + ai * hr + si; hr = nr; hi = ni;
    }
    p.out[O_SRE + so] = hr; p.out[O_SIM + so] = hi;
  }
}

__device__ __forceinline__ void v_step_store(bf16_t* vt, int S, const float* vsrc, size_t vstride, int lane) {
  const int hh = lane >> 5, dl = lane & 31;
#pragma unroll
  for (int kvh = 0; kvh < 4; ++kvh)
#pragma unroll
    for (int dt = 0; dt < 2; ++dt) {
      float v[8];
#pragma unroll
      for (int j = 0; j < 8; ++j) v[j] = vsrc[(size_t)(8 * (j >> 2) + 4 * hh + (j & 3)) * vstride + kvh * 64 + dt * 32 + dl];
      u32x4 o; o.x = cvt_pk_bf16(v[0], v[1]); o.y = cvt_pk_bf16(v[2], v[3]); o.z = cvt_pk_bf16(v[4], v[5]); o.w = cvt_pk_bf16(v[6], v[7]);
      *(u32x4*)(vt + ((((size_t)S * 4 + kvh) * 2 + dt) * 64 + lane) * 8) = o;
    }
}

__device__ __forceinline__ void kvfin_phase(const Params& p) {
  unsigned char* ws = p.ws;
  const float* kv = (const float*)(ws + W_KVRAW); bf16_t* kb = (bf16_t*)(ws + W_KB); bf16_t* vt = (bf16_t*)(ws + W_VT);
  const int lane = tid_o() & 63, wv = tid_o() >> 6;
  for (int row = bid_o() * 8 + wv; row < R_REAL; row += gdim_o() * 8) {
    const float* src = kv + (size_t)row * 512 + lane * 8;
    const f32x4 a = *(const f32x4*)src, b = *(const f32x4*)(src + 4);
    float v[8] = {a.x, a.y, a.z, a.w, b.x, b.y, b.z, b.w};
    const int col = (lane & 31) * 8, kvh = col >> 6, d0 = col & 63;
    int krow; float* ok = nullptr; float* ov = nullptr;
    if (row < R_SAMPLE) { const int b_ = row >> 14, t = row & 16383; krow = row;
      if (t >= SEQ - 128) { ok = p.out + O_PK + ((size_t)b_ * 128 + (t - (SEQ - 128))) * 256; ov = p.out + O_PV + ((size_t)b_ * 128 + (t - (SEQ - 128))) * 256; } }
    else if (row < R_META) { const int q = row - R_SAMPLE, i = q >> 5, j = q & 31; krow = KS_BASE + i * 160 + 128 + j;
      ok = p.out + O_SK + (size_t)q * 256; ov = p.out + O_SV + (size_t)q * 256; }
    else { krow = KM_BASE + (row - R_META); }
    if (lane < 32) {
      float s = 0.f;
#pragma unroll
      for (int i = 0; i < 8; ++i) s += v[i] * v[i];
      s += shx(s, 1, lane); s += shx(s, 2, lane); s += shx(s, 4, lane);
      const float r = rsqrtf(s * (1.f / 64.f) + 1e-6f);
#pragma unroll
      for (int i = 0; i < 8; ++i) v[i] = v[i] * r * p.in[22][d0 + i];
      u32x4 o; o.x = cvt_pk_bf16(v[0], v[1]); o.y = cvt_pk_bf16(v[2], v[3]); o.z = cvt_pk_bf16(v[4], v[5]); o.w = cvt_pk_bf16(v[6], v[7]);
      *(u32x4*)(kb + kf_off(krow, kvh, d0 >> 4, (d0 >> 3) & 1)) = o;
      if (ok) { *(f32x4*)(ok + col) = (f32x4){v[0], v[1], v[2], v[3]}; *(f32x4*)(ok + col + 4) = (f32x4){v[4], v[5], v[6], v[7]}; }
    } else {
      float s = 0.f; s += shx(s, 1, lane); s += shx(s, 2, lane); s += shx(s, 4, lane);
#pragma unroll
      for (int i = 0; i < 8; ++i) (void)v[i];
      if (ov) { *(f32x4*)(ov + col) = (f32x4){v[0], v[1], v[2], v[3]}; *(f32x4*)(ov + col + 4) = (f32x4){v[4], v[5], v[6], v[7]}; }
    }
  }
  for (int item = bid_o() * 8 + wv; item < 2048 + 64 + 1; item += gdim_o() * 8) {
    int S, row0;
    if (item < 2048) { S = item; row0 = item * 16; }
    else if (item < 2112) { const int q = item - 2048, i = q >> 1, s = q & 1; S = ((KS_BASE + i * 160 + 128) >> 4) + s; row0 = R_SAMPLE + i * 32 + s * 16; }
    else { S = KM_BASE >> 4; row0 = R_META; }
    v_step_store(vt, S, kv + (size_t)row0 * 512 + 256, 512, lane);
  }
}

__device__ __forceinline__ int rel_bucket(int rel) {
  const int n = rel < 0 ? -rel : rel;
  const float nf = (float)(n < 1 ? 1 : n);
  int large = 8 + (int)(logf(nf / 8.f) / 2.772588722239781f * 8.f);
  large = large < 15 ? large : 15;
  return (rel > 0 ? 16 : 0) + (n < 8 ? n : large);
}

struct AttnItem { int kvh, nt_band, ktile0, sj0, tpos, qrow0, qi0, head; bool active; };
__device__ __forceinline__ AttnItem attn_item(int item, int wv) {
  AttnItem a;
  if (item < 2048) {
    const int b = item >> 10, n = (item >> 2) & 255; a.kvh = item & 3; a.head = a.kvh * 4 + (wv >> 1); const int qt = wv & 1;
    a.qi0 = qt * 32; a.qrow0 = b * SEQ + n * 64 + a.qi0; a.tpos = n * 64 + a.qi0;
    const int c0 = n >= 2 ? n - 2 : 0;
    a.nt_band = (n - c0 + 1) * 2;
    a.ktile0 = (b * SEQ + c0 * 64) >> 5;
    a.sj0 = n >= 2 ? 0 : (2 - n) * 64; a.active = true;
  } else {
    const int q = item - 2048, i = q >> 2; a.kvh = q & 3; a.head = a.kvh * 4 + (wv & 3); a.active = wv < 4;
    a.qi0 = 0; a.qrow0 = R_SAMPLE + i * 32; a.tpos = 1024; a.nt_band = 5;
    a.ktile0 = (KS_BASE + i * 160) >> 5; a.sj0 = 0;
  }
  return a;
}
constexpr int AT_BUF0 = 16896, AT_KV = 28672, AT_BUF = 2 * AT_KV;
__device__ __forceinline__ void attn_stage(const bf16_t* kb, const bf16_t* vt, int item, int buf, int wv, int lane) {
  const AttnItem a = attn_item(item, 0);
  LAS unsigned char* lds = (LAS unsigned char*)shm + AT_BUF0 + buf * AT_BUF;
#pragma unroll
  for (int t = 0; t < 7; ++t) {
    if (t <= a.nt_band) {
      const int T = t == 0 ? (KM_BASE >> 5) : a.ktile0 + (t - 1);
      const bf16_t* src; unsigned dst;
      if (wv < 4) { src = kb + ((((size_t)T * 4 + a.kvh) * 4 + wv) * 64 + lane) * 8; dst = t * 4096 + wv * 1024; }
      else { const int s = (wv - 4) >> 1, dt = (wv - 4) & 1; src = vt + (((((size_t)T * 2 + s) * 4 + a.kvh) * 2 + dt) * 64 + lane) * 8; dst = AT_KV + t * 4096 + (wv - 4) * 1024; }
      __builtin_amdgcn_global_load_lds((const unsigned*)src, (LAS unsigned*)(lds + dst), 16, 0, 0);
    }
  }
}

__device__ __forceinline__ void attn_phase(const Params& p, int jl) {
  unsigned char* ws = p.ws;
  float* lut = (float*)shm;
  float* qg = lut + 16 * 256;
  for (int e = tid_o(); e < 16 * 256; e += 512) {
    const int h = e >> 8, idx = e & 255; const int rel = idx - 191;
    lut[e] = idx < 255 ? p.in[27][rel_bucket(rel) * 16 + h] * 1.44269504089f : 0.f;
  }
  if (tid_o() < 64) qg[tid_o()] = p.in[24][jl * 64 + tid_o()] * (0.125f * 1.44269504089f);
  const bf16_t* qb = (const bf16_t*)(ws + W_UB); const bf16_t* kb = (const bf16_t*)(ws + W_KB); const bf16_t* vt = (const bf16_t*)(ws + W_VT);
  bf16_t* ao = (bf16_t*)(ws + W_YG);
  const int tid = tid_o(), lane = tid & 63, wv = __builtin_amdgcn_readfirstlane(tid >> 6), ql = lane & 31, hh = lane >> 5;
  const int G = gdim_o(), item0 = bid_o(), NITEM = 2048 + 128;
  u32x4 qraw[4];
  if (item0 < NITEM) {
    attn_stage(kb, vt, item0, 0, wv, lane);
    const AttnItem a = attn_item(item0, wv);
    const bf16_t* qp = qb + (size_t)(a.qrow0 + ql) * D + a.head * 64 + hh * 8;
#pragma unroll
    for (int kk = 0; kk < 4; ++kk) qraw[kk] = *(const u32x4*)(qp + kk * 16);
  }
  int cur = 0;
#pragma unroll 1
  for (int item = item0; item < NITEM; item += G, cur ^= 1) {
    asm volatile("s_waitcnt vmcnt(0)" ::: "memory");
    __syncthreads();
    const AttnItem a = attn_item(item, wv);
    u32x4 qcur[4];
#pragma unroll
    for (int kk = 0; kk < 4; ++kk) qcur[kk] = qraw[kk];
    if (item + G < NITEM) {
      attn_stage(kb, vt, item + G, cur ^ 1, wv, lane);
      const AttnItem an = attn_item(item + G, wv);
      const bf16_t* qp = qb + (size_t)(an.qrow0 + ql) * D + an.head * 64 + hh * 8;
#pragma unroll
      for (int kk = 0; kk < 4; ++kk) qraw[kk] = *(const u32x4*)(qp + kk * 16);
    }
    if (!a.active) continue;
    const int head = a.head, nt_band = a.nt_band, sj0 = a.sj0, qi0 = a.qi0, tpos = a.tpos, qrow0 = a.qrow0;
    const LAS unsigned char* kl = (const LAS unsigned char*)shm + AT_BUF0 + cur * AT_BUF + lane * 16;
    bf16x8 qf[4];
    {
      float qv[32]; float s = 0.f;
#pragma unroll
      for (int kk = 0; kk < 4; ++kk) {
        const unsigned w[4] = {qcur[kk].x, qcur[kk].y, qcur[kk].z, qcur[kk].w};
#pragma unroll
        for (int i = 0; i < 4; ++i) { qv[kk * 8 + 2 * i] = bf2f(w[i] & 0xffffu); qv[kk * 8 + 2 * i + 1] = bf2f(w[i] >> 16); }
      }
#pragma unroll
      for (int i = 0; i < 32; ++i) s += qv[i] * qv[i];
      s += shx(s, 32, lane);
      const float r = rsqrtf(s * (1.f / 64.f) + 1e-6f);
#pragma unroll
      for (int kk = 0; kk < 4; ++kk) {
        u32x4 o; const float* g8 = qg + kk * 16 + hh * 8;
        o.x = cvt_pk_bf16(qv[kk * 8 + 0] * r * g8[0], qv[kk * 8 + 1] * r * g8[1]); o.y = cvt_pk_bf16(qv[kk * 8 + 2] * r * g8[2], qv[kk * 8 + 3] * r * g8[3]);
        o.z = cvt_pk_bf16(qv[kk * 8 + 4] * r * g8[4], qv[kk * 8 + 5] * r * g8[5]); o.w = cvt_pk_bf16(qv[kk * 8 + 6] * r * g8[6], qv[kk * 8 + 7] * r * g8[7]);
        qf[kk] = __builtin_bit_cast(bf16x8, o);
      }
    }
    f32x16 sc[7];
#pragma unroll
    for (int t = 0; t < 7; ++t) {
      if (t <= nt_band) {
        f32x16 a_ = {0.f, 0.f, 0.f, 0.f, 0.f, 0.f, 0.f, 0.f, 0.f, 0.f, 0.f, 0.f, 0.f, 0.f, 0.f, 0.f};
#pragma unroll
        for (int kk = 0; kk < 4; ++kk) {
          const bf16x8 kf = *(const LAS bf16x8*)(kl + t * 4096 + kk * 1024);
          a_ = __builtin_amdgcn_mfma_f32_32x32x16_bf16(kf, qf[kk], a_, 0, 0, 0);
        }
        sc[t] = a_;
      }
    }
    const float sink = p.in[25][jl * 16 + head] * 1.44269504089f;
    const float* lh = lut + head * 256 + 191;
    float mx = sink;
    const int qi = qi0 + ql;
#pragma unroll
    for (int t = 0; t < 7; ++t) {
      if (t <= nt_band) {
#pragma unroll
        for (int r = 0; r < 16; ++r) {
          const int key = 8 * (r >> 2) + 4 * hh + (r & 3);
          float v;
          if (t == 0) {
            if (r < 8) { int rel = key - 16 - (tpos + ql); rel = rel < -191 ? -191 : rel; v = sc[t][r] + lh[rel]; } else v = -1e30f;
          } else {
            const int rel = sj0 + (t - 1) * 32 + key - 128 - qi;
            v = sc[t][r] + lh[rel];
          }
          sc[t][r] = v; mx = fmaxf(mx, v);
        }
      }
    }
    mx = fmaxf(mx, shx(mx, 32, lane));
    float sum = 0.f;
#pragma unroll
    for (int t = 0; t < 7; ++t) {
      if (t <= nt_band) {
#pragma unroll
        for (int r = 0; r < 16; ++r) { const float e = __builtin_amdgcn_exp2f(sc[t][r] - mx); sc[t][r] = e; sum += e; }
      }
    }
    sum += shx(sum, 32, lane);
    const float inv = 1.f / (sum + __builtin_amdgcn_exp2f(sink - mx));
    f32x16 o0 = {0.f, 0.f, 0.f, 0.f, 0.f, 0.f, 0.f, 0.f, 0.f, 0.f, 0.f, 0.f, 0.f, 0.f, 0.f, 0.f}, o1 = o0;
#pragma unroll
    for (int t = 0; t < 7; ++t) {
      if (t <= nt_band) {
#pragma unroll
        for (int s = 0; s < 2; ++s) {
          if (t == 0 && s == 1) continue;
          u32x4 pa; pa.x = cvt_pk_bf16(sc[t][8 * s + 0] * inv, sc[t][8 * s + 1] * inv); pa.y = cvt_pk_bf16(sc[t][8 * s + 2] * inv, sc[t][8 * s + 3] * inv);
          pa.z = cvt_pk_bf16(sc[t][8 * s + 4] * inv, sc[t][8 * s + 5] * inv); pa.w = cvt_pk_bf16(sc[t][8 * s + 6] * inv, sc[t][8 * s + 7] * inv);
          const bf16x8 pf = __builtin_bit_cast(bf16x8, pa);
          const bf16x8 b0 = *(const LAS bf16x8*)(kl + AT_KV + t * 4096 + s * 2048), b1 = *(const LAS bf16x8*)(kl + AT_KV + t * 4096 + s * 2048 + 1024);
          o0 = __builtin_amdgcn_mfma_f32_32x32x16_bf16(pf, b0, o0, 0, 0, 0);
          o1 = __builtin_amdgcn_mfma_f32_32x32x16_bf16(pf, b1, o1, 0, 0, 0);
        }
      }
    }
#pragma unroll
    for (int r = 0; r < 16; ++r) {
      const int q = 8 * (r >> 2) + 4 * hh + (r & 3);
      bf16_t* op = ao + (size_t)(qrow0 + q) * D + head * 64 + ql;
      op[0] = f2bf(o0[r]); op[32] = f2bf(o1[r]);
    }
  }
  asm volatile("s_waitcnt vmcnt(0)" ::: "memory");
  __syncthreads();
}

__global__ void __launch_bounds__(512) fwd_megakernel(Params p) {
  cg::grid_group grid = cg::this_grid();
  unsigned char* ws = p.ws;
  volatile LAS unsigned* xst = (volatile LAS unsigned*)((LAS unsigned char*)shm + XB_LDS_OFF);
  if (threadIdx.x < 4) xst[threadIdx.x] = 0u;
  __syncthreads();
  (void)xcd_barrier_post((unsigned*)(ws + W_BAR), xst);
  for (int it = bid_o(); it < 128; it += gdim_o()) s5_matrices(p, it >> 6, it & 63);
  weights_phase(p);
  cache_phase(p);
  norm_phase<0>(p, p.in[7], 0);
  if (p.ws == nullptr) grid.sync();
  xcd_barrier(p.ws);
#pragma unroll 1
  for (int l = 0; l < 4; ++l) {
    if (l < 2) {
      if (l == 1) { norm_phase<1>(p, p.in[7] + D, 11); xcd_barrier(p.ws); }
      gemm_phase<G_S1>(p, nullptr, 0, (const bf16_t*)(ws + W_BS1) + (size_t)l * 8192 * 512, 8192, 512);
      xcd_barrier(p.ws);
      if (PROBE == 9) { gemm_phase<G_S1>(p, nullptr, 0, (const bf16_t*)(ws + W_BS1) + (size_t)l * 8192 * 512, 8192, 512); xcd_barrier(p.ws); }
      s2_phase(p, l);
      xcd_barrier(p.ws);
      if (PROBE == 3) { s2_phase(p, l); xcd_barrier(p.ws); s2_phase(p, l); xcd_barrier(p.ws); }
      gemm_phase<G_S3>(p, nullptr, 0, (const bf16_t*)(ws + W_BS3) + (size_t)l * 16384 * 384, 16384, 384);
      xcd_barrier(p.ws);
      if (PROBE == 10) { gemm_phase<G_S3>(p, nullptr, 0, (const bf16_t*)(ws + W_BS3) + (size_t)l * 16384 * 384, 16384, 384); xcd_barrier(p.ws); }
      gemm_phase<G_GLU>(p, (const bf16_t*)(ws + W_YG), D, (const bf16_t*)(ws + W_WGLU) + (size_t)l * 2048 * 1024, 2048, 1024, l == 0);
      xcd_barrier(p.ws);
    } else {
      norm_phase<2>(p, nullptr, 11);
      xcd_barrier(p.ws);
      if (l == 2) gemm_phase_stream<G_QKV>(p, (const bf16_t*)(ws + W_XB), D, (const bf16_t*)(ws + W_WQKV), 1536, 1024);
      else gemm_phase_stream<G_QKV>(p, (const bf16_t*)(ws + W_XB), D, (const bf16_t*)(ws + W_WQKV) + (size_t)1536 * 1024, 1024, 1024);
      xcd_barrier(p.ws);
      if (l == 2) { kvfin_phase(p); xcd_barrier(p.ws); }
      attn_phase(p, l - 2);
      xcd_barrier(p.ws);
      if (PROBE == 4) { attn_phase(p, l - 2); xcd_barrier(p.ws); attn_phase(p, l - 2); xcd_barrier(p.ws); }
      gemm_phase<G_RESID>(p, (const bf16_t*)(ws + W_YG), D, (const bf16_t*)(ws + W_WO) + (size_t)(l - 2) * 1024 * 1024, 1024, 1024);
      xcd_barrier(p.ws);
    }
    norm_phase<2>(p, nullptr, l < 2 ? 0 : 4);
    xcd_barrier(p.ws);
    gemm_phase_stream<G_FFIN>(p, (const bf16_t*)(ws + W_XB), D, (const bf16_t*)(ws + W_WIN) + (size_t)l * 5632 * 1024, 5632, 1024);
    xcd_barrier(p.ws);
    if (PROBE == 1) { gemm_phase_stream<G_FFIN>(p, (const bf16_t*)(ws + W_XB), D, (const bf16_t*)(ws + W_WIN) + (size_t)l * 5632 * 1024, 5632, 1024); xcd_barrier(p.ws); }
    if (PROBE == 2) { for (int q = 0; q < 10; ++q) xcd_barrier(p.ws); }
    gemm_phase<G_RESID>(p, (const bf16_t*)(ws + W_HB), FF, (const bf16_t*)(ws + W_WOUT) + (size_t)l * 1024 * FF, 1024, FF, l == 3 ? 2 : 0);
    xcd_barrier(p.ws);
  }
  norm_phase<3>(p, nullptr, 11);
}

extern "C" void kernel_launch(void* const* d_in, const int* in_sizes, int n_in, void* d_out, int out_size, void* d_ws, size_t ws_size, hipStream_t stream) {
  static int grid_blocks = 0;
  if (grid_blocks == 0) {
    if (n_in != 28 || (size_t)out_size != O_END || ws_size < W_END) { fprintf(stderr, "kernel_launch: unexpected shapes (n_in %d out %d ws %zu need %zu)\n", n_in, out_size, ws_size, (size_t)W_END); grid_blocks = -1; return; }
    int dev = 0, cus = 0, per_cu = 0;
    hipGetDevice(&dev);
    hipDeviceGetAttribute(&cus, hipDeviceAttributeMultiprocessorCount, dev);
    if (hipFuncSetAttribute((const void*)fwd_megakernel, hipFuncAttributeMaxDynamicSharedMemorySize, LDS_BYTES) != hipSuccess) { fprintf(stderr, "kernel_launch: hipFuncSetAttribute failed\n"); }
    hipOccupancyMaxActiveBlocksPerMultiprocessor(&per_cu, (const void*)fwd_megakernel, 512, LDS_BYTES);
    if (per_cu < 1) { fprintf(stderr, "kernel_launch: occupancy query says %d blocks/CU\n", per_cu); per_cu = 1; }
    (void)hipGetLastError();
    grid_blocks = cus;
  }
  if (grid_blocks < 0) return;
  if (hipMemsetAsync((char*)d_ws + W_BAR, 0, 4096 * 4, stream) != hipSuccess) { fprintf(stderr, "kernel_launch: memset failed\n"); return; }
  Params p{};
  for (int i = 0; i < 28; ++i) p.in[i] = (const float*)d_in[i];
  p.out = (float*)d_out; p.ws = (unsigned char*)d_ws;
  void* args[] = {&p};
  hipError_t e = hipLaunchCooperativeKernel((const void*)fwd_megakernel, dim3(grid_blocks), dim3(512), args, LDS_BYTES, stream);
  if (e != hipSuccess) fprintf(stderr, "cooperative launch failed: %s (grid %d)\n", hipGetErrorString(e), grid_blocks);
}
```

```cpp
#include <hip/hip_runtime.h>
#include <hip/hip_cooperative_groups.h>
#include <cstdio>
#include <cstdint>
namespace cg = cooperative_groups;

typedef unsigned short bf16_t;
typedef short bf16x8 __attribute__((ext_vector_type(8)));
typedef float f32x4 __attribute__((ext_vector_type(4)));
typedef float f32x16 __attribute__((ext_vector_type(16)));
typedef unsigned u32x4 __attribute__((ext_vector_type(4)));
typedef unsigned u32x2 __attribute__((ext_vector_type(2)));

constexpr int D = 1024, SEQ = 16384, NB = 2, DB = 32, DS = 32, FF = 2816;
constexpr int R_PROMPT = 0, R_SAMPLE = 32768, R_META = 33792, R_REAL = 33808, R_PAD = 34048;
constexpr int NTM = R_PAD / 256;
constexpr int NCH = 2 * 1025 + 64, NCH_PAD = 2304;
constexpr int KROWS = 32768 + 32 * 160 + 16;
constexpr int KS_BASE = 32768, KM_BASE = 32768 + 5120;
constexpr size_t VT_S = (size_t)2 * 4 * 64 * 16384, VT_M = VT_S + (size_t)32 * 4 * 64 * 160;

constexpr size_t O_YP = 0, O_YS = 33554432, O_PRE = O_YS + 1048576, O_PIM = O_PRE + 16384, O_PK = O_PIM + 16384, O_PV = O_PK + 65536,
                 O_SRE = O_PV + 65536, O_SIM = O_SRE + 262144, O_SK = O_SIM + 262144, O_SV = O_SK + 262144, O_END = O_SV + 262144;

constexpr size_t al(size_t x) { return (x + 255) & ~(size_t)255; }
constexpr size_t W_XMETA = 0;
constexpr size_t W_XB = al(W_XMETA + (size_t)256 * D * 4);
constexpr size_t W_RS = al(W_XB + (size_t)R_PAD * D * 2);
constexpr size_t W_UB = al(W_RS + (size_t)R_PAD * 4);
constexpr size_t W_YG = al(W_UB + (size_t)R_PAD * D * 2);
constexpr size_t W_SB = al(W_YG + (size_t)R_PAD * D * 2);
constexpr size_t W_HIN = al(W_SB + (size_t)NCH_PAD * 8192 * 4);
constexpr size_t W_KB = al(W_HIN + (size_t)NCH_PAD * 8192 * 2);
constexpr size_t W_VT = al(W_KB + (size_t)(KROWS + 16) * 256 * 2);
constexpr size_t W_WGLU = al(W_VT + (size_t)(KROWS + 16) * 256 * 2);
constexpr size_t W_WIN = al(W_WGLU + (size_t)2 * 2048 * 1024 * 2);
constexpr size_t W_WOUT = al(W_WIN + (size_t)4 * 5632 * 1024 * 2);
constexpr size_t W_WQKV = al(W_WOUT + (size_t)4 * 1024 * FF * 2);
constexpr size_t W_WO = al(W_WQKV + (size_t)2560 * 1024 * 2);
constexpr size_t W_BS1 = al(W_WO + (size_t)2 * 1024 * 1024 * 2);
constexpr size_t W_BS3 = al(W_BS1 + (size_t)2 * 8192 * 512 * 2);
constexpr size_t W_A16 = al(W_BS3 + (size_t)2 * 16384 * 384 * 2);
constexpr size_t W_BAR = al(W_A16 + (size_t)2 * 64 * 64 * 8);
constexpr size_t W_END = al(W_BAR + (size_t)4096 * 4);
constexpr size_t W_HB = W_UB;
constexpr size_t W_KVRAW = W_SB;
constexpr size_t W_PART = W_UB + (size_t)R_PAD * FF * 2;
constexpr int SPLIT_ROW0 = 32768, SPLIT_ROWS = R_PAD - 32768, SPLIT_PM0 = 128;
static_assert(W_PART + (size_t)11 * SPLIT_ROWS * D * 4 <= W_KB, "partials overlay");
static_assert((size_t)R_PAD * FF * 2 <= W_HIN - W_UB, "hb overlay");
static_assert((size_t)R_PAD * 512 * 4 <= W_HIN - W_SB, "kvraw overlay");
static_assert(W_END <= (size_t)512 * 1024 * 1024, "workspace");

constexpr int LDS_BYTES = 147456;
constexpr int XB_LDS_OFF = LDS_BYTES - 16;
constexpr int PROBE = 0;

struct Params {
  const float* in[28];
  float* out;
  unsigned char* ws;
};

extern __shared__ __attribute__((aligned(16))) unsigned char shm[];

__device__ __forceinline__ unsigned cvt_pk_bf16(float lo, float hi) { unsigned r; asm volatile("v_cvt_pk_bf16_f32 %0, %1, %2" : "=v"(r) : "v"(lo), "v"(hi)); return r; }
__device__ __forceinline__ bf16_t f2bf(float f) { return (bf16_t)(cvt_pk_bf16(f, 0.f) & 0xffffu); }
__device__ __forceinline__ float bf2f(unsigned b) { return __uint_as_float(b << 16); }
__device__ __forceinline__ f32x4 unpack4(u32x2 r) { return (f32x4){__uint_as_float(r.x << 16), __uint_as_float(r.x & 0xffff0000u), __uint_as_float(r.y << 16), __uint_as_float(r.y & 0xffff0000u)}; }
__device__ __forceinline__ float shx(float v, int o, int lane) { return __int_as_float(__builtin_amdgcn_ds_bpermute((lane ^ o) << 2, __float_as_int(v))); }
__device__ __forceinline__ float wave_sum(float v, int lane) {
#pragma unroll
  for (int o = 1; o < 64; o <<= 1) v += shx(v, o, lane);
  return v;
}
__device__ __forceinline__ int tid_o() { int t = threadIdx.x; asm volatile("" : "+v"(t)); return t; }
__device__ __forceinline__ int bid_o() { int b = blockIdx.x; asm volatile("" : "+s"(b)); return b; }
__device__ __forceinline__ int gdim_o() { int b = gridDim.x; asm volatile("" : "+s"(b)); return b; }
__device__ __forceinline__ float sigmoidf_(float x) { return __builtin_amdgcn_rcpf(1.f + __expf(-x)); }
__device__ __forceinline__ float gelu_tanh(float x) {
  const float x2 = x * x;
  const float w = x * (-2.302208198f - 0.102943242f * x2);
  return x * __builtin_amdgcn_rcpf(1.f + __builtin_amdgcn_exp2f(w));
}
__device__ __forceinline__ float* xrow_ptr(const Params& p, int row) {
  return row < R_META ? p.out + (size_t)row * D : (float*)(p.ws + W_XMETA) + (size_t)(row - R_META) * D;
}
__device__ __forceinline__ const float* xsrc_ptr(const Params& p, int row) {
  return row < R_SAMPLE ? p.in[0] + (size_t)row * D : row < R_META ? p.in[1] + (size_t)(row - R_SAMPLE) * D : row < R_REAL ? p.in[6] + (size_t)(row - R_META) * D : nullptr;
}
__device__ __forceinline__ int chunk_row(int cgi) {
  if (cgi >= NCH) cgi = 0;
  if (cgi < 2050) { const int b = cgi >= 1025 ? 1 : 0; const int c = cgi - b * 1025; return c == 0 ? R_META : b * SEQ + (c - 1) * 16; }
  return R_SAMPLE + (cgi - 2050) * 16;
}

#define LAS __attribute__((address_space(3)))
constexpr int BM = 256, BK = 64, HALF = 128, HTB = HALF * BK * 2;
__device__ __forceinline__ int lds_byte(int r, int c) {
  int st = (r >> 4) * 2 + (c >> 5), rr = r & 15, cc = c & 31, ob = rr * 64 + cc * 2;
  return st * 1024 + (ob ^ (((ob >> 9) & 1) << 5));
}
__device__ __forceinline__ void stage_rc(int b, int& R, int& C) {
  int st = b / 1024, sb = b % 1024, swz = sb ^ (((sb >> 9) & 1) << 5);
  R = (st >> 1) * 16 + swz / 64; C = (st & 1) * 32 + (swz % 64) / 2;
}

typedef f32x4 acc_t[2][2][4][2];

struct ARow {
  const char* base; unsigned hstep; unsigned voff[2];
  __device__ __forceinline__ void init(const bf16_t* A, int lda, int brow) {
    base = (const char*)(A + (size_t)brow * lda); hstep = (unsigned)HALF * lda * 2u;
#pragma unroll
    for (int i = 0; i < 2; ++i) { int R, C; stage_rc(tid_o() * 16 + i * 8192, R, C); voff[i] = (unsigned)(R * lda + C) * 2u; }
  }
  __device__ __forceinline__ const char* ptr(int h, int i, int kt) const { return base + (size_t)h * hstep + (size_t)kt * 128 + voff[i]; }
};
struct AS1 {
  const char* ub; unsigned voff[2][2]; int pn;
  __device__ __forceinline__ void init(const bf16_t* u, int brow, int pn_) {
    ub = (const char*)u; pn = pn_;
#pragma unroll
    for (int h = 0; h < 2; ++h)
#pragma unroll
      for (int i = 0; i < 2; ++i) { int R, C; stage_rc(tid_o() * 16 + i * 8192, R, C);
        voff[h][i] = (unsigned)(chunk_row(brow + h * 128 + R) + (C >> 4)) * 2048u + (unsigned)(C & 15) * 2u; }
  }
  __device__ __forceinline__ const char* ptr(int h, int i, int kt) const { return ub + (size_t)((pn * 2 + (kt >> 2)) * 32 + (kt & 3) * 8192) + voff[h][i]; }
};
struct AS3 {
  const char* ub; const char* hin; unsigned voffu[2][2], voffh[2][2]; int g;
  __device__ __forceinline__ void init(const bf16_t* u, const bf16_t* hn, int brow, int g_) {
    ub = (const char*)u; hin = (const char*)hn; g = g_;
#pragma unroll
    for (int h = 0; h < 2; ++h)
#pragma unroll
      for (int i = 0; i < 2; ++i) { int R, C; stage_rc(tid_o() * 16 + i * 8192, R, C);
        int cgi = brow + h * 128 + R; if (cgi >= NCH) cgi = 0;
        voffu[h][i] = (unsigned)cgi * 32768u + (unsigned)C * 2u;
        voffh[h][i] = (unsigned)cgi * 16384u + (unsigned)C * 2u; }
  }
  __device__ __forceinline__ const char* ptr(int h, int i, int kt) const {
    return kt < 4 ? ub + (size_t)(g * 512 + kt * 128) + voffu[h][i] : hin + (size_t)(g * 256 + (kt - 4) * 128) + voffh[h][i];
  }
};

template <class AF>
__device__ __forceinline__ void gemm_mainloop(acc_t& acc, const AF& A, const bf16_t* Bt, int K, int bcol, int nt) {
  LAS unsigned char* lds = (LAS unsigned char*)shm;
  const int tid = tid_o(), wid = __builtin_amdgcn_readfirstlane(tid >> 6), lane = tid & 63, wr = wid >> 2, wc = wid & 3, fr = lane & 15, fq = lane >> 4;
  unsigned voffB[2];
#pragma unroll
  for (int i = 0; i < 2; ++i) { int R, C; stage_rc(tid * 16 + i * 8192, R, C); voffB[i] = (unsigned)(R * K + C) * 2u; }
  const char* cB = (const char*)(Bt + (size_t)bcol * K);
  const size_t hstepB = (size_t)HALF * K * 2;
  const unsigned ldsw = (unsigned)wid * 1024u;
  const int aoff = lds_byte(wr * 64 + fr, fq * 8), boff = lds_byte(wc * 32 + fr, fq * 8);
#define SA(b, h) (((b) * 2 + (h)) * HTB)
#define SB(b, h) ((4 + (b) * 2 + (h)) * HTB)
#define STAGE_A(bufoff, h, kt) do { _Pragma("unroll") for (int _i = 0; _i < 2; ++_i) \
    __builtin_amdgcn_global_load_lds((const unsigned*)A.ptr(h, _i, kt), (LAS unsigned*)(lds + (bufoff) + ldsw + _i * 8192), 16, 0, 0); } while (0)
#define STAGE_B(bufoff, h, kt) do { _Pragma("unroll") for (int _i = 0; _i < 2; ++_i) \
    __builtin_amdgcn_global_load_lds((const unsigned*)(cB + (size_t)(h) * hstepB + (size_t)(kt) * 128 + voffB[_i]), (LAS unsigned*)(lds + (bufoff) + ldsw + _i * 8192), 16, 0, 0); } while (0)
#define LDA(dst, b, h) do { _Pragma("unroll") for (int m = 0; m < 4; ++m) _Pragma("unroll") for (int k = 0; k < 2; ++k) dst[m][k] = *(const LAS bf16x8*)(lds + SA(b, h) + aoff + m * 2048 + k * 1024); } while (0)
#define LDB(dst, b, h) do { _Pragma("unroll") for (int n = 0; n < 2; ++n) _Pragma("unroll") for (int k = 0; k < 2; ++k) dst[n][k] = *(const LAS bf16x8*)(lds + SB(b, h) + boff + n * 2048 + k * 1024); } while (0)
#define MMA(ai, bj, At_, Bt_) do { __builtin_amdgcn_s_setprio(1); _Pragma("unroll") for (int m = 0; m < 4; ++m) _Pragma("unroll") for (int n = 0; n < 2; ++n) _Pragma("unroll") for (int k = 0; k < 2; ++k) \
      acc[ai][bj][m][n] = __builtin_amdgcn_mfma_f32_16x16x32_bf16(Bt_[n][k], At_[m][k], acc[ai][bj][m][n], 0, 0, 0); \
    __builtin_amdgcn_s_setprio(0); } while (0)
#define WAIT_V(n) asm volatile("s_waitcnt vmcnt(" #n ")" ::: "memory")
#define WAIT_L(n) asm volatile("s_waitcnt lgkmcnt(" #n ")" ::: "memory")
#define BAR __builtin_amdgcn_s_barrier()
#define SCHED __builtin_amdgcn_sched_barrier(0)
#pragma unroll
  for (int a = 0; a < 2; ++a)
#pragma unroll
    for (int b = 0; b < 2; ++b)
#pragma unroll
      for (int m = 0; m < 4; ++m)
#pragma unroll
        for (int n = 0; n < 2; ++n) acc[a][b][m][n] = (f32x4){0.f, 0.f, 0.f, 0.f};
  bf16x8 At[4][2], B0[2][2], B1[2][2];
  STAGE_B(SB(0, 0), 0, 0); STAGE_B(SB(0, 1), 1, 0); STAGE_A(SA(0, 0), 0, 0); STAGE_A(SA(0, 1), 1, 0);
  if (wr == 1) BAR;
  WAIT_V(2); BAR;
  STAGE_B(SB(1, 0), 0, 1); STAGE_A(SA(1, 0), 0, 1); STAGE_B(SB(1, 1), 1, 1);
  WAIT_V(6); BAR;
#pragma unroll 1
  for (int t = 0; t < nt - 2; t += 2) {
    const int k2 = t + 2, k3 = t + 3;
    LDB(B0, 0, 0); LDB(B1, 0, 1); SCHED; LDA(At, 0, 0); STAGE_A(SA(1, 1), 1, t + 1);
    WAIT_V(8); WAIT_L(0); BAR; MMA(0, 0, At, B0); MMA(0, 1, At, B1); BAR; SCHED;
    LDA(At, 0, 1); STAGE_B(SB(0, 0), 0, k2); STAGE_B(SB(0, 1), 1, k2); STAGE_A(SA(0, 0), 0, k2);
    WAIT_V(8); WAIT_L(0); BAR; MMA(1, 0, At, B0); MMA(1, 1, At, B1); BAR; SCHED;
    LDB(B0, 1, 0); LDB(B1, 1, 1); SCHED; LDA(At, 1, 0); STAGE_A(SA(0, 1), 1, k2);
    WAIT_V(8); WAIT_L(0); BAR; MMA(0, 0, At, B0); MMA(0, 1, At, B1); BAR; SCHED;
    LDA(At, 1, 1); STAGE_B(SB(1, 0), 0, k3); STAGE_B(SB(1, 1), 1, k3); STAGE_A(SA(1, 0), 0, k3);
    WAIT_V(8); WAIT_L(0); BAR; MMA(1, 0, At, B0); MMA(1, 1, At, B1); BAR; SCHED;
  }
  {
    LDB(B0, 0, 0); LDB(B1, 0, 1); SCHED; LDA(At, 0, 0); STAGE_A(SA(1, 1), 1, nt - 1);
    WAIT_V(8); WAIT_L(0); BAR; MMA(0, 0, At, B0); MMA(0, 1, At, B1); BAR; SCHED;
    LDA(At, 0, 1);
    WAIT_V(2); WAIT_L(0); BAR; MMA(1, 0, At, B0); MMA(1, 1, At, B1); BAR; SCHED;
    LDB(B0, 1, 0); LDB(B1, 1, 1); SCHED; LDA(At, 1, 0);
    WAIT_V(0); WAIT_L(0); BAR; MMA(0, 0, At, B0); MMA(0, 1, At, B1); BAR; SCHED;
    LDA(At, 1, 1);
    WAIT_L(0); BAR; MMA(1, 0, At, B0); MMA(1, 1, At, B1); BAR;
  }
  WAIT_V(0);
  if (wr == 0) BAR;
  BAR;
#undef SA
#undef SB
}


#define XB_TMO      128
#define XB_XCNT(j)  (256  + 64 * (j))
#define XB_XSUB(j)  (1280 + 64 * (j))
#define XB_XGEN(j)  (2304 + 64 * (j))
#define XB_TOP      3328
#define XB_TOPGEN   3392
#define XCD_BAR_WORDS 3456
#define XB_SPIN_CAP (1u << 18)
__device__ __forceinline__ unsigned xb_ld(unsigned* p)              { return __hip_atomic_load(p, __ATOMIC_RELAXED, __HIP_MEMORY_SCOPE_AGENT); }
__device__ __forceinline__ unsigned xb_add(unsigned* p, unsigned v) { return __hip_atomic_fetch_add(p, v, __ATOMIC_RELAXED, __HIP_MEMORY_SCOPE_AGENT); }
__device__ __forceinline__ unsigned xb_xcc_id() { return (unsigned)__builtin_amdgcn_s_getreg((3 << 11) | 20) & 0xFu; }
#define XB_SPIN(cond, bar) do { unsigned _sp = 0; while (cond) { __builtin_amdgcn_s_sleep(1); \
    if ((++_sp & 255u) == 0u) { if (xb_ld(&(bar)[XB_TMO])) break; if (_sp > XB_SPIN_CAP) { atomicAdd(&(bar)[XB_TMO], 1u); break; } } } } while (0)
struct XcdBarrier { unsigned* bar; unsigned x; volatile LAS unsigned* st; };
__device__ __forceinline__ XcdBarrier xcd_barrier_post(unsigned* bar, volatile LAS unsigned* st) {
  XcdBarrier b; b.bar = bar; b.x = xb_xcc_id(); b.st = st;
  if (threadIdx.x == 0) (void)xb_add(&bar[XB_XCNT(b.x)], 1u);
  return b;
}
__device__ __forceinline__ void xcd_barrier_complete(unsigned* bar, unsigned x, unsigned& nloc, unsigned& nx) {
  const unsigned G = gridDim.x * gridDim.y * gridDim.z;
  unsigned sum, cnt, mine, sp = 0u;
  for (;;) {
    sum = 0u; cnt = 0u; mine = 0u;
#pragma unroll
    for (unsigned j = 0; j < 16; ++j) { const unsigned c = xb_ld(&bar[XB_XCNT(j)]); sum += c; cnt += (c > 0u) ? 1u : 0u; mine = (j == x) ? c : mine; }
    if (sum == G) break;
    __builtin_amdgcn_s_sleep(1);
    if ((++sp & 255u) == 0u) { if (xb_ld(&bar[XB_TMO])) break; if (sp > XB_SPIN_CAP) { atomicAdd(&bar[XB_TMO], 1u); break; } }
  }
  nloc = mine > 0u ? mine : 1u; nx = cnt > 0u ? cnt : 1u;
}
__device__ __forceinline__ void xcd_barrier(unsigned char* ws_) {
  XcdBarrier b; b.bar = (unsigned*)(ws_ + W_BAR); b.x = xb_xcc_id(); b.st = (volatile LAS unsigned*)((LAS unsigned char*)shm + XB_LDS_OFF);
  asm volatile("s_waitcnt vmcnt(0)" ::: "memory");
  __syncthreads();
  if (threadIdx.x == 0) {
    unsigned* bar = b.bar;
    __builtin_amdgcn_s_waitcnt(0);
    unsigned nloc = b.st[0], nx = b.st[1];
    if (nloc == 0u) { xcd_barrier_complete(bar, b.x, nloc, nx); b.st[0] = nloc; b.st[1] = nx; }
    const unsigned old = xb_add(&bar[XB_XSUB(b.x)], 1u);
    const unsigned gen = old / nloc;
    if (old + 1u == (gen + 1u) * nloc) {
      __builtin_amdgcn_fence(__ATOMIC_RELEASE, "agent");
      asm volatile("s_waitcnt vmcnt(0)" ::: "memory");
      const unsigned og = xb_add(&bar[XB_TOP], 1u);
      const unsigned tg = og / nx;
      if (og + 1u == (tg + 1u) * nx) xb_add(&bar[XB_TOPGEN], 1u);
      else XB_SPIN(xb_ld(&bar[XB_TOPGEN]) == tg, bar);
      __builtin_amdgcn_fence(__ATOMIC_ACQUIRE, "agent");
      xb_add(&bar[XB_XGEN(b.x)], 1u);
      asm volatile("s_waitcnt vmcnt(0)" ::: "memory");
    } else {
      XB_SPIN(xb_ld(&bar[XB_XGEN(b.x)]) == gen, bar);
      __builtin_amdgcn_fence(__ATOMIC_ACQUIRE, "agent");
      asm volatile("s_waitcnt vmcnt(0)" ::: "memory");
    }
  }
  __syncthreads();
}

__device__ __forceinline__ bool tile_at(long L, int nM, int nN, int& pm, int& pn) {
  const int nwg = nM * nN;
  if (L >= nwg) return false;
  int wgid = (int)L;
  { const int q = nwg / 8, r = nwg % 8, xcd = wgid % 8, off = wgid / 8; wgid = (xcd < r ? xcd * (q + 1) : r * (q + 1) + (xcd - r) * q) + off; }
  const int nig = 8 * nN, gid = wgid / nig, fm = gid * 8, gsz = (nM - fm) < 8 ? (nM - fm) : 8;
  pm = fm + ((wgid % nig) % gsz); pn = (wgid % nig) / gsz;
  return true;
}
__device__ __forceinline__ bool tile_next(int it, int nM, int nN, int& pm, int& pn) { return tile_at((long)it * gdim_o() + bid_o(), nM, nN, pm, pn); }

#define EPI_ROWS_BEGIN \
  const int wid = tid_o() >> 6, lane = tid_o() & 63, wr = wid >> 2, wc = wid & 3, fr = lane & 15, fq = lane >> 4; \
  _Pragma("unroll") for (int ai = 0; ai < 2; ++ai) _Pragma("unroll") for (int m = 0; m < 4; ++m) { \
    const int row = brow + ai * 128 + wr * 64 + m * 16 + fr;
#define EPI_ROWS_END }

enum { G_GLU = 0, G_FFIN = 1, G_RESID = 2, G_QKV = 3, G_S1 = 4, G_S3 = 5 };

template <int MODE>
__device__ __forceinline__ void gemm_epilogue(const Params& p, acc_t& acc, int brow, int bcol, int pn, bool split, int ksi, int first, const float (&rsv)[8]) {
  unsigned char* ws = p.ws;
    if (MODE == G_GLU) {
      bf16_t* xb = (bf16_t*)(ws + W_XB);
      EPI_ROWS_BEGIN
        bf16_t* xr = xb + (size_t)row * D;
        const int oc = (bcol >> 1) + wc * 32 + fq * 8;
        f32x4 x0, x1;
        if (first & 1) { const float* xs = xsrc_ptr(p, row); x0 = xs ? *(const f32x4*)(xs + oc) : (f32x4){0.f, 0.f, 0.f, 0.f}; x1 = xs ? *(const f32x4*)(xs + oc + 4) : (f32x4){0.f, 0.f, 0.f, 0.f}; }
        else { const u32x4 raw = *(const u32x4*)(xr + oc); x0 = unpack4((u32x2){raw.x, raw.y}); x1 = unpack4((u32x2){raw.z, raw.w}); }
#pragma unroll
        for (int j = 0; j < 4; ++j) { x0[j] += acc[ai][0][m][0][j] * sigmoidf_(acc[ai][1][m][0][j]); x1[j] += acc[ai][0][m][1][j] * sigmoidf_(acc[ai][1][m][1][j]); }
        u32x4 o; o.x = cvt_pk_bf16(x0[0], x0[1]); o.y = cvt_pk_bf16(x0[2], x0[3]); o.z = cvt_pk_bf16(x1[0], x1[1]); o.w = cvt_pk_bf16(x1[2], x1[3]);
        *(u32x4*)(xr + oc) = o;
      EPI_ROWS_END
    } else if (MODE == G_FFIN) {
      bf16_t* hb = (bf16_t*)(ws + W_HB); const float* rs = (const float*)(ws + W_RS);
      EPI_ROWS_BEGIN
        const float s = rsv[ai * 4 + m];
        const int oc = (bcol >> 1) + wc * 32 + fq * 8;
        float hv[8];
#pragma unroll
        for (int n = 0; n < 2; ++n)
#pragma unroll
          for (int j = 0; j < 4; ++j) { const float gt = acc[ai][0][m][n][j] * s, up = acc[ai][1][m][n][j] * s; hv[n * 4 + j] = gt * sigmoidf_(gt) * up; }
        u32x4 o; o.x = cvt_pk_bf16(hv[0], hv[1]); o.y = cvt_pk_bf16(hv[2], hv[3]); o.z = cvt_pk_bf16(hv[4], hv[5]); o.w = cvt_pk_bf16(hv[6], hv[7]);
        *(u32x4*)(hb + (size_t)row * FF + oc) = o;
      EPI_ROWS_END
    } else if (MODE == G_RESID) {
      bf16_t* xb = (bf16_t*)(ws + W_XB);
      EPI_ROWS_BEGIN
        bf16_t* xr = xb + (size_t)row * D;
#pragma unroll
        for (int bj = 0; bj < 2; ++bj)
#pragma unroll
          for (int n = 0; n < 2; ++n) {
            const int oc = bcol + bj * 128 + wc * 32 + n * 16 + fq * 4;
            if (split) {
              *(f32x4*)((float*)(ws + W_PART) + ((size_t)ksi * SPLIT_ROWS + (row - SPLIT_ROW0)) * D + oc) = acc[ai][bj][m][n];
            } else {
              f32x4 x = unpack4(*(const u32x2*)(xr + oc));
              x += acc[ai][bj][m][n];
              if (first & 2) *(f32x4*)(xrow_ptr(p, row) + oc) = x;
              else { u32x2 o; o.x = cvt_pk_bf16(x[0], x[1]); o.y = cvt_pk_bf16(x[2], x[3]); *(u32x2*)(xr + oc) = o; }
            }
          }
      EPI_ROWS_END
    } else if (MODE == G_QKV) {
      bf16_t* qb = (bf16_t*)(ws + W_UB); float* kv = (float*)(ws + W_KVRAW); const float* rs = (const float*)(ws + W_RS);
      EPI_ROWS_BEGIN
        const float s = rsv[ai * 4 + m];
#pragma unroll
        for (int bj = 0; bj < 2; ++bj)
#pragma unroll
          for (int n = 0; n < 2; ++n) {
            const int oc = bcol + bj * 128 + wc * 32 + n * 16 + fq * 4;
            const f32x4 v = acc[ai][bj][m][n] * s;
            if (bcol < 1024) { u32x2 o; o.x = cvt_pk_bf16(v[0], v[1]); o.y = cvt_pk_bf16(v[2], v[3]); *(u32x2*)(qb + (size_t)row * D + oc) = o; }
            else *(f32x4*)(kv + (size_t)row * 512 + (oc - 1024)) = v;
          }
      EPI_ROWS_END
    } else if (MODE == G_S1) {
      float* sb = (float*)(ws + W_SB);
      EPI_ROWS_BEGIN
#pragma unroll
        for (int bj = 0; bj < 2; ++bj)
#pragma unroll
          for (int n = 0; n < 2; ++n) {
            const int oc = bcol + bj * 128 + wc * 32 + n * 16 + fq * 4;
            *(f32x4*)(sb + (size_t)row * 8192 + oc) = acc[ai][bj][m][n];
          }
      EPI_ROWS_END
    } else if (MODE == G_S3) {
      bf16_t* yg = (bf16_t*)(ws + W_YG);
      EPI_ROWS_BEGIN
        const bool valid = row < NCH && row != 1025;
        const int tr = chunk_row(row);
        if (valid) {
#pragma unroll
          for (int bj = 0; bj < 2; ++bj)
#pragma unroll
            for (int n = 0; n < 2; ++n) {
              const int t = bj * 8 + wc * 2 + n;
              const f32x4 v = acc[ai][bj][m][n];
              u32x2 o; o.x = cvt_pk_bf16(gelu_tanh(v[0]), gelu_tanh(v[1])); o.y = cvt_pk_bf16(gelu_tanh(v[2]), gelu_tanh(v[3]));
              *(u32x2*)(yg + (size_t)(tr + t) * D + pn * 16 + fq * 4) = o;
            }
        }
      EPI_ROWS_END
    }
}

template <int MODE>
__device__ __forceinline__ void gemm_phase(const Params& p, const bf16_t* A, int lda, const bf16_t* Bt, int N, int K, int first = 0) {
  const int nM = (MODE == G_S1 || MODE == G_S3) ? NCH_PAD / 256 : NTM, nN = N / 256, nt = K / BK;
  unsigned char* ws = p.ws;
  const int G = gdim_o(), ks = nt / 4, nsplit = (NTM - SPLIT_PM0) * nN * ks, nMw = (MODE == G_RESID) ? SPLIT_PM0 : nM;
  const int nfull_it = (nMw * nN + G - 1) / G;
#pragma unroll 1
  for (int it = 0;; ++it) {
    int pm, pn; bool split = false; int kt0 = 0, ntu = nt, ksi = 0;
    if (MODE == G_RESID && it >= nfull_it) {
      const int u = (it - nfull_it) * G + bid_o();
      if (u >= nsplit) break;
      ksi = u % ks; const int tq = u / ks; pn = tq % nN; pm = SPLIT_PM0 + tq / nN;
      split = true; kt0 = ksi * 4; ntu = 4;
    } else if (!tile_next(it, nMw, nN, pm, pn)) { if (MODE == G_RESID) continue; else break; }
    const int brow = pm * 256, bcol = pn * 256;
    float rsv[8];
    if (MODE == G_FFIN || MODE == G_QKV) {
      const int tid_ = tid_o(), wr_ = (tid_ >> 6) >> 2, fr_ = tid_ & 15;
      const float* rsp = (const float*)(ws + W_RS) + brow + wr_ * 64 + fr_;
#pragma unroll
      for (int q = 0; q < 8; ++q) rsv[q] = rsp[(q >> 2) * 128 + (q & 3) * 16];
    }
    acc_t acc;
    if (MODE == G_S1) { ARow af; af.init((const bf16_t*)(ws + W_UB) + pn * 512, 16384, brow); gemm_mainloop(acc, af, Bt, K, bcol, nt); }
    else if (MODE == G_S3) { AS3 af; af.init((const bf16_t*)(ws + W_UB), (const bf16_t*)(ws + W_HIN), brow, pn); gemm_mainloop(acc, af, Bt, K, bcol, nt); }
    else { ARow af; af.init(A + kt0 * BK, lda, brow); gemm_mainloop(acc, af, Bt + kt0 * BK, K, bcol, ntu); }
    gemm_epilogue<MODE>(p, acc, brow, bcol, pn, split, ksi, first, rsv);
    __builtin_amdgcn_s_barrier();
  }
}

template <int MODE>
__device__ __forceinline__ void gemm_phase_stream(const Params& p, const bf16_t* A, int lda, const bf16_t* Bt, int N, int K) {
  const int nM = NTM, nN = N / 256, nt = K / BK;
  unsigned char* ws = p.ws;
  LAS unsigned char* lds = (LAS unsigned char*)shm;
  const int tid = tid_o(), wid = __builtin_amdgcn_readfirstlane(tid >> 6), lane = tid & 63, wr = wid >> 2, wc = wid & 3, fr = lane & 15, fq = lane >> 4;
  unsigned voffA[2], voffB[2];
#pragma unroll
  for (int i = 0; i < 2; ++i) { int R, C; stage_rc(tid * 16 + i * 8192, R, C); voffA[i] = (unsigned)(R * lda + C) * 2u; voffB[i] = (unsigned)(R * K + C) * 2u; }
  const size_t kstep = (size_t)(BK * 2);
  const size_t hstepA = (size_t)HALF * lda * 2, hstepB = (size_t)HALF * K * 2;
  const unsigned ldsw = (unsigned)wid * 1024u;
  const int aoff = lds_byte(wr * 64 + fr, fq * 8), boff = lds_byte(wc * 32 + fr, fq * 8);
#define SA(b, h) (((b) * 2 + (h)) * HTB)
#define SB(b, h) ((4 + (b) * 2 + (h)) * HTB)
#define STG(bufoff, gbase, voff) do { _Pragma("unroll") for (int _i = 0; _i < 2; ++_i) \
    __builtin_amdgcn_global_load_lds((const unsigned*)((const char*)(gbase) + (voff)[_i]), (LAS unsigned*)(lds + (bufoff) + ldsw + _i * 8192), 16, 0, 0); } while (0)
  int cpm, cpn, npm, npn, ui = 0;
  if (!tile_next(0, nM, nN, cpm, cpn)) return;
  acc_t acc;
#pragma unroll
  for (int a = 0; a < 2; ++a)
#pragma unroll
    for (int b = 0; b < 2; ++b)
#pragma unroll
      for (int m = 0; m < 4; ++m)
#pragma unroll
        for (int n = 0; n < 2; ++n) acc[a][b][m][n] = (f32x4){0.f, 0.f, 0.f, 0.f};
  bf16x8 At[4][2], B0[2][2], B1[2][2];
  float rsv[8];
  const float* rsb = (const float*)(ws + W_RS) + wr * 64 + fr;
#pragma unroll
  for (int q = 0; q < 8; ++q) rsv[q] = rsb[cpm * 256 + (q >> 2) * 128 + (q & 3) * 16];
  const char* cA = (const char*)A + (size_t)cpm * 2 * hstepA; const char* cB = (const char*)Bt + (size_t)cpn * 2 * hstepB;
  STG(SB(0, 0), cB, voffB); STG(SB(0, 1), cB + hstepB, voffB); STG(SA(0, 0), cA, voffA); STG(SA(0, 1), cA + hstepA, voffA);
  if (wr == 1) BAR;
  WAIT_V(2); BAR;
  STG(SB(1, 0), cB + kstep, voffB); STG(SA(1, 0), cA + kstep, voffA); STG(SB(1, 1), cB + hstepB + kstep, voffB);
  WAIT_V(6); BAR;
#pragma unroll 1
  for (;;) {
    const bool has_next = tile_next(ui + 1, nM, nN, npm, npn);
    const char* nA = has_next ? (const char*)A + (size_t)npm * 2 * hstepA : cA; const char* nB = has_next ? (const char*)Bt + (size_t)npn * 2 * hstepB : cB;
#pragma unroll 1
    for (int t = 0; t < nt; t += 2) {
      const bool last = (t == nt - 2);
      const char* a1 = cA + (size_t)(t + 1) * kstep;
      const char* a2 = last ? nA : cA + (size_t)(t + 2) * kstep; const char* b2 = last ? nB : cB + (size_t)(t + 2) * kstep;
      const char* a3 = a2 + kstep; const char* b3 = b2 + kstep;
      LDB(B0, 0, 0); LDB(B1, 0, 1); SCHED; LDA(At, 0, 0); STG(SA(1, 1), a1 + hstepA, voffA);
      WAIT_V(8); WAIT_L(0); BAR; MMA(0, 0, At, B0); MMA(0, 1, At, B1); BAR; SCHED;
      LDA(At, 0, 1); STG(SB(0, 0), b2, voffB); STG(SB(0, 1), b2 + hstepB, voffB); STG(SA(0, 0), a2, voffA);
      WAIT_V(8); WAIT_L(0); BAR; MMA(1, 0, At, B0); MMA(1, 1, At, B1); BAR; SCHED;
      LDB(B0, 1, 0); LDB(B1, 1, 1); SCHED; LDA(At, 1, 0); STG(SA(0, 1), a2 + hstepA, voffA);
      WAIT_V(8); WAIT_L(0); BAR; MMA(0, 0, At, B0); MMA(0, 1, At, B1); BAR; SCHED;
      LDA(At, 1, 1); STG(SB(1, 0), b3, voffB); STG(SB(1, 1), b3 + hstepB, voffB); STG(SA(1, 0), a3, voffA);
      WAIT_V(8); WAIT_L(0); BAR; MMA(1, 0, At, B0); MMA(1, 1, At, B1); BAR; SCHED;
    }
    if (wr == 0) BAR;
    gemm_epilogue<MODE>(p, acc, cpm * 256, cpn * 256, cpn, false, 0, 0, rsv);
    if (!has_next) break;
#pragma unroll
    for (int a = 0; a < 2; ++a)
#pragma unroll
      for (int b = 0; b < 2; ++b)
#pragma unroll
        for (int m = 0; m < 4; ++m)
#pragma unroll
          for (int n = 0; n < 2; ++n) acc[a][b][m][n] = (f32x4){0.f, 0.f, 0.f, 0.f};
    cpm = npm; cpn = npn; cA = nA; cB = nB; ++ui;
#pragma unroll
    for (int q = 0; q < 8; ++q) rsv[q] = rsb[cpm * 256 + (q >> 2) * 128 + (q & 3) * 16];
    if (wr == 1) BAR;
  }
  WAIT_V(0);
  BAR;
#undef SA
#undef SB
#undef STG
}

__device__ __forceinline__ int perm32(int rho) { return 8 * ((rho & 15) >> 2) + 4 * (rho >> 4) + (rho & 3); }
__device__ __forceinline__ int srccol(int np, int mode, int Nh) {
  if (mode == 0) return np;
  const int t256 = np >> 8, r = np & 255, bj = r >> 7, r128 = r & 127, out = t256 * 128 + (r128 & ~31) + perm32(r128 & 31);
  return bj ? Nh + out : out;
}
__device__ __forceinline__ void transpose_tile(const float* W, int K, int N, bf16_t* Wt, int np0, int k0, int mode, int Nh, const float* gain) {
  float* tile = (float*)shm;
  const int tid = tid_o(), c4 = tid & 63, r0 = tid >> 6;
  const int sc = srccol(np0 + c4 * 4, mode, Nh);
  f32x4 v[8];
#pragma unroll
  for (int q = 0; q < 8; ++q) v[q] = *(const f32x4*)(W + (size_t)(k0 + r0 + q * 8) * N + sc);
#pragma unroll
  for (int q = 0; q < 8; ++q) { const int r = r0 + q * 8; const float g = gain ? gain[k0 + r] : 1.f; float* t = tile + r * 257 + c4 * 4; t[0] = v[q].x * g; t[1] = v[q].y * g; t[2] = v[q].z * g; t[3] = v[q].w * g; }
  __syncthreads();
#pragma unroll
  for (int q = 0; q < 4; ++q) {
    const int e = tid + q * 512, n = e & 255, ks = e >> 8;
    const float* s = tile + (ks * 8) * 257 + n;
    u32x4 o; o.x = cvt_pk_bf16(s[0], s[257]); o.y = cvt_pk_bf16(s[2 * 257], s[3 * 257]); o.z = cvt_pk_bf16(s[4 * 257], s[5 * 257]); o.w = cvt_pk_bf16(s[6 * 257], s[7 * 257]);
    *(u32x4*)(Wt + (size_t)(np0 + n) * K + k0 + ks * 8) = o;
  }
  __syncthreads();
}

__device__ __forceinline__ void weights_phase(const Params& p) {
  unsigned char* ws = p.ws;
  const int total = 2 * 128 + 4 * 352 + 4 * 176 + 64 + 32 + 64 + 2 * 64;
  unsigned* qctr = (unsigned*)(ws + W_BAR) + 3600;
  volatile LAS int* qslot = (volatile LAS int*)((LAS unsigned char*)shm + XB_LDS_OFF + 8);
  for (;;) {
    __syncthreads();
    if (tid_o() == 0) *qslot = (int)__hip_atomic_fetch_add(qctr, 1u, __ATOMIC_RELAXED, __HIP_MEMORY_SCOPE_AGENT);
    __syncthreads();
    const int t = *qslot;
    if (t >= total) break;
    int r = t; const float* W; int K, N, mode = 0, Nh = 0; const float* gain = nullptr; bf16_t* dst;
    if (r < 256) { const int l = r / 128; r -= l * 128; W = p.in[17] + (size_t)l * 1024 * 2048; K = 1024; N = 2048; mode = 1; Nh = 1024; dst = (bf16_t*)(ws + W_WGLU) + (size_t)l * 2048 * 1024; }
    else if ((r -= 256) < 1408) { const int l = r / 352; r -= l * 352; W = p.in[18] + (size_t)l * 1024 * 5632; K = 1024; N = 5632; mode = 1; Nh = FF; gain = p.in[8] + l * D; dst = (bf16_t*)(ws + W_WIN) + (size_t)l * 5632 * 1024; }
    else if ((r -= 1408) < 704) { const int l = r / 176; r -= l * 176; W = p.in[19] + (size_t)l * FF * 1024; K = FF; N = 1024; dst = (bf16_t*)(ws + W_WOUT) + (size_t)l * 1024 * FF; }
    else if ((r -= 704) < 64) { W = p.in[23]; K = 1024; N = 1024; gain = p.in[7] + 2 * D; dst = (bf16_t*)(ws + W_WQKV); }
    else if ((r -= 64) < 32) { W = p.in[21]; K = 1024; N = 512; gain = p.in[20]; dst = (bf16_t*)(ws + W_WQKV) + (size_t)1024 * 1024; }
    else if ((r -= 32) < 64) { W = p.in[23] + (size_t)1024 * 1024; K = 1024; N = 1024; gain = p.in[7] + 3 * D; dst = (bf16_t*)(ws + W_WQKV) + (size_t)1536 * 1024; }
    else { r -= 64; const int l = r / 64; r -= l * 64; W = p.in[26] + (size_t)l * 1024 * 1024; K = 1024; N = 1024; dst = (bf16_t*)(ws + W_WO) + (size_t)l * 1024 * 1024; }
    const int nkt = K / 64, kt = r % nkt, nb = r / nkt;
    transpose_tile(W, K, N, dst, nb * 256, kt * 64, mode, Nh, gain);
  }
}

__device__ __forceinline__ void s5_matrices(const Params& p, int l, int g) {
  float* L = (float*)shm;
  float* apr = L;
  float* api = apr + 64 * 17;
  float* bbr = api + 64 * 17;
  float* bbi = bbr + 1024;
  float* ccr = bbi + 1024;
  float* cci = ccr + 1024;
  float* fre = cci + 1024;
  float* fim = fre + 64;
  float* Kv = fim + 64;
  const int tid = tid_o();
  unsigned char* ws = p.ws;
  const size_t lg = (size_t)l * 64 + g;
  if (tid < 64) {
    const int pp = tid;
    const double dt = exp((double)p.in[11][lg]);
    const double are = p.in[9][lg * 64 + pp], aim = p.in[10][lg * 64 + pp];
    const double mg = exp(are * dt), an = aim * dt, br = mg * cos(an), bi = mg * sin(an);
    { double pr = 1.0, pi = 0.0;
      for (int j = 0; j <= 16; ++j) { apr[pp * 17 + j] = (float)pr; api[pp * 17 + j] = (float)pi; const double t = pr * br - pi * bi; pi = pr * bi + pi * br; pr = t; } }
    const double nr = br - 1.0, ni = bi, inv = 1.0 / (are * are + aim * aim);
    fre[pp] = (float)((nr * are + ni * aim) * inv); fim[pp] = (float)((ni * are - nr * aim) * inv);
    float* a16 = (float*)(ws + W_A16) + (lg * 64 + pp) * 2;
    a16[0] = apr[pp * 17 + 16]; a16[1] = api[pp * 17 + 16];
  }
  __syncthreads();
  for (int e = tid; e < 1024; e += 512) {
    const int pp = e >> 4;
    const float br = p.in[12][lg * 1024 + e], bi = p.in[13][lg * 1024 + e];
    bbr[e] = fre[pp] * br - fim[pp] * bi; bbi[e] = fre[pp] * bi + fim[pp] * br;
    ccr[e] = p.in[14][lg * 1024 + e]; cci[e] = p.in[15][lg * 1024 + e];
  }
  __syncthreads();
  for (int e = tid; e < 4096; e += 512) {
    const int j = e >> 8, cp = (e >> 4) & 15, c = e & 15;
    float s = 0.f;
    for (int pp = 0; pp < 64; ++pp) {
      const float xr = ccr[cp * 64 + pp] * apr[pp * 17 + j] - cci[cp * 64 + pp] * api[pp * 17 + j];
      const float xi = ccr[cp * 64 + pp] * api[pp * 17 + j] + cci[cp * 64 + pp] * apr[pp * 17 + j];
      s += xr * bbr[pp * 16 + c] - xi * bbi[pp * 16 + c];
    }
    if (j == 0 && cp == c) s += p.in[16][lg * 16 + c];
    Kv[e] = s;
  }
  __syncthreads();
  bf16_t* bs3 = (bf16_t*)(ws + W_BS3) + ((size_t)l * 16384 + (size_t)g * 256) * 384;
  for (int e = tid; e < 256 * 48; e += 512) {
    const int n = e / 48, k8 = e % 48, t = n >> 4, cp = n & 15;
    float v[8];
    if (k8 < 32) {
      const int s = k8 >> 1, c0 = (k8 & 1) * 8;
#pragma unroll
      for (int i = 0; i < 8; ++i) v[i] = (s <= t) ? Kv[((t - s) * 16 + cp) * 16 + c0 + i] : 0.f;
    } else {
      const int kk = (k8 - 32) * 8;
#pragma unroll
      for (int i = 0; i < 8; ++i) {
        const int q = kk + i, pp = q & 63;
        const float cr = ccr[cp * 64 + pp], ci = cci[cp * 64 + pp], ar = apr[pp * 17 + t + 1], ai = api[pp * 17 + t + 1];
        v[i] = q < 64 ? (cr * ar - ci * ai) : -(cr * ai + ci * ar);
      }
    }
    u32x4 o; o.x = cvt_pk_bf16(v[0], v[1]); o.y = cvt_pk_bf16(v[2], v[3]); o.z = cvt_pk_bf16(v[4], v[5]); o.w = cvt_pk_bf16(v[6], v[7]);
    *(u32x4*)(bs3 + (size_t)n * 384 + k8 * 8) = o;
  }
  bf16_t* bs1 = (bf16_t*)(ws + W_BS1) + ((size_t)l * 8192 + (size_t)(g >> 1) * 256 + (g & 1) * 128) * 512;
  for (int e = tid; e < 128 * 64; e += 512) {
    const int jn = e >> 6, k8 = e & 63, k = k8 * 8, pp = jn & 63;
    float v[8];
    if ((k >> 8) == (g & 1)) {
      const int s = (k & 255) >> 4, c0 = k & 15;
      const float ar = apr[pp * 17 + 15 - s], ai = api[pp * 17 + 15 - s];
#pragma unroll
      for (int i = 0; i < 8; ++i) {
        const float br = bbr[pp * 16 + c0 + i], bi = bbi[pp * 16 + c0 + i];
        v[i] = jn < 64 ? (ar * br - ai * bi) : (ar * bi + ai * br);
      }
    } else {
#pragma unroll
      for (int i = 0; i < 8; ++i) v[i] = 0.f;
    }
    u32x4 o; o.x = cvt_pk_bf16(v[0], v[1]); o.y = cvt_pk_bf16(v[2], v[3]); o.z = cvt_pk_bf16(v[4], v[5]); o.w = cvt_pk_bf16(v[6], v[7]);
    *(u32x4*)(bs1 + (size_t)jn * 512 + k) = o;
  }
  __syncthreads();
}

__device__ __forceinline__ size_t kf_off(int krow, int kvh, int kk, int hh) { return ((((size_t)(krow >> 5) * 4 + kvh) * 4 + kk) * 64 + hh * 32 + (krow & 31)) * 8; }
__device__ __forceinline__ size_t vf_off(int krow, int kvh, int d) {
  const int kin = krow & 15, hh = (kin >> 2) & 1, j = (kin >> 3) * 4 + (kin & 3);
  return ((((size_t)(krow >> 4) * 4 + kvh) * 2 + (d >> 5)) * 64 + hh * 32 + (d & 31)) * 8 + j;
}
__device__ __forceinline__ void v_step_store(bf16_t* vt, int S, const float* vsrc, size_t vstride, int lane);
__device__ __forceinline__ void cache_phase(const Params& p) {
  unsigned char* ws = p.ws;
  bf16_t* kb = (bf16_t*)(ws + W_KB); bf16_t* vt = (bf16_t*)(ws + W_VT);
  const int gt = bid_o() * 512 + tid_o(), nth = gdim_o() * 512;
  for (int e = gt; e < 32 * 128 * 32; e += nth) {
    const int i = e / (128 * 32), w = (e / 32) % 128, c8 = e % 32, kvh = c8 >> 3, d0 = (c8 & 7) * 8;
    const int krow = KS_BASE + i * 160 + w;
    const float* s = p.in[4] + ((size_t)i * 128 + w) * 256 + c8 * 8;
    const f32x4 a = *(const f32x4*)s, b = *(const f32x4*)(s + 4);
    u32x4 o; o.x = cvt_pk_bf16(a.x, a.y); o.y = cvt_pk_bf16(a.z, a.w); o.z = cvt_pk_bf16(b.x, b.y); o.w = cvt_pk_bf16(b.z, b.w);
    *(u32x4*)(kb + kf_off(krow, kvh, d0 >> 4, (d0 >> 3) & 1)) = o;
  }
  const int lane = tid_o() & 63, wv = tid_o() >> 6;
  for (int item = bid_o() * 8 + wv; item < 32 * 8; item += gdim_o() * 8) {
    const int i = item >> 3, s = item & 7;
    v_step_store(vt, ((KS_BASE + i * 160) >> 4) + s, p.in[5] + ((size_t)i * 128 + s * 16) * 256, 256, lane);
  }
}

template <int MODE>
__device__ __forceinline__ void norm_phase(const Params& p, const float* gain, int nks) {
  unsigned char* ws = p.ws;
  const int lane = tid_o() & 63, wv = tid_o() >> 6;
  bf16_t* ub = (bf16_t*)(ws + W_UB); float* rs = (float*)(ws + W_RS);
  if (MODE == 2) {
    const bf16_t* xb = (const bf16_t*)(ws + W_XB);
    for (int row = (bid_o() * 8 + wv) * 4; row < SPLIT_ROW0; row += gdim_o() * 32) {
      u32x2 raw[4][4];
#pragma unroll
      for (int q = 0; q < 4; ++q)
#pragma unroll
        for (int j = 0; j < 4; ++j) raw[q][j] = *(const u32x2*)(xb + (size_t)(row + q) * D + (lane + 64 * j) * 4);
#pragma unroll
      for (int q = 0; q < 4; ++q) {
        float s = 0.f;
#pragma unroll
        for (int j = 0; j < 4; ++j) { const f32x4 v = unpack4(raw[q][j]); s += (v.x * v.x + v.y * v.y) + (v.z * v.z + v.w * v.w); }
        const float r = rsqrtf(wave_sum(s, lane) * (1.f / D) + 1e-6f);
        if (lane == 0) rs[row + q] = r;
      }
    }
  }
  for (int row = ((MODE == 3 || MODE == 2) ? SPLIT_ROW0 : 0) + bid_o() * 8 + wv; row < R_PAD; row += gdim_o() * 8) {
    float* xr = xrow_ptr(p, row);
    f32x4 v[4];
    if (MODE == 0) {
      const float* src = xsrc_ptr(p, row);
#pragma unroll
      for (int j = 0; j < 4; ++j) v[j] = src ? *(const f32x4*)(src + (lane + 64 * j) * 4) : (f32x4){0.f, 0.f, 0.f, 0.f};
    } else {
      bf16_t* xbr = (bf16_t*)(ws + W_XB) + (size_t)row * D;
#pragma unroll
      for (int j = 0; j < 4; ++j) v[j] = unpack4(*(const u32x2*)(xbr + (lane + 64 * j) * 4));
      if (nks > 0 && row >= SPLIT_ROW0) {
        const float* pp = (const float*)(ws + W_PART) + (size_t)(row - SPLIT_ROW0) * D + lane * 4;
        for (int k = 0; k < nks; k += 4) {
          f32x4 t[4][4];
#pragma unroll
          for (int kk = 0; kk < 4; ++kk)
#pragma unroll
            for (int j = 0; j < 4; ++j) t[kk][j] = (k + kk < nks) ? *(const f32x4*)(pp + (size_t)(k + kk) * SPLIT_ROWS * D + 256 * j) : (f32x4){0.f, 0.f, 0.f, 0.f};
#pragma unroll
          for (int kk = 0; kk < 4; ++kk)
#pragma unroll
            for (int j = 0; j < 4; ++j) v[j] += t[kk][j];
        }
        if (MODE == 3) {
#pragma unroll
          for (int j = 0; j < 4; ++j) *(f32x4*)(xr + (lane + 64 * j) * 4) = v[j];
        } else {
#pragma unroll
          for (int j = 0; j < 4; ++j) { u32x2 o; o.x = cvt_pk_bf16(v[j].x, v[j].y); o.y = cvt_pk_bf16(v[j].z, v[j].w); *(u32x2*)(xbr + (lane + 64 * j) * 4) = o; }
        }
      }
    }
    if (MODE == 3) continue;
    float s = 0.f;
#pragma unroll
    for (int j = 0; j < 4; ++j) s += (v[j].x * v[j].x + v[j].y * v[j].y) + (v[j].z * v[j].z + v[j].w * v[j].w);
    const float r = rsqrtf(wave_sum(s, lane) * (1.f / D) + 1e-6f);
    if (MODE == 2) {
      if (lane == 0) rs[row] = r;
    }
    else {
#pragma unroll
      for (int j = 0; j < 4; ++j) {
        const f32x4 gg = *(const f32x4*)(gain + (lane + 64 * j) * 4);
        u32x2 o; o.x = cvt_pk_bf16(v[j].x * r * gg.x, v[j].y * r * gg.y); o.y = cvt_pk_bf16(v[j].z * r * gg.z, v[j].w * r * gg.w);
        const int col0 = (lane + 64 * j) * 4;
        if (row < R_REAL) {
          int cgi, s_;
          if (row < R_SAMPLE) { const int b_ = row >> 14, t = row & 16383; cgi = b_ * 1025 + 1 + (t >> 4); s_ = t & 15; }
          else if (row < R_META) { const int q = row - R_SAMPLE; cgi = 2050 + (q >> 4); s_ = q & 15; }
          else { cgi = 0; s_ = row - R_META; }
          const size_t off = (size_t)cgi * 16384 + (col0 >> 4) * 256 + s_ * 16 + (col0 & 15);
          *(u32x2*)(ub + off) = o;
          if (row >= R_META) *(u32x2*)(ub + off + (size_t)1025 * 16384) = o;
        }
      }
    }
  }
}

__device__ __forceinline__ void s2_phase(const Params& p, int l) {
  unsigned char* ws = p.ws;
  const float* sb = (const float*)(ws + W_SB); bf16_t* hin = (bf16_t*)(ws + W_HIN);
  const int lane = tid_o() & 63, wv = tid_o() >> 6;
  float* ex = (float*)shm;
  constexpr int SEG = 129;
  for (int item = bid_o(); item < 128; item += gdim_o()) {
    const int b = item >> 6, g = item & 63;
    const float* a16 = (const float*)(ws + W_A16) + (((size_t)l * 64 + g) * 64 + lane) * 2;
    const float ar = a16[0], ai = a16[1];
    const int c0 = wv * SEG, c1 = (c0 + SEG) < 1025 ? (c0 + SEG) : 1025;
    const float* sp = sb + (size_t)(b * 1025) * 8192 + g * 128 + lane;
    bf16_t* hp = hin + (size_t)(b * 1025) * 8192 + g * 128 + lane;
    float hr = 0.f, hi = 0.f;
    {
      int c = c0;
      float sr[8], si[8], pr[8], pi[8];
      if (c + 8 <= c1) {
#pragma unroll
        for (int u = 0; u < 8; ++u) { sr[u] = sp[(size_t)(c + u) * 8192]; si[u] = sp[(size_t)(c + u) * 8192 + 64]; }
      }
      for (; c + 8 <= c1; c += 8) {
        const bool more = c + 16 <= c1;
        if (more) {
#pragma unroll
          for (int u = 0; u < 8; ++u) { pr[u] = sp[(size_t)(c + 8 + u) * 8192]; pi[u] = sp[(size_t)(c + 8 + u) * 8192 + 64]; }
        }
#pragma unroll
        for (int u = 0; u < 8; ++u) { const float nr = ar * hr - ai * hi + sr[u], ni = ar * hi + ai * hr + si[u]; hr = nr; hi = ni; }
#pragma unroll
        for (int u = 0; u < 8; ++u) { sr[u] = pr[u]; si[u] = pi[u]; }
      }
      for (; c < c1; ++c) { const float sr = sp[(size_t)c * 8192], si = sp[(size_t)c * 8192 + 64]; const float nr = ar * hr - ai * hi + sr, ni = ar * hi + ai * hr + si; hr = nr; hi = ni; }
    }
    ex[(wv * 2) * 64 + lane] = hr; ex[(wv * 2 + 1) * 64 + lane] = hi;
    float qr = ar, qi = ai;
#pragma unroll
    for (int s = 0; s < 7; ++s) { const float t = qr * qr - qi * qi; qi = 2.f * qr * qi; qr = t; }
    { const float t = qr * ar - qi * ai; qi = qr * ai + qi * ar; qr = t; }
    __syncthreads();
    hr = 0.f; hi = 0.f;
    for (int j = 0; j < wv; ++j) { const float er = ex[(j * 2) * 64 + lane], ei = ex[(j * 2 + 1) * 64 + lane]; const float nr = qr * hr - qi * hi + er, ni = qr * hi + qi * hr + ei; hr = nr; hi = ni; }
    {
      int c = c0;
      float sr[8], si[8], pr[8], pi[8];
      if (c + 8 <= c1) {
#pragma unroll
        for (int u = 0; u < 8; ++u) { sr[u] = sp[(size_t)(c + u) * 8192]; si[u] = sp[(size_t)(c + u) * 8192 + 64]; }
      }
      for (; c + 8 <= c1; c += 8) {
        const bool more = c + 16 <= c1;
        if (more) {
#pragma unroll
          for (int u = 0; u < 8; ++u) { pr[u] = sp[(size_t)(c + 8 + u) * 8192]; pi[u] = sp[(size_t)(c + 8 + u) * 8192 + 64]; }
        }
#pragma unroll
        for (int u = 0; u < 8; ++u) {
          hp[(size_t)(c + u) * 8192] = f2bf(hr); hp[(size_t)(c + u) * 8192 + 64] = f2bf(hi);
          const float nr = ar * hr - ai * hi + sr[u], ni = ar * hi + ai * hr + si[u]; hr = nr; hi = ni;
        }
#pragma unroll
        for (int u = 0; u < 8; ++u) { sr[u] = pr[u]; si[u] = pi[u]; }
      }
      for (; c < c1; ++c) {
        const float sr = sp[(size_t)c * 8192], si = sp[(size_t)c * 8192 + 64];
        hp[(size_t)c * 8192] = f2bf(hr); hp[(size_t)c * 8192 + 64] = f2bf(hi);
        const float nr = ar * hr - ai * hi + sr, ni = ar * hi + ai * hr + si; hr = nr; hi = ni;
      }
    }
    if (wv == 7) {
      p.out[O_PRE + (((size_t)l * NB + b) * 64 + g) * 64 + lane] = hr; p.out[O_PIM + (((size_t)l * NB + b) * 64 + g) * 64 + lane] = hi;
    }
    __syncthreads();
  }
  for (int q = bid_o() * 8 + wv; q < 2048; q += gdim_o() * 8) {
    const int i = q >> 6, g = q & 63, c0 = 2050 + 2 * i;
    const size_t so = (((size_t)l * DB + i) * 64 + g) * 64 + lane;
    float hr = p.in[2][so], hi = p.in[3][so];
    const float* a16 = (const float*)(ws + W_A16) + (((size_t)l * 64 + g) * 64 + lane) * 2;
    const float ar = a16[0], ai = a16[1];
    const float* sp = sb + (size_t)c0 * 8192 + g * 128 + lane;
    bf16_t* hp = hin + (size_t)c0 * 8192 + g * 128 + lane;
#pragma unroll
    for (int c = 0; c < 2; ++c) {
      const float sr = sp[(size_t)c * 8192], si = sp[(size_t)c * 8192 + 64];
      hp[(size_t)c * 8192] = f2bf(hr); hp[(size_t)c * 8192 + 64] = f2bf(hi);
      const float nr = ar * hr - ai * hi + sr, ni = ar * hi + ai * hr + si; hr = nr; hi = ni;
    }
    p.out[O_SRE + so] = hr; p.out[O_SIM + so] = hi;
  }
}

__device__ __forceinline__ void v_step_store(bf16_t* vt, int S, const float* vsrc, size_t vstride, int lane) {
  const int hh = lane >> 5, dl = lane & 31;
#pragma unroll
  for (int kvh = 0; kvh < 4; ++kvh)
#pragma unroll
    for (int dt = 0; dt < 2; ++dt) {
      float v[8];
#pragma unroll
      for (int j = 0; j < 8; ++j) v[j] = vsrc[(size_t)(8 * (j >> 2) + 4 * hh + (j & 3)) * vstride + kvh * 64 + dt * 32 + dl];
      u32x4 o; o.x = cvt_pk_bf16(v[0], v[1]); o.y = cvt_pk_bf16(v[2], v[3]); o.z = cvt_pk_bf16(v[4], v[5]); o.w = cvt_pk_bf16(v[6], v[7]);
      *(u32x4*)(vt + ((((size_t)S * 4 + kvh) * 2 + dt) * 64 + lane) * 8) = o;
    }
}

__device__ __forceinline__ void kvfin_phase(const Params& p) {
  unsigned char* ws = p.ws;
  const float* kv = (const float*)(ws + W_KVRAW); bf16_t* kb = (bf16_t*)(ws + W_KB); bf16_t* vt = (bf16_t*)(ws + W_VT);
  const int lane = tid_o() & 63, wv = tid_o() >> 6;
  for (int row = bid_o() * 8 + wv; row < R_REAL; row += gdim_o() * 8) {
    const float* src = kv + (size_t)row * 512 + lane * 8;
    const f32x4 a = *(const f32x4*)src, b = *(const f32x4*)(src + 4);
    float v[8] = {a.x, a.y, a.z, a.w, b.x, b.y, b.z, b.w};
    const int col = (lane & 31) * 8, kvh = col >> 6, d0 = col & 63;
    int krow; float* ok = nullptr; float* ov = nullptr;
    if (row < R_SAMPLE) { const int b_ = row >> 14, t = row & 16383; krow = row;
      if (t >= SEQ - 128) { ok = p.out + O_PK + ((size_t)b_ * 128 + (t - (SEQ - 128))) * 256; ov = p.out + O_PV + ((size_t)b_ * 128 + (t - (SEQ - 128))) * 256; } }
    else if (row < R_META) { const int q = row - R_SAMPLE, i = q >> 5, j = q & 31; krow = KS_BASE + i * 160 + 128 + j;
      ok = p.out + O_SK + (size_t)q * 256; ov = p.out + O_SV + (size_t)q * 256; }
    else { krow = KM_BASE + (row - R_META); }
    if (lane < 32) {
      float s = 0.f;
#pragma unroll
      for (int i = 0; i < 8; ++i) s += v[i] * v[i];
      s += shx(s, 1, lane); s += shx(s, 2, lane); s += shx(s, 4, lane);
      const float r = rsqrtf(s * (1.f / 64.f) + 1e-6f);
#pragma unroll
      for (int i = 0; i < 8; ++i) v[i] = v[i] * r * p.in[22][d0 + i];
      u32x4 o; o.x = cvt_pk_bf16(v[0], v[1]); o.y = cvt_pk_bf16(v[2], v[3]); o.z = cvt_pk_bf16(v[4], v[5]); o.w = cvt_pk_bf16(v[6], v[7]);
      *(u32x4*)(kb + kf_off(krow, kvh, d0 >> 4, (d0 >> 3) & 1)) = o;
      if (ok) { *(f32x4*)(ok + col) = (f32x4){v[0], v[1], v[2], v[3]}; *(f32x4*)(ok + col + 4) = (f32x4){v[4], v[5], v[6], v[7]}; }
    } else {
      float s = 0.f; s += shx(s, 1, lane); s += shx(s, 2, lane); s += shx(s, 4, lane);
#pragma unroll
      for (int i = 0; i < 8; ++i) (void)v[i];
      if (ov) { *(f32x4*)(ov + col) = (f32x4){v[0], v[1], v[2], v[3]}; *(f32x4*)(ov + col + 4) = (f32x4){v[4], v[5], v[6], v[7]}; }
    }
  }
  for (int item = bid_o() * 8 + wv; item < 2048 + 64 + 1; item += gdim_o() * 8) {
    int S, row0;
    if (item < 2048) { S = item; row0 = item * 16; }
    else if (item < 2112) { const int q = item - 2048, i = q >> 1, s = q & 1; S = ((KS_BASE + i * 160 + 128) >> 4) + s; row0 = R_SAMPLE + i * 32 + s * 16; }
    else { S = KM_BASE >> 4; row0 = R_META; }
    v_step_store(vt, S, kv + (size_t)row0 * 512 + 256, 512, lane);
  }
}

__device__ __forceinline__ int rel_bucket(int rel) {
  const int n = rel < 0 ? -rel : rel;
  const float nf = (float)(n < 1 ? 1 : n);
  int large = 8 + (int)(logf(nf / 8.f) / 2.772588722239781f * 8.f);
  large = large < 15 ? large : 15;
  return (rel > 0 ? 16 : 0) + (n < 8 ? n : large);
}

struct AttnItem { int kvh, nt_band, ktile0, sj0, tpos, qrow0, qi0, head; bool active; };
__device__ __forceinline__ AttnItem attn_item(int item, int wv) {
  AttnItem a;
  if (item < 2048) {
    const int b = item >> 10, n = (item >> 2) & 255; a.kvh = item & 3; a.head = a.kvh * 4 + (wv >> 1); const int qt = wv & 1;
    a.qi0 = qt * 32; a.qrow0 = b * SEQ + n * 64 + a.qi0; a.tpos = n * 64 + a.qi0;
    const int c0 = n >= 2 ? n - 2 : 0;
    a.nt_band = (n - c0 + 1) * 2;
    a.ktile0 = (b * SEQ + c0 * 64) >> 5;
    a.sj0 = n >= 2 ? 0 : (2 - n) * 64; a.active = true;
  } else {
    const int q = item - 2048, i = q >> 2; a.kvh = q & 3; a.head = a.kvh * 4 + (wv & 3); a.active = wv < 4;
    a.qi0 = 0; a.qrow0 = R_SAMPLE + i * 32; a.tpos = 1024; a.nt_band = 5;
    a.ktile0 = (KS_BASE + i * 160) >> 5; a.sj0 = 0;
  }
  return a;
}
constexpr int AT_BUF0 = 16896, AT_KV = 28672, AT_BUF = 2 * AT_KV;
__device__ __forceinline__ void attn_stage(const bf16_t* kb, const bf16_t* vt, int item, int buf, int wv, int lane) {
  const AttnItem a = attn_item(item, 0);
  LAS unsigned char* lds = (LAS unsigned char*)shm + AT_BUF0 + buf * AT_BUF;
#pragma unroll
  for (int t = 0; t < 7; ++t) {
    if (t <= a.nt_band) {
      const int T = t == 0 ? (KM_BASE >> 5) : a.ktile0 + (t - 1);
      const bf16_t* src; unsigned dst;
      if (wv < 4) { src = kb + ((((size_t)T * 4 + a.kvh) * 4 + wv) * 64 + lane) * 8; dst = t * 4096 + wv * 1024; }
      else { const int s = (wv - 4) >> 1, dt = (wv - 4) & 1; src = vt + (((((size_t)T * 2 + s) * 4 + a.kvh) * 2 + dt) * 64 + lane) * 8; dst = AT_KV + t * 4096 + (wv - 4) * 1024; }
      __builtin_amdgcn_global_load_lds((const unsigned*)src, (LAS unsigned*)(lds + dst), 16, 0, 0);
    }
  }
}

__device__ __forceinline__ void attn_phase(const Params& p, int jl) {
  unsigned char* ws = p.ws;
  float* lut = (float*)shm;
  float* qg = lut + 16 * 256;
  for (int e = tid_o(); e < 16 * 256; e += 512) {
    const int h = e >> 8, idx = e & 255; const int rel = idx - 191;
    lut[e] = idx < 255 ? p.in[27][rel_bucket(rel) * 16 + h] * 1.44269504089f : 0.f;
  }
  if (tid_o() < 64) qg[tid_o()] = p.in[24][jl * 64 + tid_o()] * (0.125f * 1.44269504089f);
  const bf16_t* qb = (const bf16_t*)(ws + W_UB); const bf16_t* kb = (const bf16_t*)(ws + W_KB); const bf16_t* vt = (const bf16_t*)(ws + W_VT);
  bf16_t* ao = (bf16_t*)(ws + W_YG);
  const int tid = tid_o(), lane = tid & 63, wv = __builtin_amdgcn_readfirstlane(tid >> 6), ql = lane & 31, hh = lane >> 5;
  const int G = gdim_o(), item0 = bid_o(), NITEM = 2048 + 128;
  u32x4 qraw[4];
  if (item0 < NITEM) {
    attn_stage(kb, vt, item0, 0, wv, lane);
    const AttnItem a = attn_item(item0, wv);
    const bf16_t* qp = qb + (size_t)(a.qrow0 + ql) * D + a.head * 64 + hh * 8;
#pragma unroll
    for (int kk = 0; kk < 4; ++kk) qraw[kk] = *(const u32x4*)(qp + kk * 16);
  }
  int cur = 0;
#pragma unroll 1
  for (int item = item0; item < NITEM; item += G, cur ^= 1) {
    asm volatile("s_waitcnt vmcnt(0)" ::: "memory");
    __syncthreads();
    const AttnItem a = attn_item(item, wv);
    u32x4 qcur[4];
#pragma unroll
    for (int kk = 0; kk < 4; ++kk) qcur[kk] = qraw[kk];
    if (item + G < NITEM) {
      attn_stage(kb, vt, item + G, cur ^ 1, wv, lane);
      const AttnItem an = attn_item(item + G, wv);
      const bf16_t* qp = qb + (size_t)(an.qrow0 + ql) * D + an.head * 64 + hh * 8;
#pragma unroll
      for (int kk = 0; kk < 4; ++kk) qraw[kk] = *(const u32x4*)(qp + kk * 16);
    }
    if (!a.active) continue;
    const int head = a.head, nt_band = a.nt_band, sj0 = a.sj0, qi0 = a.qi0, tpos = a.tpos, qrow0 = a.qrow0;
    const LAS unsigned char* kl = (const LAS unsigned char*)shm + AT_BUF0 + cur * AT_BUF + lane * 16;
    bf16x8 qf[4];
    {
      float qv[32]; float s = 0.f;
#pragma unroll
      for (int kk = 0; kk < 4; ++kk) {
        const unsigned w[4] = {qcur[kk].x, qcur[kk].y, qcur[kk].z, qcur[kk].w};
#pragma unroll
        for (int i = 0; i < 4; ++i) { qv[kk * 8 + 2 * i] = bf2f(w[i] & 0xffffu); qv[kk * 8 + 2 * i + 1] = bf2f(w[i] >> 16); }
      }
#pragma unroll
      for (int i = 0; i < 32; ++i) s += qv[i] * qv[i];
      s += shx(s, 32, lane);
      const float r = rsqrtf(s * (1.f / 64.f) + 1e-6f);
#pragma unroll
      for (int kk = 0; kk < 4; ++kk) {
        u32x4 o; const float* g8 = qg + kk * 16 + hh * 8;
        o.x = cvt_pk_bf16(qv[kk * 8 + 0] * r * g8[0], qv[kk * 8 + 1] * r * g8[1]); o.y = cvt_pk_bf16(qv[kk * 8 + 2] * r * g8[2], qv[kk * 8 + 3] * r * g8[3]);
        o.z = cvt_pk_bf16(qv[kk * 8 + 4] * r * g8[4], qv[kk * 8 + 5] * r * g8[5]); o.w = cvt_pk_bf16(qv[kk * 8 + 6] * r * g8[6], qv[kk * 8 + 7] * r * g8[7]);
        qf[kk] = __builtin_bit_cast(bf16x8, o);
      }
    }
    f32x16 sc[7];
#pragma unroll
    for (int t = 0; t < 7; ++t) {
      if (t <= nt_band) {
        f32x16 a_ = {0.f, 0.f, 0.f, 0.f, 0.f, 0.f, 0.f, 0.f, 0.f, 0.f, 0.f, 0.f, 0.f, 0.f, 0.f, 0.f};
#pragma unroll
        for (int kk = 0; kk < 4; ++kk) {
          const bf16x8 kf = *(const LAS bf16x8*)(kl + t * 4096 + kk * 1024);
          a_ = __builtin_amdgcn_mfma_f32_32x32x16_bf16(kf, qf[kk], a_, 0, 0, 0);
        }
        sc[t] = a_;
      }
    }
    const float sink = p.in[25][jl * 16 + head] * 1.44269504089f;
    const float* lh = lut + head * 256 + 191;
    float mx = sink;
    const int qi = qi0 + ql;
#pragma unroll
    for (int t = 0; t < 7; ++t) {
      if (t <= nt_band) {
#pragma unroll
        for (int r = 0; r < 16; ++r) {
          const int key = 8 * (r >> 2) + 4 * hh + (r & 3);
          float v;
          if (t == 0) {
            if (r < 8) { int rel = key - 16 - (tpos + ql); rel = rel < -191 ? -191 : rel; v = sc[t][r] + lh[rel]; } else v = -1e30f;
          } else {
            const int rel = sj0 + (t - 1) * 32 + key - 128 - qi;
            v = sc[t][r] + lh[rel];
          }
          sc[t][r] = v; mx = fmaxf(mx, v);
        }
      }
    }
    mx = fmaxf(mx, shx(mx, 32, lane));
    float sum = 0.f;
#pragma unroll
    for (int t = 0; t < 7; ++t) {
      if (t <= nt_band) {
#pragma unroll
        for (int r = 0; r < 16; ++r) { const float e = __builtin_amdgcn_exp2f(sc[t][r] - mx); sc[t][r] = e; sum += e; }
      }
    }
    sum += shx(sum, 32, lane);
    const float inv = 1.f / (sum + __builtin_amdgcn_exp2f(sink - mx));
    f32x16 o0 = {0.f, 0.f, 0.f, 0.f, 0.f, 0.f, 0.f, 0.f, 0.f, 0.f, 0.f, 0.f, 0.f, 0.f, 0.f, 0.f}, o1 = o0;
#pragma unroll
    for (int t = 0; t < 7; ++t) {
      if (t <= nt_band) {
#pragma unroll
        for (int s = 0; s < 2; ++s) {
          if (t == 0 && s == 1) continue;
          u32x4 pa; pa.x = cvt_pk_bf16(sc[t][8 * s + 0] * inv, sc[t][8 * s + 1] * inv); pa.y = cvt_pk_bf16(sc[t][8 * s + 2] * inv, sc[t][8 * s + 3] * inv);
          pa.z = cvt_pk_bf16(sc[t][8 * s + 4] * inv, sc[t][8 * s + 5] * inv); pa.w = cvt_pk_bf16(sc[t][8 * s + 6] * inv, sc[t][8 * s + 7] * inv);
          const bf16x8 pf = __builtin_bit_cast(bf16x8, pa);
          const bf16x8 b0 = *(const LAS bf16x8*)(kl + AT_KV + t * 4096 + s * 2048), b1 = *(const LAS bf16x8*)(kl + AT_KV + t * 4096 + s * 2048 + 1024);
          o0 = __builtin_amdgcn_mfma_f32_32x32x16_bf16(pf, b0, o0, 0, 0, 0);
          o1 = __builtin_amdgcn_mfma_f32_32x32x16_bf16(pf, b1, o1, 0, 0, 0);
        }
      }
    }
#pragma unroll
    for (int r = 0; r < 16; ++r) {
      const int q = 8 * (r >> 2) + 4 * hh + (r & 3);
      bf16_t* op = ao + (size_t)(qrow0 + q) * D + head * 64 + ql;
      op[0] = f2bf(o0[r]); op[32] = f2bf(o1[r]);
    }
  }
  asm volatile("s_waitcnt vmcnt(0)" ::: "memory");
  __syncthreads();
}

__global__ void __launch_bounds__(512) fwd_megakernel(Params p) {
  cg::grid_group grid = cg::this_grid();
  unsigned char* ws = p.ws;
  volatile LAS unsigned* xst = (volatile LAS unsigned*)((LAS unsigned char*)shm + XB_LDS_OFF);
  if (threadIdx.x < 4) xst[threadIdx.x] = 0u;
  __syncthreads();
  (void)xcd_barrier_post((unsigned*)(ws + W_BAR), xst);
  for (int it = bid_o(); it < 128; it += gdim_o()) s5_matrices(p, it >> 6, it & 63);
  weights_phase(p);
  cache_phase(p);
  norm_phase<0>(p, p.in[7], 0);
  if (p.ws == nullptr) grid.sync();
  xcd_barrier(p.ws);
#pragma unroll 1
  for (int l = 0; l < 4; ++l) {
    if (l < 2) {
      if (l == 1) { norm_phase<1>(p, p.in[7] + D, 11); xcd_barrier(p.ws); }
      gemm_phase<G_S1>(p, nullptr, 0, (const bf16_t*)(ws + W_BS1) + (size_t)l * 8192 * 512, 8192, 512);
      xcd_barrier(p.ws);
      if (PROBE == 9) { gemm_phase<G_S1>(p, nullptr, 0, (const bf16_t*)(ws + W_BS1) + (size_t)l * 8192 * 512, 8192, 512); xcd_barrier(p.ws); }
      s2_phase(p, l);
      xcd_barrier(p.ws);
      if (PROBE == 3) { s2_phase(p, l); xcd_barrier(p.ws); s2_phase(p, l); xcd_barrier(p.ws); }
      gemm_phase<G_S3>(p, nullptr, 0, (const bf16_t*)(ws + W_BS3) + (size_t)l * 16384 * 384, 16384, 384);
      xcd_barrier(p.ws);
      if (PROBE == 10) { gemm_phase<G_S3>(p, nullptr, 0, (const bf16_t*)(ws + W_BS3) + (size_t)l * 16384 * 384, 16384, 384); xcd_barrier(p.ws); }
      gemm_phase<G_GLU>(p, (const bf16_t*)(ws + W_YG), D, (const bf16_t*)(ws + W_WGLU) + (size_t)l * 2048 * 1024, 2048, 1024, l == 0);
      xcd_barrier(p.ws);
    } else {
      norm_phase<2>(p, nullptr, 11);
      xcd_barrier(p.ws);
      if (l == 2) gemm_phase_stream<G_QKV>(p, (const bf16_t*)(ws + W_XB), D, (const bf16_t*)(ws + W_WQKV), 1536, 1024);
      else gemm_phase_stream<G_QKV>(p, (const bf16_t*)(ws + W_XB), D, (const bf16_t*)(ws + W_WQKV) + (size_t)1536 * 1024, 1024, 1024);
      xcd_barrier(p.ws);
      if (l == 2) { kvfin_phase(p); xcd_barrier(p.ws); }
      attn_phase(p, l - 2);
      xcd_barrier(p.ws);
      if (PROBE == 4) { attn_phase(p, l - 2); xcd_barrier(p.ws); attn_phase(p, l - 2); xcd_barrier(p.ws); }
      gemm_phase<G_RESID>(p, (const bf16_t*)(ws + W_YG), D, (const bf16_t*)(ws + W_WO) + (size_t)(l - 2) * 1024 * 1024, 1024, 1024);
      xcd_barrier(p.ws);
    }
    norm_phase<2>(p, nullptr, l < 2 ? 0 : 4);
    xcd_barrier(p.ws);
    gemm_phase_stream<G_FFIN>(p, (const bf16_t*)(ws + W_XB), D, (const bf16_t*)(ws + W_WIN) + (size_t)l * 5632 * 1024, 5632, 1024);
    xcd_barrier(p.ws);
    if (PROBE == 1) { gemm_phase_stream<G_FFIN>(p, (const bf16_t*)(ws + W_XB), D, (const bf16_t*)(ws + W_WIN) + (size_t)l * 5632 * 1024, 5632, 1024); xcd_barrier(p.ws); }
    if (PROBE == 2) { for (int q = 0; q < 10; ++q) xcd_barrier(p.ws); }
    gemm_phase<G_RESID>(p, (const bf16_t*)(ws + W_HB), FF, (const bf16_t*)(ws + W_WOUT) + (size_t)l * 1024 * FF, 1024, FF, l == 3 ? 2 : 0);
    xcd_barrier(p.ws);
  }
  norm_phase<3>(p, nullptr, 11);
}

extern "C" void kernel_launch(void* const* d_in, const int* in_sizes, int n_in, void* d_out, int out_size, void* d_ws, size_t ws_size, hipStream_t stream) {
  static int grid_blocks = 0;
  if (grid_blocks == 0) {
    if (n_in != 28 || (size_t)out_size != O_END || ws_size < W_END) { fprintf(stderr, "kernel_launch: unexpected shapes (n_in %d out %d ws %zu need %zu)\n", n_in, out_size, ws_size, (size_t)W_END); grid_blocks = -1; return; }
    int dev = 0, cus = 0, per_cu = 0;
    hipGetDevice(&dev);
    hipDeviceGetAttribute(&cus, hipDeviceAttributeMultiprocessorCount, dev);
    if (hipFuncSetAttribute((const void*)fwd_megakernel, hipFuncAttributeMaxDynamicSharedMemorySize, LDS_BYTES) != hipSuccess) { fprintf(stderr, "kernel_launch: hipFuncSetAttribute failed\n"); }
    hipOccupancyMaxActiveBlocksPerMultiprocessor(&per_cu, (const void*)fwd_megakernel, 512, LDS_BYTES);
    if (per_cu < 1) { fprintf(stderr, "kernel_launch: occupancy query says %d blocks/CU\n", per_cu); per_cu = 1; }
    (void)hipGetLastError();
    grid_blocks = cus;
  }
  if (grid_blocks < 0) return;
  if (hipMemsetAsync((char*)d_ws + W_BAR, 0, 4096 * 4, stream) != hipSuccess) { fprintf(stderr, "kernel_launch: memset failed\n"); return; }
  Params p{};
  for (int i = 0; i < 28; ++i) p.in[i] = (const float*)d_in[i];
  p.out = (float*)d_out; p.ws = (unsigned char*)d_ws;
  void* args[] = {&p};
  hipError_t e = hipLaunchCooperativeKernel((const void*)fwd_megakernel, dim3(grid_blocks), dim3(512), args, LDS_BYTES, stream);
  if (e != hipSuccess) fprintf(stderr, "cooperative launch failed: %s (grid %d)\n", hipGetErrorString(e), grid_blocks);
}
```
